# Optimizing an MI355X kernel written in HIP

```python
import jax, jax.numpy as jnp
from jax import lax
import numpy as np

D_MODEL = 1024
BATCH = 8
SEQ = 4096
DEPTH = 2

GRID_W = 64
CTX_LEN = 256
EPS = 1e-6
HEAD_DIM = 64
CONV_WIDTH = 512
CONV_K = 3
NA_HEADS = 8
NA_WIDTH = NA_HEADS * HEAD_DIM
NA_KH = 8
NA_KW = 16
GQA_Q_HEADS = 8
GQA_KV_HEADS = 2
GQA_WIDTH = GQA_Q_HEADS * HEAD_DIM
GQA_KV_WIDTH = GQA_KV_HEADS * HEAD_DIM
ROPE_THETA = 10000.0
Q_BLOCK = 128
N_EXPERTS = 32
TOP_K = 4
D_FF_EXPERT = D_MODEL
SWIGLU_ALPHA = 1.702
SWIGLU_LIMIT = 7.0
MOE_BLOCK = 128
IN_SPLITS = (CONV_WIDTH,) * 3 + (NA_WIDTH,) * 3 + (GQA_WIDTH, GQA_KV_WIDTH, GQA_KV_WIDTH) + (D_MODEL,) * 3
IN_COLS = sum(IN_SPLITS)
IN_OFFSETS = [int(o) for o in np.cumsum(IN_SPLITS)[:-1]]

kernel_name = 'hybrid_conv_na_gqa_moe_dit'


def rmsnorm(x, g):
    xf = x.astype(jnp.float32)
    y = xf * lax.rsqrt(jnp.mean(xf * xf, axis=-1, keepdims=True) + EPS)
    return (y * g.astype(jnp.float32)).astype(x.dtype)


def modulate(h, shift, scale):
    return h * (1 + scale) + shift


def split_in(p):
    return jnp.split(p, IN_OFFSETS, axis=-1)


def heads(t, h):
    return t.reshape(t.shape[:-1] + (h, HEAD_DIM))


def conv3_centered(u, w):
    up = jnp.pad(u, ((0, 0), (1, 1), (0, 0)))
    return up[:, :-2] * w[0] + up[:, 1:-1] * w[1] + up[:, 2:] * w[2]


def axial_rope(x):
    n, dh = x.shape[1], x.shape[-1]
    half = dh // 2
    t = jnp.arange(n)
    inv = ROPE_THETA ** (-jnp.arange(0, half, 2, dtype=jnp.float32) / half)

    def rot(xa, pos):
        ang = pos.astype(jnp.float32)[:, None] * inv
        cos = jnp.cos(ang)[None, :, None, :]
        sin = jnp.sin(ang)[None, :, None, :]
        x1, x2 = jnp.split(xa.astype(jnp.float32), 2, axis=-1)
        return jnp.concatenate([x1 * cos - x2 * sin, x1 * sin + x2 * cos], axis=-1)

    xr, xc = jnp.split(x, 2, axis=-1)
    return jnp.concatenate([rot(xr, t // GRID_W), rot(xc, t % GRID_W)], axis=-1).astype(x.dtype)


def attend(q, k, v):
    b, t, hq, dh = q.shape
    hkv = k.shape[2]
    qg = q.reshape(b, t, hkv, hq // hkv, dh)
    s = jnp.einsum('btkgd,bskd->bkgts', qg, k).astype(jnp.float32) * (dh ** -0.5)
    p = jax.nn.softmax(s, axis=-1).astype(v.dtype)
    o = jnp.einsum('bkgts,bskd->btkgd', p, v)
    return o.reshape(b, t, hq * dh)


def gqa_blocked(q, k, v, kc, vc):
    b, n, hq, dh = q.shape
    k_all = jnp.concatenate([k, kc], axis=1)
    v_all = jnp.concatenate([v, vc], axis=1)
    nb = n // Q_BLOCK
    qb = jnp.moveaxis(q.reshape(b, nb, Q_BLOCK, hq, dh), 1, 0)
    out = lax.map(lambda qi: attend(qi, k_all, v_all), qb)
    return jnp.moveaxis(out, 0, 1).reshape(b, n, hq * dh)


def neighborhood_attention(q, k, v, kc, vc, rpb):
    b, n, h, dh = q.shape
    rows = n // GRID_W
    wh = min(NA_KH, rows)
    qg = q.reshape(b, rows, GRID_W, h, dh)
    kg = k.reshape(b, rows, GRID_W, h, dh)
    vg = v.reshape(b, rows, GRID_W, h, dh)
    cols = jnp.arange(GRID_W)
    col_start = jnp.clip(cols - NA_KW // 2, 0, GRID_W - NA_KW)
    cidx = col_start[:, None] + jnp.arange(NA_KW)
    coff = cidx - cols[:, None] + (NA_KW - 1)
    scale = dh ** -0.5
    n_win = wh * NA_KW

    def row_block(r):
        rs = jnp.clip(r - NA_KH // 2, 0, rows - wh)
        q_r = lax.dynamic_index_in_dim(qg, r, axis=1, keepdims=False)
        k_band = lax.dynamic_slice_in_dim(kg, rs, wh, axis=1)
        v_band = lax.dynamic_slice_in_dim(vg, rs, wh, axis=1)
        k_win = k_band[:, :, cidx]
        v_win = v_band[:, :, cidx]
        roff = rs + jnp.arange(wh) - r + (NA_KH - 1)
        bias = rpb[:, roff[None, :, None], coff[:, None, :]]
        s_win = jnp.einsum('bchd,bicjhd->bhcij', q_r, k_win).astype(jnp.float32) * scale + bias.astype(jnp.float32)[None]
        s_ctx = jnp.einsum('bchd,blhd->bhcl', q_r, kc).astype(jnp.float32) * scale
        s = jnp.concatenate([s_win.reshape(b, h, GRID_W, n_win), s_ctx], axis=-1)
        p = jax.nn.softmax(s, axis=-1).astype(v.dtype)
        p_win = p[..., :n_win].reshape(b, h, GRID_W, wh, NA_KW)
        p_ctx = p[..., n_win:]
        return jnp.einsum('bhcij,bicjhd->bchd', p_win, v_win) + jnp.einsum('bhcl,blhd->bchd', p_ctx, vc)

    out = lax.map(row_block, jnp.arange(rows))
    return jnp.moveaxis(out, 0, 1).reshape(b, n, h * dh)


def branch_merge(y_conv, y_na, y_gqa, g_conv, g_na, g_gqa, w_br_conv, w_br_na, w_br_gqa, w_out):
    m = (jax.nn.sigmoid(g_conv) * (y_conv @ w_br_conv)
         + jax.nn.sigmoid(g_na) * (y_na @ w_br_na)
         + jax.nn.sigmoid(g_gqa) * (y_gqa @ w_br_gqa))
    return m @ w_out


def clamped_swiglu(hgu):
    g = jnp.minimum(hgu[..., ::2], SWIGLU_LIMIT)
    u = jnp.clip(hgu[..., 1::2], -SWIGLU_LIMIT, SWIGLU_LIMIT)
    return (u + 1) * (g * jax.nn.sigmoid(SWIGLU_ALPHA * g))


def moe(h, router_w, router_b, w_gu, b_gu, w_down, b_down):
    n, d = h.shape
    logits = (h @ router_w + router_b).astype(jnp.float32)
    top_val, top_idx = lax.top_k(logits, TOP_K)
    gates = jax.nn.softmax(top_val, axis=-1).astype(h.dtype)
    nk = n * TOP_K
    flat_e = top_idx.reshape(nk)
    flat_tok = jnp.repeat(jnp.arange(n, dtype=jnp.int32), TOP_K)
    flat_g = gates.reshape(nk)
    order = jnp.argsort(flat_e)
    se, stok, sg = flat_e[order], flat_tok[order], flat_g[order]
    counts = jnp.bincount(flat_e, length=N_EXPERTS)
    padded = (counts + MOE_BLOCK - 1) // MOE_BLOCK * MOE_BLOCK
    pend = jnp.cumsum(padded)
    pstart = pend - padded
    cstart = jnp.cumsum(counts) - counts
    dest = pstart[se] + jnp.arange(nk) - cstart[se]
    n_blocks = -(-nk // MOE_BLOCK) + N_EXPERTS
    cap = n_blocks * MOE_BLOCK
    tok_buf = jnp.zeros((cap,), jnp.int32).at[dest].set(stok)
    gate_buf = jnp.zeros((cap,), h.dtype).at[dest].set(sg)
    block_e = jnp.minimum(jnp.searchsorted(pend, jnp.arange(n_blocks) * MOE_BLOCK, side='right'), N_EXPERTS - 1)

    def expert_block(args):
        tok, g, e = args
        xb = h[tok]
        a = clamped_swiglu(xb @ w_gu[e] + b_gu[e])
        return (a @ w_down[e] + b_down[e]) * g[:, None]

    y = lax.map(expert_block, (tok_buf.reshape(n_blocks, MOE_BLOCK), gate_buf.reshape(n_blocks, MOE_BLOCK), block_e))
    return jnp.zeros_like(h).at[tok_buf].add(y.reshape(cap, d))


def setup_inputs(seed: int = 0) -> dict:
    key = jax.random.key(seed)
    ks = jax.random.split(key, 24)

    def nrm(k, shape, scale):
        return jax.random.normal(k, shape, jnp.float32) * scale

    return {
        'x': nrm(ks[0], (BATCH, SEQ, D_MODEL), 1.0),
        'c': nrm(ks[1], (BATCH, D_MODEL), 1.0),
        'ctx': nrm(ks[2], (BATCH, CTX_LEN, D_MODEL), 1.0),
        'c_ctx': nrm(ks[3], (D_MODEL,), 1.0),
        'ada_w': nrm(ks[4], (DEPTH, D_MODEL, 6 * D_MODEL), 0.5 * D_MODEL ** -0.5),
        'ada_b': nrm(ks[5], (DEPTH, 6 * D_MODEL), 0.02),
        'norm1_g': 1.0 + nrm(ks[6], (DEPTH, D_MODEL), 0.02),
        'norm2_g': 1.0 + nrm(ks[7], (DEPTH, D_MODEL), 0.02),
        'w_in': nrm(ks[8], (DEPTH, D_MODEL, IN_COLS), D_MODEL ** -0.5),
        'conv_w': nrm(ks[9], (DEPTH, CONV_K, CONV_WIDTH), CONV_K ** -0.5),
        'na_rpb': nrm(ks[10], (DEPTH, NA_HEADS, 2 * NA_KH - 1, 2 * NA_KW - 1), 0.1),
        'q_norm_g': 1.0 + nrm(ks[11], (DEPTH, HEAD_DIM), 0.02),
        'k_norm_g': 1.0 + nrm(ks[12], (DEPTH, HEAD_DIM), 0.02),
        'w_br_conv': nrm(ks[13], (DEPTH, CONV_WIDTH, D_MODEL), CONV_WIDTH ** -0.5),
        'w_br_na': nrm(ks[14], (DEPTH, NA_WIDTH, D_MODEL), NA_WIDTH ** -0.5),
        'w_br_gqa': nrm(ks[15], (DEPTH, GQA_WIDTH, D_MODEL), GQA_WIDTH ** -0.5),
        'w_out': nrm(ks[16], (DEPTH, D_MODEL, D_MODEL), D_MODEL ** -0.5),
        'router_w': nrm(ks[17], (DEPTH, D_MODEL, N_EXPERTS), D_MODEL ** -0.5),
        'router_b': nrm(ks[18], (DEPTH, N_EXPERTS), 0.01),
        'w_gu': nrm(ks[19], (DEPTH, N_EXPERTS, D_MODEL, 2 * D_FF_EXPERT), D_MODEL ** -0.5),
        'b_gu': nrm(ks[20], (DEPTH, N_EXPERTS, 2 * D_FF_EXPERT), 0.01),
        'w_down': nrm(ks[21], (DEPTH, N_EXPERTS, D_FF_EXPERT, D_MODEL), D_FF_EXPERT ** -0.5),
        'b_down': nrm(ks[22], (DEPTH, N_EXPERTS, D_MODEL), 0.01),
        'final_g': 1.0 + nrm(ks[23], (D_MODEL,), 0.02),
    }


def reference(x, c, ctx, c_ctx, ada_w, ada_b, norm1_g, norm2_g, w_in, conv_w, na_rpb,
              q_norm_g, k_norm_g, w_br_conv, w_br_na, w_br_gqa, w_out,
              router_w, router_b, w_gu, b_gu, w_down, b_down, final_g):
    b, n, d = x.shape
    n_ctx = ctx.shape[1]
    xl, xc = x, ctx
    for l in range(DEPTH):
        last = l == DEPTH - 1
        mod_l = (jax.nn.silu(c) @ ada_w[l] + ada_b[l])[:, None, :]
        mod_c = jax.nn.silu(c_ctx) @ ada_w[l] + ada_b[l]
        sh1_l, sc1_l, gt1_l, sh2_l, sc2_l, gt2_l = jnp.split(mod_l, 6, axis=-1)
        sh1_c, sc1_c, gt1_c, sh2_c, sc2_c, gt2_c = jnp.split(mod_c, 6, axis=-1)

        hl = modulate(rmsnorm(xl, norm1_g[l]), sh1_l, sc1_l)
        hc = modulate(rmsnorm(xc, norm1_g[l]), sh1_c, sc1_c)
        (cb_l, cc_l, cx_l, naq_l, nak_l, nav_l, gq_l, gk_l, gv_l,
         bg_conv_l, bg_na_l, bg_gqa_l) = split_in(hl @ w_in[l])
        (cb_c, cc_c, cx_c, naq_c, nak_c, nav_c, gq_c, gk_c, gv_c,
         bg_conv_c, bg_na_c, bg_gqa_c) = split_in(hc @ w_in[l])
        na_kc = heads(nak_c, NA_HEADS)
        na_vc = heads(nav_c, NA_HEADS)
        gqa_kc = rmsnorm(heads(gk_c, GQA_KV_HEADS), k_norm_g[l])
        gqa_vc = heads(gv_c, GQA_KV_HEADS)

        y_conv = cb_l * conv3_centered(cc_l * cx_l, conv_w[l])
        y_na = neighborhood_attention(heads(naq_l, NA_HEADS), heads(nak_l, NA_HEADS),
                                      heads(nav_l, NA_HEADS), na_kc, na_vc, na_rpb[l])
        q_l = axial_rope(rmsnorm(heads(gq_l, GQA_Q_HEADS), q_norm_g[l]))
        k_l = axial_rope(rmsnorm(heads(gk_l, GQA_KV_HEADS), k_norm_g[l]))
        y_gqa = gqa_blocked(q_l, k_l, heads(gv_l, GQA_KV_HEADS), gqa_kc, gqa_vc)
        xl = xl + gt1_l * branch_merge(y_conv, y_na, y_gqa, bg_conv_l, bg_na_l, bg_gqa_l,
                                       w_br_conv[l], w_br_na[l], w_br_gqa[l], w_out[l])

        if not last:
            yc_conv = cb_c * conv3_centered(cc_c * cx_c, conv_w[l])
            yc_na = attend(heads(naq_c, NA_HEADS), na_kc, na_vc)
            yc_gqa = attend(rmsnorm(heads(gq_c, GQA_Q_HEADS), q_norm_g[l]), gqa_kc, gqa_vc)
            xc = xc + gt1_c * branch_merge(yc_conv, yc_na, yc_gqa, bg_conv_c, bg_na_c, bg_gqa_c,
                                           w_br_conv[l], w_br_na[l], w_br_gqa[l], w_out[l])

        hl2 = modulate(rmsnorm(xl, norm2_g[l]), sh2_l, sc2_l).reshape(b * n, d)
        if not last:
            hc2 = modulate(rmsnorm(xc, norm2_g[l]), sh2_c, sc2_c).reshape(b * n_ctx, d)
            out = moe(jnp.concatenate([hl2, hc2], axis=0), router_w[l], router_b[l],
                      w_gu[l], b_gu[l], w_down[l], b_down[l])
            xl = xl + gt2_l * out[:b * n].reshape(b, n, d)
            xc = xc + gt2_c * out[b * n:].reshape(b, n_ctx, d)
        else:
            out = moe(hl2, router_w[l], router_b[l], w_gu[l], b_gu[l], w_down[l], b_down[l])
            xl = xl + gt2_l * out.reshape(b, n, d)
    return rmsnorm(xl, final_g)
```

```cpp
#include <hip/hip_runtime.h>
#include <stdint.h>
#include <stdio.h>

typedef unsigned short bf16_t;
#define LAS __attribute__((address_space(3)))
#define GAS __attribute__((address_space(1)))
__device__ __forceinline__ float bf2f(unsigned b) { return __uint_as_float(b << 16); }
__device__ __forceinline__ unsigned f2bf(float f) { unsigned u = __float_as_uint(f); return (u + 0x7fffu + ((u >> 16) & 1u)) >> 16; }
__device__ __forceinline__ unsigned pk2(float lo, float hi) { return f2bf(lo) | (f2bf(hi) << 16); }

constexpr int D = 1024, NB = 8, SEQ = 4096, CTXL = 256, NLAT = NB * SEQ, NCTX = NB * CTXL, NTOK = NLAT + NCTX;
constexpr int INC = 6912, MODW = 6144;
constexpr int O_CB = 0, O_CC = 512, O_CX = 1024, O_NAQ = 1536, O_NAK = 2048, O_NAV = 2560, O_GQ = 3072, O_GK = 3584, O_GV = 3712, O_BGC = 3840, O_BGN = 4864, O_BGG = 5888;
constexpr int NE = 32, TOPK = 4, KVLEN = SEQ + CTXL;
constexpr int MPAD = 147456;
constexpr int NRB = 256;
constexpr float EPS = 1e-6f;
constexpr float YB_SCALE = 8.f;

constexpr size_t al256(size_t x) { return (x + 255) & ~(size_t)255; }
constexpr size_t WS_CTL = 0;
constexpr int CW_BAR = 4096;
constexpr size_t WS_MOD = 1 << 20;
constexpr size_t WS_TOKE = WS_MOD + al256(2 * 9 * MODW * 4);
constexpr size_t WS_TOKG = WS_TOKE + al256((size_t)NTOK * 16);
constexpr size_t WS_TOKS = WS_TOKG + al256((size_t)NTOK * 16);
constexpr size_t WS_BCNT = WS_TOKS + al256((size_t)NTOK * 16);
constexpr size_t WS_EOFF = WS_BCNT + al256(2 * NRB * 32 * 4);
constexpr size_t WS_STOK = al256(WS_EOFF + 512);
constexpr size_t WS_X = al256(WS_STOK + (size_t)MPAD * 4);
constexpr size_t WS_H = WS_X + (size_t)NTOK * D * 4;
constexpr size_t WS_KG = WS_H + (size_t)NTOK * D * 2;
constexpr size_t WS_VG = WS_KG + (size_t)NB * KVLEN * 128 * 2;
constexpr size_t WS_R1 = WS_VG + (size_t)NB * KVLEN * 128 * 2;
constexpr size_t WS_P = WS_R1;
constexpr size_t WS_Y = WS_P + (size_t)NTOK * INC * 2;
constexpr size_t WS_M = WS_Y + (size_t)NTOK * 1536 * 2;
constexpr size_t WS_XG = WS_R1;
constexpr size_t WS_A = WS_XG + (size_t)MPAD * D;
constexpr size_t WS_YB = WS_A + (size_t)MPAD * D;
constexpr size_t WS_R1_END = (WS_M + (size_t)NTOK * D * 2) > (WS_YB + (size_t)MPAD * D * 2) ? (WS_M + (size_t)NTOK * D * 2) : (WS_YB + (size_t)MPAD * D * 2);
constexpr size_t WS_WIN = al256(WS_R1_END);
constexpr size_t WS_WMG = WS_WIN + (size_t)2 * INC * D * 2;
constexpr size_t WS_WOUT = WS_WMG + (size_t)2 * 3 * D * 512 * 2;
constexpr size_t WS_WGU = WS_WOUT + (size_t)2 * D * D * 2;
constexpr size_t WS_WDN = WS_WGU + (size_t)2 * NE * 2048 * D;
constexpr size_t WS_BGU = WS_WDN + (size_t)2 * NE * D * D;
constexpr size_t WS_WRT = WS_BGU + (size_t)2 * NE * 2048 * 4;
constexpr size_t WS_H8 = al256(WS_WRT + (size_t)2 * NE * D * 2);
constexpr size_t WS_WIN8 = WS_H8 + (size_t)NTOK * D;
constexpr size_t WS_END = WS_WIN8 + (size_t)2 * INC * D;
#ifndef INPROJ_SPLIT
#define INPROJ_SPLIT 6
#endif
constexpr int IP_S = INPROJ_SPLIT;

struct Ptrs {
    const float *x, *c, *ctx, *c_ctx, *ada_w, *ada_b, *norm1_g, *norm2_g, *w_in, *conv_w, *na_rpb, *q_norm_g, *k_norm_g;
    const float *w_br_conv, *w_br_na, *w_br_gqa, *w_out, *router_w, *router_b, *w_gu, *b_gu, *w_down, *b_down, *final_g;
    float* out; unsigned char* ws;
};

__device__ __forceinline__ int mod_row(int row) { return row < NLAT ? row / SEQ : 8; }
__device__ __forceinline__ float lane_xor(float v, int lane, int o) { return __int_as_float(__builtin_amdgcn_ds_bpermute((lane ^ o) << 2, __float_as_int(v))); }
__device__ __forceinline__ float wave_sum(float v, int lane) {
#pragma unroll
    for (int o = 1; o < 64; o <<= 1) v += lane_xor(v, lane, o);
    return v;
}
__device__ __forceinline__ int opaque_tid(int wv) { int l; asm volatile("v_mbcnt_lo_u32_b32 %0, -1, 0\n\tv_mbcnt_hi_u32_b32 %0, -1, %0" : "=v"(l)); return wv * 64 + l; }

__device__ __forceinline__ void sincos_small(float a, float& s, float& c) {
    const float k = rintf(a * 0.6366197723675814f); const float r = ((a - k * 1.5703125f) - k * 4.837512969970703125e-4f) - k * 7.54978995489188216e-8f; const float r2 = r * r;
    const float sr = r + r * r2 * (-1.6666654611e-1f + r2 * (8.3321608736e-3f + r2 * (-1.9515295891e-4f)));
    const float cr = 1.f - 0.5f * r2 + r2 * r2 * (4.166664568298827e-2f + r2 * (-1.388731625493765e-3f + r2 * 2.443315711809948e-5f));
    const int q = ((int)k) & 3; s = (q == 0) ? sr : (q == 1) ? cr : (q == 2) ? -sr : -cr; c = (q == 0) ? cr : (q == 1) ? -sr : (q == 2) ? -cr : sr;
}
__device__ __forceinline__ void head_norm_rope(float (&v)[64], const float* g, bool rope, int t) {
    float ss = 0.f;
#pragma unroll
    for (int d = 0; d < 64; ++d) ss += v[d] * v[d];
    const float r = rsqrtf(ss * (1.f / 64.f) + EPS);
#pragma unroll
    for (int d = 0; d < 64; ++d) v[d] = v[d] * r * g[d];
    if (rope) {
        const float pr = (float)(t / 64), pc = (float)(t % 64);
#pragma unroll
        for (int i = 0; i < 16; ++i) { const float inv = exp2f(-(float)i * 0.8304820237218406f);
            { float cs, sn; sincos_small(pr * inv, sn, cs); const float x1 = v[i], x2 = v[16 + i]; v[i] = x1 * cs - x2 * sn; v[16 + i] = x1 * sn + x2 * cs; }
            { float cs, sn; sincos_small(pc * inv, sn, cs); const float x1 = v[32 + i], x2 = v[48 + i]; v[32 + i] = x1 * cs - x2 * sn; v[48 + i] = x1 * sn + x2 * cs; } }
    }
}
__device__ __forceinline__ void load64(float (&v)[64], const bf16_t* src) {
#pragma unroll
    for (int i = 0; i < 8; ++i) { const uint4 w = ((const uint4*)src)[i];
        v[8 * i + 0] = bf2f(w.x & 0xffff); v[8 * i + 1] = bf2f(w.x >> 16); v[8 * i + 2] = bf2f(w.y & 0xffff); v[8 * i + 3] = bf2f(w.y >> 16);
        v[8 * i + 4] = bf2f(w.z & 0xffff); v[8 * i + 5] = bf2f(w.z >> 16); v[8 * i + 6] = bf2f(w.w & 0xffff); v[8 * i + 7] = bf2f(w.w >> 16); }
}
__device__ __forceinline__ void store64(bf16_t* dst, const float (&v)[64]) {
#pragma unroll
    for (int i = 0; i < 8; ++i) { uint4 w; w.x = pk2(v[8 * i], v[8 * i + 1]); w.y = pk2(v[8 * i + 2], v[8 * i + 3]); w.z = pk2(v[8 * i + 4], v[8 * i + 5]); w.w = pk2(v[8 * i + 6], v[8 * i + 7]); ((uint4*)dst)[i] = w; }
}

__device__ __forceinline__ void norm_mod_store(const float4 (&v)[4], float r, const float* gain, const float* m, unsigned char* ws_, int row, int lane) {
    uint2* hb = (uint2*)((bf16_t*)(ws_ + WS_H) + (size_t)row * D); int* ho = (int*)(ws_ + WS_H8 + (size_t)row * D);
#pragma unroll
    for (int i = 0; i < 4; ++i) { const int c4 = lane + 64 * i; const float4 g = ((const float4*)gain)[c4], sh = ((const float4*)m)[c4], sc = ((const float4*)(m + D))[c4];
        const float h0 = v[i].x * r * g.x * (1.f + sc.x) + sh.x, h1 = v[i].y * r * g.y * (1.f + sc.y) + sh.y, h2 = v[i].z * r * g.z * (1.f + sc.z) + sh.z, h3 = v[i].w * r * g.w * (1.f + sc.w) + sh.w;
        if (IP_S > 0) { uint2 o; o.x = pk2(h0, h1); o.y = pk2(h2, h3); hb[c4] = o; }
        if (IP_S < 27) { int w8 = __builtin_amdgcn_cvt_pk_fp8_f32(h0, h1, 0, false); w8 = __builtin_amdgcn_cvt_pk_fp8_f32(h2, h3, w8, true); ho[c4] = w8; } }
}
__device__ __forceinline__ void mod_item(const Ptrs& p, int item, int lane, const LAS float* sil) {
    const int l = item / (MODW / 32), cb = item % (MODW / 32), kq = lane >> 3, cq = lane & 7;
    const float* w = p.ada_w + (size_t)l * D * MODW + cb * 32 + cq * 4;
    float4 acc[9];
#pragma unroll
    for (int r = 0; r < 9; ++r) acc[r] = make_float4(0.f, 0.f, 0.f, 0.f);
#pragma unroll 16
    for (int k = kq; k < D; k += 8) { const float4 wv = *(const float4*)(w + (size_t)k * MODW);
#pragma unroll
        for (int r = 0; r < 9; ++r) { const float s = sil[r * D + k]; acc[r].x += s * wv.x; acc[r].y += s * wv.y; acc[r].z += s * wv.z; acc[r].w += s * wv.w; } }
#pragma unroll
    for (int r = 0; r < 9; ++r)
#pragma unroll
        for (int o = 8; o < 64; o <<= 1) { acc[r].x += lane_xor(acc[r].x, lane, o); acc[r].y += lane_xor(acc[r].y, lane, o); acc[r].z += lane_xor(acc[r].z, lane, o); acc[r].w += lane_xor(acc[r].w, lane, o); }
    if (kq == 0) { const float4 b = *(const float4*)(p.ada_b + l * MODW + cb * 32 + cq * 4);
#pragma unroll
        for (int r = 0; r < 9; ++r) *(float4*)((float*)(p.ws + WS_MOD) + ((size_t)l * 9 + r) * MODW + cb * 32 + cq * 4) = make_float4(acc[r].x + b.x, acc[r].y + b.y, acc[r].z + b.z, acc[r].w + b.w); }
}
__device__ __forceinline__ void conv_item4(const Ptrs& p, int layer, int item) {
    const int row0 = (item >> 6) * 4, c8 = (item & 63) * 8;
    const bf16_t* P = (const bf16_t*)(p.ws + WS_P); const float* w = p.conv_w + layer * 3 * 512 + c8;
    int t0, T; if (row0 < NLAT) { t0 = row0 % SEQ; T = SEQ; } else { t0 = (row0 - NLAT) % CTXL; T = CTXL; }
    const bf16_t* pr = P + (size_t)row0 * INC + c8;
    const uint4 z4 = make_uint4(0, 0, 0, 0);
    uint4 cc[6], cx[6], cb[4];
#pragma unroll
    for (int j = 0; j < 6; ++j) { const bool ok = (j > 0 || t0 > 0) && (j < 5 || t0 + 4 < T); cc[j] = ok ? *(const uint4*)(pr + (j - 1) * INC + O_CC) : z4; cx[j] = ok ? *(const uint4*)(pr + (j - 1) * INC + O_CX) : z4; }
#pragma unroll
    for (int j = 0; j < 4; ++j) cb[j] = *(const uint4*)(pr + j * INC + O_CB);
    float u[6][8];
#pragma unroll
    for (int j = 0; j < 6; ++j) { const unsigned a[4] = {cc[j].x, cc[j].y, cc[j].z, cc[j].w}, x[4] = {cx[j].x, cx[j].y, cx[j].z, cx[j].w};
#pragma unroll
        for (int q = 0; q < 4; ++q) { u[j][2 * q] = bf2f(a[q] & 0xffff) * bf2f(x[q] & 0xffff); u[j][2 * q + 1] = bf2f(a[q] >> 16) * bf2f(x[q] >> 16); } }
    float w0[8], w1[8], w2[8];
#pragma unroll
    for (int c = 0; c < 8; ++c) { w0[c] = w[c]; w1[c] = w[512 + c]; w2[c] = w[1024 + c]; }
#pragma unroll
    for (int j = 0; j < 4; ++j) { const unsigned bw[4] = {cb[j].x, cb[j].y, cb[j].z, cb[j].w}; unsigned o[4];
#pragma unroll
        for (int q = 0; q < 4; ++q) { const float r0 = bf2f(bw[q] & 0xffff) * (w0[2 * q] * u[j][2 * q] + w1[2 * q] * u[j + 1][2 * q] + w2[2 * q] * u[j + 2][2 * q]);
            const float r1 = bf2f(bw[q] >> 16) * (w0[2 * q + 1] * u[j][2 * q + 1] + w1[2 * q + 1] * u[j + 1][2 * q + 1] + w2[2 * q + 1] * u[j + 2][2 * q + 1]); o[q] = pk2(r0, r1); }
        *(uint4*)((bf16_t*)(p.ws + WS_Y) + (size_t)(row0 + j) * 1536 + c8) = make_uint4(o[0], o[1], o[2], o[3]); }
}
__device__ __forceinline__ void kprep_item(const Ptrs& p, int layer, int i) {
    const int row = i >> 1, kvh = i & 1;
    const bf16_t* pr = (const bf16_t*)(p.ws + WS_P) + (size_t)row * INC;
    int b, pos, t; if (row < NLAT) { b = row / SEQ; t = row % SEQ; pos = t; } else { b = (row - NLAT) / CTXL; t = 0; pos = SEQ + (row - NLAT) % CTXL; }
    float v[64]; load64(v, pr + O_GK + kvh * 64); head_norm_rope(v, p.k_norm_g + layer * 64, row < NLAT, t);
    const size_t o = (((size_t)b * KVLEN + pos) * 2 + kvh) * 64;
    store64((bf16_t*)(p.ws + WS_KG) + o, v);
    const uint4* s = (const uint4*)(pr + O_GV + kvh * 64); uint4* d = (uint4*)((bf16_t*)(p.ws + WS_VG) + o);
#pragma unroll
    for (int j = 0; j < 8; ++j) d[j] = s[j];
}
constexpr float ATT_C2 = 0.125f * 1.4426950408889634f;
__device__ __forceinline__ void qprep_item(const Ptrs& p, int layer, int i) {
    const int row = i >> 3, h = i & 7; bf16_t* pr = (bf16_t*)(p.ws + WS_P) + (size_t)row * INC;
    float v[64]; load64(v, pr + O_GQ + h * 64); head_norm_rope(v, p.q_norm_g + layer * 64, row < NLAT, row < NLAT ? row % SEQ : 0);
#pragma unroll
    for (int d = 0; d < 64; ++d) v[d] *= ATT_C2;
    store64(pr + O_GQ + h * 64, v);
}
#define ATT_STEP(kp, vp, bias) do { float kv_[64]; load64(kv_, kp); float s_ = 0.f; _Pragma("unroll") for (int d = 0; d < 64; ++d) s_ += q[d] * kv_[d]; s_ = s_ * 0.125f + (bias); \
    const float mn_ = fmaxf(mx, s_), cr_ = __expf(mx - mn_), pp_ = __expf(s_ - mn_); l = l * cr_ + pp_; mx = mn_; load64(kv_, vp); _Pragma("unroll") for (int d = 0; d < 64; ++d) o[d] = o[d] * cr_ + pp_ * kv_[d]; } while (0)
__device__ __forceinline__ void gqa_ref_item(const Ptrs& p, int layer, int i) {
    const int t = i & (SEQ - 1), h = (i >> 12) & 7, b = i >> 15, row = b * SEQ + t;
    float q[64]; load64(q, (const bf16_t*)(p.ws + WS_P) + (size_t)row * INC + O_GQ + h * 64); head_norm_rope(q, p.q_norm_g + layer * 64, true, t);
    float o[64]; float mx = -1e30f, l = 0.f;
#pragma unroll
    for (int d = 0; d < 64; ++d) o[d] = 0.f;
    const bf16_t* kb = (const bf16_t*)(p.ws + WS_KG) + ((size_t)b * KVLEN * 2 + (h >> 2)) * 64; const bf16_t* vb = (const bf16_t*)(p.ws + WS_VG) + ((size_t)b * KVLEN * 2 + (h >> 2)) * 64;
    for (int j = 0; j < KVLEN; ++j) ATT_STEP(kb + (size_t)j * 128, vb + (size_t)j * 128, 0.f);
    const float il = 1.f / l;
#pragma unroll
    for (int d = 0; d < 64; ++d) o[d] *= il;
    store64((bf16_t*)(p.ws + WS_Y) + (size_t)row * 1536 + 1024 + h * 64, o);
}
__device__ __forceinline__ void na_ref_item(const Ptrs& p, int layer, int i) {
    const int t = i & (SEQ - 1), h = (i >> 12) & 7, b = i >> 15, row = b * SEQ + t;
    const bf16_t* P = (const bf16_t*)(p.ws + WS_P);
    float q[64]; load64(q, P + (size_t)row * INC + O_NAQ + h * 64);
    float o[64]; float mx = -1e30f, l = 0.f;
#pragma unroll
    for (int d = 0; d < 64; ++d) o[d] = 0.f;
    const int r = t >> 6, c = t & 63; const int rs = min(max(r - 4, 0), 56), cs = min(max(c - 8, 0), 48);
    const float* rpb = p.na_rpb + ((size_t)layer * 8 + h) * 15 * 31;
    for (int ii = 0; ii < 8; ++ii) for (int j = 0; j < 16; ++j) { const int kr = rs + ii, kc = cs + j; const bf16_t* kp = P + (size_t)(b * SEQ + kr * 64 + kc) * INC;
        ATT_STEP(kp + O_NAK + h * 64, kp + O_NAV + h * 64, rpb[(kr - r + 7) * 31 + (kc - c + 15)]); }
    for (int j = 0; j < CTXL; ++j) { const bf16_t* kp = P + (size_t)(NLAT + b * CTXL + j) * INC; ATT_STEP(kp + O_NAK + h * 64, kp + O_NAV + h * 64, 0.f); }
    const float il = 1.f / l;
#pragma unroll
    for (int d = 0; d < 64; ++d) o[d] *= il;
    store64((bf16_t*)(p.ws + WS_Y) + (size_t)row * 1536 + 512 + h * 64, o);
}
__device__ __forceinline__ void ctx_ref_item(const Ptrs& p, int layer, int i, int which) {
    const int h = i & 7, cr = i >> 3, row = NLAT + cr, b = cr / CTXL; const bf16_t* P = (const bf16_t*)(p.ws + WS_P);
    float q[64]; float o[64]; float mx = -1e30f, l = 0.f;
#pragma unroll
    for (int d = 0; d < 64; ++d) o[d] = 0.f;
    if (which == 0) { load64(q, P + (size_t)row * INC + O_NAQ + h * 64);
        for (int j = 0; j < CTXL; ++j) { const bf16_t* kp = P + (size_t)(NLAT + b * CTXL + j) * INC; ATT_STEP(kp + O_NAK + h * 64, kp + O_NAV + h * 64, 0.f); } }
    else { load64(q, P + (size_t)row * INC + O_GQ + h * 64); head_norm_rope(q, p.q_norm_g + layer * 64, false, 0);
        const bf16_t* kb = (const bf16_t*)(p.ws + WS_KG) + (((size_t)b * KVLEN + SEQ) * 2 + (h >> 2)) * 64; const bf16_t* vb = (const bf16_t*)(p.ws + WS_VG) + (((size_t)b * KVLEN + SEQ) * 2 + (h >> 2)) * 64;
        for (int j = 0; j < CTXL; ++j) ATT_STEP(kb + (size_t)j * 128, vb + (size_t)j * 128, 0.f); }
    const float il = 1.f / l;
#pragma unroll
    for (int d = 0; d < 64; ++d) o[d] *= il;
    store64((bf16_t*)(p.ws + WS_Y) + (size_t)row * 1536 + (which ? 1024 : 512) + h * 64, o);
}
__device__ __forceinline__ unsigned top4_store(const Ptrs& p, int row, const float (&lg)[32]) {
    int ie[4]; float ve[4];
#pragma unroll
    for (int k = 0; k < 4; ++k) { float bv = -3.0e38f; int bi = 0;
#pragma unroll
        for (int e = 0; e < 32; ++e) { const bool taken = (k > 0 && ie[0] == e) || (k > 1 && ie[1] == e) || (k > 2 && ie[2] == e); if (!taken && lg[e] > bv) { bv = lg[e]; bi = e; } }
        ie[k] = bi; ve[k] = bv; }
    const float e0 = 1.f, e1 = expf(ve[1] - ve[0]), e2 = expf(ve[2] - ve[0]), e3 = expf(ve[3] - ve[0]), is = 1.f / (e0 + e1 + e2 + e3);
    ((int4*)(p.ws + WS_TOKE))[row] = make_int4(ie[0], ie[1], ie[2], ie[3]); ((float4*)(p.ws + WS_TOKG))[row] = make_float4(e0 * is, e1 * is, e2 * is, e3 * is);
    return (unsigned)ie[0] | ((unsigned)ie[1] << 8) | ((unsigned)ie[2] << 16) | ((unsigned)ie[3] << 24);
}
template <int NR>
__device__ __forceinline__ void combine_rows(const Ptrs& p, int layer, int mode, int row0, int stride, int nrows, int lane, float gmul = 1.f) {
    typedef float v2f_ __attribute__((ext_vector_type(2)));
    int4 sl[NR]; float4 gg[NR]; unsigned yv[NR][4][4]; uint2 xv[NR][4];
#pragma unroll
    for (int q = 0; q < NR; ++q) { const int row = min(row0 + q * stride, nrows - 1); sl[q] = ((const int4*)(p.ws + WS_TOKS))[row]; gg[q] = ((const float4*)(p.ws + WS_TOKG))[row]; }
#pragma unroll
    for (int q = 0; q < NR; ++q) { const int row = min(row0 + q * stride, nrows - 1); const int sls[4] = {sl[q].x, sl[q].y, sl[q].z, sl[q].w}; const uint2* xr = (const uint2*)((const bf16_t*)(p.ws + WS_X) + (size_t)row * D);
#pragma unroll
        for (int i = 0; i < 4; ++i) { xv[q][i] = xr[lane + 64 * i];
#pragma unroll
            for (int k = 0; k < 4; ++k) yv[q][i][k] = ((const unsigned*)(p.ws + WS_YB + (size_t)sls[k] * D))[lane + 64 * i]; } }
#pragma unroll
    for (int q = 0; q < NR; ++q) { const int row = row0 + q * stride; if (row >= nrows) continue;
        const float gs[4] = {gg[q].x * (1.f / YB_SCALE), gg[q].y * (1.f / YB_SCALE), gg[q].z * (1.f / YB_SCALE), gg[q].w * (1.f / YB_SCALE)};
        uint2* xr = (uint2*)((bf16_t*)(p.ws + WS_X) + (size_t)row * D);
        const float* ml = (const float*)(p.ws + WS_MOD) + ((size_t)layer * 9 + mod_row(row)) * MODW;
        float4 v[4]; float ss = 0.f;
#pragma unroll
        for (int i = 0; i < 4; ++i) { const int c4 = lane + 64 * i; float4 a = make_float4(0, 0, 0, 0);
#pragma unroll
            for (int k = 0; k < 4; ++k) { const int w = (int)yv[q][i][k]; const v2f_ y01 = __builtin_amdgcn_cvt_pk_f32_fp8(w, false), y23 = __builtin_amdgcn_cvt_pk_f32_fp8(w, true);
                a.x += gs[k] * y01[0]; a.y += gs[k] * y01[1]; a.z += gs[k] * y23[0]; a.w += gs[k] * y23[1]; }
            const float4 g2 = ((const float4*)(ml + 5 * D))[c4]; const uint2 xw_ = xv[q][i]; float4 x = make_float4(bf2f(xw_.x & 0xffff), bf2f(xw_.x >> 16), bf2f(xw_.y & 0xffff), bf2f(xw_.y >> 16));
            x.x += gmul * g2.x * a.x; x.y += gmul * g2.y * a.y; x.z += gmul * g2.z * a.z; x.w += gmul * g2.w * a.w; v[i] = x; ss += x.x * x.x + x.y * x.y + x.z * x.z + x.w * x.w; }
        const float r = rsqrtf(wave_sum(ss, lane) * (1.f / D) + EPS);
        if (mode == 0) {
#pragma unroll
            for (int i = 0; i < 4; ++i) xr[lane + 64 * i] = make_uint2(pk2(v[i].x, v[i].y), pk2(v[i].z, v[i].w));
            norm_mod_store(v, r, p.norm1_g + (layer + 1) * D, (const float*)(p.ws + WS_MOD) + ((size_t)(layer + 1) * 9 + mod_row(row)) * MODW, p.ws, row, lane);
        } else {
            float4* orow = (float4*)(p.out + (size_t)row * D);
#pragma unroll
            for (int i = 0; i < 4; ++i) { const int c4 = lane + 64 * i; const float4 g = ((const float4*)p.final_g)[c4]; orow[c4] = make_float4(v[i].x * r * g.x, v[i].y * r * g.y, v[i].z * r * g.z, v[i].w * r * g.w); }
        }
    }
}

namespace pg8 {
typedef short bf16x8 __attribute__((ext_vector_type(8)));
typedef float f32x4 __attribute__((ext_vector_type(4)));
typedef unsigned u32x4 __attribute__((ext_vector_type(4)));
typedef unsigned u32x2 __attribute__((ext_vector_type(2)));
typedef int v4i __attribute__((ext_vector_type(4)));
typedef int v8i __attribute__((ext_vector_type(8)));
#ifndef PG8_WGM
#define PG8_WGM 8
#endif
constexpr int BM = 256, BK = 64, HALF = 128, HTB = HALF * BK * 2, STAGE_BYTES = 8 * HTB, NXCD = 8, WGM = PG8_WGM;
__host__ __device__ __forceinline__ int lds_byte(int r, int c) { const int st = (r >> 4) * 2 + (c >> 5), rr = r & 15, cc = c & 31, ob = rr * 64 + cc * 2; return st * 1024 + (ob ^ (((ob >> 9) & 1) << 5)); }
__host__ __device__ __forceinline__ void stage_rc(int b, int& R, int& C) { const int st = b / 1024, sb = b % 1024, swz = sb ^ (((sb >> 9) & 1) << 5); R = (st >> 1) * 16 + swz / 64; C = (st & 1) * 32 + (swz % 64) / 2; }
__host__ __device__ __forceinline__ int perm32(int rho) { const int n = rho >> 4, i = rho & 15; return 8 * (i >> 2) + 4 * n + (i & 3); }
struct Unit { int pm, pn, z, hf; };
struct Gemm { int Kb, lda, ldb; int scaleA, scaleB; };
__device__ __forceinline__ bool tile_order(int L, int nM, int nN, int& pm, int& pn) {
    const int nwg = nM * nN; if (L >= nwg) return false;
    int wgid = L; { const int q = nwg / NXCD, r = nwg % NXCD, xcd = wgid % NXCD, off = wgid / NXCD; wgid = (xcd < r ? xcd * (q + 1) : r * (q + 1) + (xcd - r) * q) + off; }
    const int nig = WGM * nN, gid = wgid / nig, fm = gid * WGM, gsz = (nM - fm) < WGM ? (nM - fm) : WGM;
    pm = fm + ((wgid % nig) % gsz); pn = (wgid % nig) / gsz; return true;
}
__device__ __forceinline__ unsigned cvt_pk_bf16(float lo, float hi) { unsigned r; asm volatile("v_cvt_pk_bf16_f32 %0, %1, %2" : "=v"(r) : "v"(lo), "v"(hi)); return r; }
__device__ __forceinline__ float fast_sigmoid(float v) { return __builtin_amdgcn_rcpf(1.f + __builtin_amdgcn_exp2f(-1.4426950408889634f * v)); }

template <class Epi, class Sched, bool ALIGN_EPI, bool SP2, bool FP8 = false, bool GATHER = false, bool HALFU = false>
__device__ __forceinline__ void gemm_phase(LAS unsigned char* lds, const Gemm g, const Sched& S, const Epi& E, int wvid, const int* gtab = nullptr, LAS int* ltab = nullptr, LAS float* lbias = nullptr) {
    const int tid_ = opaque_tid(wvid);
    const int tid = tid_, wid = __builtin_amdgcn_readfirstlane(tid >> 6), lane = tid & 63, wr = wid >> 2, wc = wid & 3, fr = lane & 15, fq = lane >> 4;
    const int nt = g.Kb / (BK * 2);
    unsigned voffA[2], voffB[2];
#pragma unroll
    for (int i = 0; i < 2; ++i) { int R, C; stage_rc(tid * 16 + i * 8192, R, C); const int Rb = Epi::PERM ? ((R & ~31) + perm32(R & 31)) : R;
        voffA[i] = (unsigned)(R * g.lda + C * 2); voffB[i] = (unsigned)(Rb * g.ldb + C * 2); }
    const size_t kstep = (size_t)(BK * 2);
    const size_t hstepA = (size_t)HALF * g.lda, hstepB = (size_t)HALF * g.ldb;
    const unsigned ldsw = (unsigned)wid * 1024u;
    const int aoff = lds_byte(wr * 64 + fr, fq * 8), boff = lds_byte(wc * 32 + fr, fq * 8);
#define PG8_SA(b, h) (((b) * 2 + (h)) * HTB)
#define PG8_SB(b, h) ((4 + (b) * 2 + (h)) * HTB)
#define PG8_STAGE(bufoff, gbase, voff) do { _Pragma("unroll") for (int _i = 0; _i < 2; ++_i) \
        __builtin_amdgcn_global_load_lds((const unsigned*)((const char*)(gbase) + (voff)[_i]), (LAS unsigned*)(lds + (bufoff) + ldsw + _i * 8192), 16, 0, 0); } while (0)
    unsigned vgC[2], vgN[2], gc2 = 0; (void)vgC; (void)vgN; (void)gc2;
    if constexpr (GATHER) { int R0_, C0_, R1_, C1_; stage_rc(tid * 16, R0_, C0_); stage_rc(tid * 16 + 8192, R1_, C1_); gc2 = (unsigned)(C0_ * 2) | ((unsigned)(C1_ * 2) << 8); }
#define PG8_GTAB_FETCH(u, buf) do { if (wid == 7) { int ln_; asm volatile("v_mbcnt_lo_u32_b32 %0, -1, 0\n\tv_mbcnt_hi_u32_b32 %0, -1, %0" : "=v"(ln_));   \
        __builtin_amdgcn_global_load_lds((const unsigned*)(gtab + (size_t)(u).pm * BM + ln_ * 4), (LAS unsigned*)(ltab + (buf) * BM), 16, 0, 0); } } while (0)
#define PG8_GTAB_READ(dst, buf) do { int tq_; asm volatile("v_mbcnt_lo_u32_b32 %0, -1, 0\n\tv_mbcnt_hi_u32_b32 %0, -1, %0" : "=v"(tq_)); tq_ += wid * 64;   \
        int Ra_, Ca_, Rb_, Cb_; stage_rc(tq_ * 16, Ra_, Ca_); stage_rc(tq_ * 16 + 8192, Rb_, Cb_); \
        _Pragma("unroll") for (int h_ = 0; h_ < 2; ++h_) dst[h_] = (unsigned)ltab[(buf) * BM + Ra_ + HALF * h_] | ((unsigned)ltab[(buf) * BM + Rb_ + HALF * h_] << 16); } while (0)
#define PG8_STAGE_A(bufoff, ptr, h, nx) do { if constexpr (GATHER) { const unsigned pk_ = (nx) ? vgN[h] : vgC[h]; unsigned vo_[2] = {(pk_ & 0xffffu) * (unsigned)g.lda + (gc2 & 0xffu), (pk_ >> 16) * (unsigned)g.lda + (gc2 >> 8)}; PG8_STAGE(bufoff, ptr, vo_); } \
        else PG8_STAGE(bufoff, (ptr) + (h) * hstepA, voffA); } while (0)
#define PG8_LD16(off) (*(const LAS v4i*)(lds + (off)))
#define PG8_LDA(dst, b, h) do { _Pragma("unroll") for (int m = 0; m < 4; ++m) { \
        if constexpr (FP8) dst##q[m] = __builtin_shufflevector(PG8_LD16(PG8_SA(b, h) + aoff + m * 2048), PG8_LD16(PG8_SA(b, h) + aoff + m * 2048 + 1024), 0, 1, 2, 3, 4, 5, 6, 7); \
        else { _Pragma("unroll") for (int k = 0; k < 2; ++k) dst[m][k] = *(const LAS bf16x8*)(lds + PG8_SA(b, h) + aoff + m * 2048 + k * 1024); } } } while (0)
#define PG8_LDB(dst, b, h) do { _Pragma("unroll") for (int n = 0; n < 2; ++n) { \
        if constexpr (FP8) dst##q[n] = __builtin_shufflevector(PG8_LD16(PG8_SB(b, h) + boff + n * 2048), PG8_LD16(PG8_SB(b, h) + boff + n * 2048 + 1024), 0, 1, 2, 3, 4, 5, 6, 7); \
        else { _Pragma("unroll") for (int k = 0; k < 2; ++k) dst[n][k] = *(const LAS bf16x8*)(lds + PG8_SB(b, h) + boff + n * 2048 + k * 1024); } } } while (0)
#define PG8_MMA(ai, bj, At, Bt) do { __builtin_amdgcn_s_setprio(1); _Pragma("unroll") for (int m = 0; m < 4; ++m) _Pragma("unroll") for (int n = 0; n < 2; ++n) { \
        if constexpr (FP8)   \
            asm volatile("v_mfma_scale_f32_16x16x128_f8f6f4 %0, %1, %2, %0, %3, %4 op_sel_hi:[0,0,0]" : "+v"(acc[ai][bj][m][n]) : "v"(Bt##q[n]), "v"(At##q[m]), "v"(scB_), "v"(scA_));   \
        else { _Pragma("unroll") for (int k = 0; k < 2; ++k) acc[ai][bj][m][n] = __builtin_amdgcn_mfma_f32_16x16x32_bf16(Bt[n][k], At[m][k], acc[ai][bj][m][n], 0, 0, 0); } } \
        __builtin_amdgcn_s_setprio(0); } while (0)
#define PG8_WAIT_V(n) asm volatile("s_waitcnt vmcnt(" #n ")" ::: "memory")
#define PG8_WAIT_L(n) asm volatile("s_waitcnt lgkmcnt(" #n ")" ::: "memory")
#define PG8_BAR __builtin_amdgcn_s_barrier()
#define PG8_SCHED __builtin_amdgcn_sched_barrier(0)
    Unit cur, nxt; int ui = 0;
    if (!S.next(0, cur)) return;
    f32x4 acc[2][2][4][2];
    float z0_; asm volatile("v_mov_b32 %0, 0" : "=v"(z0_));
#pragma unroll
    for (int a = 0; a < 2; ++a)
#pragma unroll
        for (int b = 0; b < 2; ++b)
#pragma unroll
            for (int m = 0; m < 4; ++m)
#pragma unroll
                for (int n = 0; n < 2; ++n) acc[a][b][m][n] = (f32x4){0.f, 0.f, 0.f, 0.f};
    const int scA_ = g.scaleA, scB_ = g.scaleB; (void)scA_; (void)scB_;
    const char* cA = S.a_ptr(cur); const char* cB = S.b_ptr(cur);
#define PG8_BIAS_FETCH(u, buf) do { if constexpr (Epi::BIAS_LDS) { if (wid == 6) { int lb_; asm volatile("v_mbcnt_lo_u32_b32 %0, -1, 0\n\tv_mbcnt_hi_u32_b32 %0, -1, %0" : "=v"(lb_));   \
        __builtin_amdgcn_global_load_lds((const unsigned*)(E.bias_src(u) + lb_ * 4), (LAS unsigned*)(lbias + (buf) * BM), 16, 0, 0); } } } while (0)
    PG8_BIAS_FETCH(cur, 0);
    if constexpr (GATHER) { PG8_GTAB_FETCH(cur, 0); PG8_WAIT_V(0); PG8_BAR; PG8_GTAB_READ(vgC, 0); }
    if constexpr (SP2) {
        PG8_STAGE(PG8_SB(0, 0), cB, voffB); PG8_STAGE(PG8_SB(0, 1), cB + hstepB, voffB); PG8_STAGE_A(PG8_SA(0, 0), cA, 0, false); PG8_STAGE_A(PG8_SA(0, 1), cA, 1, false);
        if (wr == 1) PG8_BAR;
        PG8_WAIT_V(2); PG8_BAR;
        PG8_STAGE(PG8_SB(1, 0), cB + kstep, voffB); PG8_STAGE_A(PG8_SA(1, 0), cA + kstep, 0, false); PG8_STAGE(PG8_SB(1, 1), cB + hstepB + kstep, voffB);
        PG8_WAIT_V(6); PG8_BAR;
    } else {
        PG8_STAGE(PG8_SB(0, 0), cB, voffB); PG8_STAGE(PG8_SA(0, 0), cA, voffA); PG8_STAGE(PG8_SB(0, 1), cB + hstepB, voffB); PG8_STAGE(PG8_SA(0, 1), cA + hstepA, voffA);
        if (wr == 1) PG8_BAR;
        PG8_WAIT_V(4); PG8_BAR;
        PG8_STAGE(PG8_SB(1, 0), cB + kstep, voffB); PG8_STAGE_A(PG8_SA(1, 0), cA + kstep, 0, false); PG8_STAGE(PG8_SB(1, 1), cB + hstepB + kstep, voffB);
        PG8_WAIT_V(6); PG8_BAR;
    }
    for (;;) {
        const bool has_next = S.next(ui + 1, nxt);
        const char* nA = has_next ? S.a_ptr(nxt) : cA; const char* nB = has_next ? S.b_ptr(nxt) : cB;
        if constexpr (GATHER) { if (has_next) PG8_GTAB_FETCH(nxt, (ui + 1) & 1); }
        if (ui > 0) PG8_BIAS_FETCH(cur, ui & 1);
        const bool hu = HALFU && cur.hf != 0;
        for (int t = 0; t < nt; t += 2) {
            const bool last = (t == nt - 2);
            if constexpr (GATHER) { if (last && has_next) PG8_GTAB_READ(vgN, (ui + 1) & 1); }
            const char* a1 = cA + (size_t)(t + 1) * kstep;
            const char* a2 = last ? nA : cA + (size_t)(t + 2) * kstep; const char* b2 = last ? nB : cB + (size_t)(t + 2) * kstep;
            const char* a3 = a2 + kstep; const char* b3 = b2 + kstep;
            bf16x8 At[4][2], B0[2][2], B1[2][2]; v8i Atq[4], B0q[2], B1q[2]; (void)At; (void)B0; (void)B1; (void)Atq; (void)B0q; (void)B1q;
            if constexpr (SP2) {
            PG8_LDB(B0, 0, 0); PG8_LDB(B1, 0, 1); PG8_SCHED; PG8_LDA(At, 0, 0); PG8_STAGE_A(PG8_SA(1, 1), a1, 1, false);
            PG8_WAIT_V(8); PG8_WAIT_L(0); PG8_BAR; PG8_MMA(0, 0, At, B0); PG8_MMA(0, 1, At, B1); PG8_BAR; PG8_SCHED;
            if (!hu) PG8_LDA(At, 0, 1); PG8_STAGE(PG8_SB(0, 0), b2, voffB); PG8_STAGE(PG8_SB(0, 1), b2 + hstepB, voffB); PG8_STAGE_A(PG8_SA(0, 0), a2, 0, last);
            PG8_WAIT_V(8); PG8_WAIT_L(0); PG8_BAR; if (!hu) { PG8_MMA(1, 0, At, B0); PG8_MMA(1, 1, At, B1); } PG8_BAR; PG8_SCHED;
            PG8_LDB(B0, 1, 0); PG8_LDB(B1, 1, 1); PG8_SCHED; PG8_LDA(At, 1, 0); PG8_STAGE_A(PG8_SA(0, 1), a2, 1, last);
            PG8_WAIT_V(8); PG8_WAIT_L(0); PG8_BAR; PG8_MMA(0, 0, At, B0); PG8_MMA(0, 1, At, B1); PG8_BAR; PG8_SCHED;
            if (!hu) PG8_LDA(At, 1, 1); PG8_STAGE(PG8_SB(1, 0), b3, voffB); PG8_STAGE(PG8_SB(1, 1), b3 + hstepB, voffB); PG8_STAGE_A(PG8_SA(1, 0), a3, 0, last);
            PG8_WAIT_V(8); PG8_WAIT_L(0); PG8_BAR; if (!hu) { PG8_MMA(1, 0, At, B0); PG8_MMA(1, 1, At, B1); } PG8_BAR; PG8_SCHED;
            } else {
            PG8_LDB(B0, 0, 0); PG8_SCHED; PG8_LDA(At, 0, 0); PG8_STAGE_A(PG8_SA(1, 1), a1, 1, false);
            PG8_WAIT_L(8); PG8_BAR; PG8_WAIT_L(0); PG8_MMA(0, 0, At, B0); PG8_BAR; PG8_SCHED;
            PG8_LDB(B1, 0, 1); PG8_STAGE(PG8_SB(0, 0), b2, voffB);
            PG8_BAR; PG8_WAIT_L(0); PG8_MMA(0, 1, At, B1); PG8_BAR;
            PG8_LDA(At, 0, 1); PG8_STAGE_A(PG8_SA(0, 0), a2, 0, last);
            PG8_BAR; PG8_WAIT_L(0); PG8_MMA(1, 0, At, B0); PG8_BAR; PG8_SCHED;
            PG8_STAGE(PG8_SB(0, 1), b2 + hstepB, voffB);
            PG8_WAIT_V(6); PG8_BAR; PG8_MMA(1, 1, At, B1); PG8_BAR;
            PG8_LDB(B0, 1, 0); PG8_SCHED; PG8_LDA(At, 1, 0); PG8_STAGE_A(PG8_SA(0, 1), a2, 1, last);
            PG8_WAIT_L(8); PG8_BAR; PG8_WAIT_L(0); PG8_MMA(0, 0, At, B0); PG8_BAR; PG8_SCHED;
            PG8_LDB(B1, 1, 1); PG8_STAGE(PG8_SB(1, 0), b3, voffB);
            PG8_BAR; PG8_WAIT_L(0); PG8_MMA(0, 1, At, B1); PG8_BAR;
            PG8_LDA(At, 1, 1); PG8_STAGE_A(PG8_SA(1, 0), a3, 0, last);
            PG8_BAR; PG8_WAIT_L(0); PG8_MMA(1, 0, At, B0); PG8_BAR; PG8_SCHED;
            PG8_STAGE(PG8_SB(1, 1), b3 + hstepB, voffB);
            PG8_WAIT_V(6); PG8_BAR; PG8_MMA(1, 1, At, B1); PG8_BAR;
            }
        }
        if constexpr (ALIGN_EPI) { if (wr == 0) PG8_BAR; }
        if constexpr (FP8) asm volatile("s_nop 15\n\ts_nop 15" ::: "memory");
        bool keep_ = false; if constexpr (Epi::CHAIN) keep_ = E.chain(acc, cur, wr, wc, fr, fq); else if constexpr (Epi::BIAS_LDS) E(acc, cur, wr, wc, fr, fq, lbias + (ui & 1) * BM); else E(acc, cur, wr, wc, fr, fq);
        if (!has_next) break;
        if (!keep_) {
#pragma unroll
        for (int a = 0; a < 2; ++a)
#pragma unroll
            for (int b = 0; b < 2; ++b)
#pragma unroll
                for (int m = 0; m < 4; ++m)
#pragma unroll
                    for (int n = 0; n < 2; ++n) acc[a][b][m][n] = (f32x4){z0_, z0_, z0_, z0_};
        }
        cur = nxt; cA = nA; cB = nB; ++ui;
        if constexpr (GATHER) {
#pragma unroll
            for (int h_ = 0; h_ < 2; ++h_) vgC[h_] = vgN[h_]; }
        if constexpr (ALIGN_EPI) { if (wr == 1) PG8_BAR; }
    }
    PG8_WAIT_V(0);
    if constexpr (!ALIGN_EPI) { if (wr == 0) PG8_BAR; }
    PG8_BAR;
#undef PG8_SA
#undef PG8_SB
#undef PG8_STAGE
#undef PG8_LDA
#undef PG8_LD16
#undef PG8_STAGE_A
#undef PG8_GTAB_FETCH
#undef PG8_GTAB_READ
#undef PG8_BIAS_FETCH
#undef PG8_LDB
#undef PG8_MMA
#undef PG8_WAIT_V
#undef PG8_WAIT_L
#undef PG8_BAR
#undef PG8_SCHED
}

template <bool HAS_BIAS> struct EpiStoreBf16 {
    static constexpr bool PERM = true, CHAIN = false, BIAS_LDS = HAS_BIAS;
    bf16_t* O; int ldc; const float* bias; int bias_stride; float scale; int sc_lo, sc_hi, ex_lo;
    __device__ __forceinline__ const float* bias_src(const Unit& u) const { return bias + (size_t)u.z * bias_stride + u.pn * BM; }
    __device__ __forceinline__ void operator()(const f32x4 (&acc)[2][2][4][2], const Unit& u, int wr, int wc, int fr, int fq, const LAS float* lb = nullptr) const {
        const int row0 = u.pm * BM + wr * 64 + fr, col0 = u.pn * BM + wc * 32 + 8 * fq; const float sc = (u.pn >= sc_lo && u.pn < sc_hi) ? scale : 1.f;
        f32x4 bv[2][2];
#pragma unroll
        for (int bj = 0; bj < 2; ++bj)
#pragma unroll
            for (int n = 0; n < 2; ++n) { if constexpr (HAS_BIAS) bv[bj][n] = *(const LAS f32x4*)(lb + wc * 32 + 8 * fq + bj * HALF + 4 * n); }
#pragma unroll
        for (int ai = 0; ai < 2; ++ai)
#pragma unroll
            for (int m = 0; m < 4; ++m) { bf16_t* rowp = O + (size_t)(row0 + ai * HALF + m * 16) * ldc + col0;
#pragma unroll
                for (int bj = 0; bj < 2; ++bj) { f32x4 v0 = acc[ai][bj][m][0], v1 = acc[ai][bj][m][1]; if constexpr (HAS_BIAS) { v0 += bv[bj][0]; v1 += bv[bj][1]; } v0 *= sc; v1 *= sc;
                    if (u.pn >= ex_lo) {
#pragma unroll
                        for (int j = 0; j < 4; ++j) { v0[j] = __builtin_amdgcn_exp2f(fminf(-1.4426950408889634f * v0[j], 8.75f)); v1[j] = __builtin_amdgcn_exp2f(fminf(-1.4426950408889634f * v1[j], 8.75f)); }
                        int lo = __builtin_amdgcn_cvt_pk_fp8_f32(v0[0], v0[1], 0, false); lo = __builtin_amdgcn_cvt_pk_fp8_f32(v0[2], v0[3], lo, true);
                        int hi = __builtin_amdgcn_cvt_pk_fp8_f32(v1[0], v1[1], 0, false); hi = __builtin_amdgcn_cvt_pk_fp8_f32(v1[2], v1[3], hi, true);
                        *(u32x2*)((unsigned char*)(rowp - col0) + ex_lo * BM * 2 + (col0 - ex_lo * BM) + bj * HALF) = (u32x2){(unsigned)lo, (unsigned)hi}; }
                    else { u32x4 w; w.x = cvt_pk_bf16(v0[0], v0[1]); w.y = cvt_pk_bf16(v0[2], v0[3]); w.z = cvt_pk_bf16(v1[0], v1[1]); w.w = cvt_pk_bf16(v1[2], v1[3]);
                        *(u32x4*)(rowp + bj * HALF) = w; } } }
    }
};
struct EpiStoreF8 {
    static constexpr bool PERM = true, CHAIN = false, BIAS_LDS = true;
    unsigned char* O; int ldc; const float* bias; int bias_stride; float scale;
    __device__ __forceinline__ const float* bias_src(const Unit& u) const { return bias + (size_t)u.z * bias_stride + u.pn * BM; }
    __device__ __forceinline__ void operator()(const f32x4 (&acc)[2][2][4][2], const Unit& u, int wr, int wc, int fr, int fq, const LAS float* lb) const {
        const int row0 = u.pm * BM + wr * 64 + fr, col0 = u.pn * BM + wc * 32 + 8 * fq;
        f32x4 bv[2][2];
#pragma unroll
        for (int bj = 0; bj < 2; ++bj)
#pragma unroll
            for (int n = 0; n < 2; ++n) bv[bj][n] = *(const LAS f32x4*)(lb + wc * 32 + 8 * fq + bj * HALF + 4 * n);
#pragma unroll
        for (int ai = 0; ai < 2; ++ai)
#pragma unroll
            for (int m = 0; m < 4; ++m) { unsigned char* rowp = O + (size_t)(row0 + ai * HALF + m * 16) * ldc + col0;
#pragma unroll
                for (int bj = 0; bj < 2; ++bj) { const f32x4 v0 = (acc[ai][bj][m][0] + bv[bj][0]) * scale, v1 = (acc[ai][bj][m][1] + bv[bj][1]) * scale;
                    int lo = __builtin_amdgcn_cvt_pk_fp8_f32(v0[0], v0[1], 0, false); lo = __builtin_amdgcn_cvt_pk_fp8_f32(v0[2], v0[3], lo, true);
                    int hi = __builtin_amdgcn_cvt_pk_fp8_f32(v1[0], v1[1], 0, false); hi = __builtin_amdgcn_cvt_pk_fp8_f32(v1[2], v1[3], hi, true);
                    *(u32x2*)(rowp + bj * HALF) = (u32x2){(unsigned)lo, (unsigned)hi}; } }
    }
};
struct EpiMergeF {
    static constexpr bool PERM = true, CHAIN = true, BIAS_LDS = false;
    const bf16_t* P; bf16_t* Mo;
    __device__ __forceinline__ bool chain(f32x4 (&acc)[2][2][4][2], const Unit& u, int wr, int wc, int fr, int fq) const {
        const int row0 = u.pm * BM + (u.hf == 2 ? HALF : 0) + wr * 64 + fr, col0 = u.pn * BM + wc * 32 + 8 * fq; const int ga = (u.z == 0 ? O_BGC : u.z == 1 ? O_BGN : O_BGG) + col0, gb = (u.z == 0 ? O_BGN : O_BGG) + col0;
        const bool last = (u.z == 2);
#pragma unroll
        for (int ai = 0; ai < 2; ++ai) { if (ai == 1 && u.hf != 0) break;
            u32x2 wa[4][2], wb[4][2];
#pragma unroll
            for (int m = 0; m < 4; ++m) { const unsigned char* gp = (const unsigned char*)(P + (size_t)(row0 + ai * HALF + m * 16) * INC + O_BGC);
#pragma unroll
                for (int bj = 0; bj < 2; ++bj) { wa[m][bj] = *(const u32x2*)(gp + (ga - O_BGC) + bj * HALF); wb[m][bj] = last ? wa[m][bj] : *(const u32x2*)(gp + (gb - O_BGC) + bj * HALF); } }
            asm volatile("" ::: "memory");
#pragma unroll
            for (int m = 0; m < 4; ++m) { const size_t row = (size_t)(row0 + ai * HALF + m * 16);
#pragma unroll
                for (int bj = 0; bj < 2; ++bj) { typedef float v2f_ __attribute__((ext_vector_type(2))); float f[8];
#pragma unroll
                    for (int j = 0; j < 2; ++j) { const int w = (int)(j ? wa[m][bj].y : wa[m][bj].x); const v2f_ e01 = __builtin_amdgcn_cvt_pk_f32_fp8(w, false), e23 = __builtin_amdgcn_cvt_pk_f32_fp8(w, true);
                        f[4 * j] = __builtin_amdgcn_rcpf(1.f + e01[0]); f[4 * j + 1] = __builtin_amdgcn_rcpf(1.f + e01[1]); f[4 * j + 2] = __builtin_amdgcn_rcpf(1.f + e23[0]); f[4 * j + 3] = __builtin_amdgcn_rcpf(1.f + e23[1]); }
                    if (!last) {
#pragma unroll
                        for (int j = 0; j < 2; ++j) { const int w = (int)(j ? wb[m][bj].y : wb[m][bj].x); const v2f_ e01 = __builtin_amdgcn_cvt_pk_f32_fp8(w, false), e23 = __builtin_amdgcn_cvt_pk_f32_fp8(w, true);
                            f[4 * j] *= 1.f + e01[0]; f[4 * j + 1] *= 1.f + e01[1]; f[4 * j + 2] *= 1.f + e23[0]; f[4 * j + 3] *= 1.f + e23[1]; } }
                    f32x4& a0 = acc[ai][bj][m][0]; f32x4& a1 = acc[ai][bj][m][1];
                    a0[0] *= f[0]; a0[1] *= f[1]; a0[2] *= f[2]; a0[3] *= f[3]; a1[0] *= f[4]; a1[1] *= f[5]; a1[2] *= f[6]; a1[3] *= f[7];
                    if (last) { u32x4 w; w.x = cvt_pk_bf16(a0[0], a0[1]); w.y = cvt_pk_bf16(a0[2], a0[3]); w.z = cvt_pk_bf16(a1[0], a1[1]); w.w = cvt_pk_bf16(a1[2], a1[3]);
                        *(u32x4*)(Mo + row * D + col0 + bj * HALF) = w; } } }
        }
        return !last;
    }
};
struct EpiNull { static constexpr bool PERM = true, CHAIN = false, BIAS_LDS = false; float* sink;
    __device__ __forceinline__ void operator()(const f32x4 (&acc)[2][2][4][2], const Unit& u, int wr, int wc, int fr, int fq) const { float s = 0.f;
#pragma unroll
        for (int a = 0; a < 2; ++a)
#pragma unroll
            for (int b = 0; b < 2; ++b)
#pragma unroll
                for (int m = 0; m < 4; ++m)
#pragma unroll
                    for (int n = 0; n < 2; ++n) s += acc[a][b][m][n][0];
        if (s == 1.2345e30f) sink[0] = s; } };
struct EpiOutF {
    static constexpr bool PERM = true, CHAIN = false, BIAS_LDS = false;
    bf16_t* X; const float* modl; float gmul;
    __device__ __forceinline__ void operator()(const f32x4 (&acc)[2][2][4][2], const Unit& u, int wr, int wc, int fr, int fq) const {
        const int row0 = u.pm * BM + (u.hf == 2 ? HALF : 0) + wr * 64 + fr, col0 = u.pn * BM + wc * 32 + 8 * fq; const bool lat = u.pm < NLAT / BM; const int mr = lat ? u.pm / (SEQ / BM) : 8;
        const float* gt = modl + (size_t)mr * MODW + 2 * D + col0;
        f32x4 gv[2][2];
#pragma unroll
        for (int bj = 0; bj < 2; ++bj)
#pragma unroll
            for (int n = 0; n < 2; ++n) gv[bj][n] = *(const f32x4*)(gt + bj * HALF + n * 4) * gmul;
#pragma unroll
        for (int ai = 0; ai < 2; ++ai) { if (ai == 1 && u.hf != 0) break;
            u32x4 xb[4][2];
#pragma unroll
            for (int m = 0; m < 4; ++m) { const bf16_t* srcp = X + (size_t)row0 * D + (size_t)(ai * HALF + m * 16) * D + col0;
#pragma unroll
                for (int bj = 0; bj < 2; ++bj) xb[m][bj] = *(const u32x4*)(srcp + bj * HALF); }
            asm volatile("" ::: "memory");
#pragma unroll
            for (int m = 0; m < 4; ++m) { bf16_t* rowp = X + (size_t)row0 * D + (size_t)(ai * HALF + m * 16) * D + col0;
#pragma unroll
                for (int bj = 0; bj < 2; ++bj) { const u32x4 w = xb[m][bj];
                    const f32x4 x0 = {bf2f(w.x & 0xffff), bf2f(w.x >> 16), bf2f(w.y & 0xffff), bf2f(w.y >> 16)}, x1 = {bf2f(w.z & 0xffff), bf2f(w.z >> 16), bf2f(w.w & 0xffff), bf2f(w.w >> 16)};
                    const f32x4 o0 = x0 + gv[bj][0] * acc[ai][bj][m][0], o1 = x1 + gv[bj][1] * acc[ai][bj][m][1];
                    *(u32x4*)(rowp + bj * HALF) = (u32x4){cvt_pk_bf16(o0[0], o0[1]), cvt_pk_bf16(o0[2], o0[3]), cvt_pk_bf16(o1[0], o1[1]), cvt_pk_bf16(o1[2], o1[3])}; } }
        }
    }
};
struct EpiGUF {
    static constexpr bool PERM = true, CHAIN = false, BIAS_LDS = true;
    unsigned char* Ao; const float* bias; bool nobias;
    __device__ __forceinline__ const float* bias_src(const Unit& u) const { return bias + (size_t)u.z * 2048 + u.pn * BM; }
    __device__ __forceinline__ void operator()(const f32x4 (&acc)[2][2][4][2], const Unit& u, int wr, int wc, int fr, int fq, const LAS float* lb) const {
        const int row0 = u.pm * BM + wr * 64 + fr;
        f32x4 bv[2][2];
#pragma unroll
        for (int bj = 0; bj < 2; ++bj)
#pragma unroll
            for (int n = 0; n < 2; ++n) { bv[bj][n] = nobias ? (f32x4){0.1f, 0.2f, 0.3f, 0.4f} : *(const LAS f32x4*)(lb + wc * 32 + 8 * fq + bj * HALF + 4 * n); if (n == 0) bv[bj][n] *= -1.702f * 1.4426950408889634f; }
        constexpr float C1 = -1.702f * 1.4426950408889634f, K4 = 4.f / C1;
#pragma unroll
        for (int ai = 0; ai < 2; ++ai)
#pragma unroll
            for (int bj = 0; bj < 2; ++bj) { unsigned w[4];
#pragma unroll
                for (int m = 0; m < 4; ++m) { float r[4];
#pragma unroll
                    for (int j = 0; j < 4; ++j) { const float t = fmaxf(fmaf(acc[ai][bj][m][0][j], C1, bv[bj][0][j]), 7.f * C1);
                        const float s = __builtin_amdgcn_rcpf(1.f + __builtin_amdgcn_exp2f(t));
                        const float uc = __builtin_amdgcn_fmed3f(acc[ai][bj][m][1][j] + bv[bj][1][j], -7.f, 7.f);
                        r[j] = fmaf(uc, K4, K4) * (t * s); }
                    int pk = __builtin_amdgcn_cvt_pk_fp8_f32(r[0], r[1], 0, false); pk = __builtin_amdgcn_cvt_pk_fp8_f32(r[2], r[3], pk, true); w[m] = (unsigned)pk; }
                { auto p02 = __builtin_amdgcn_permlane32_swap(w[0], w[2], false, false); auto p13 = __builtin_amdgcn_permlane32_swap(w[1], w[3], false, false);
                  auto q01 = __builtin_amdgcn_permlane16_swap(p02[0], p13[0], false, false); auto q23 = __builtin_amdgcn_permlane16_swap(p02[1], p13[1], false, false);
                  w[0] = q01[0]; w[1] = q01[1]; w[2] = q23[0]; w[3] = q23[1]; }
                *(u32x4*)(Ao + (size_t)(row0 + ai * HALF + fq * 16) * D + (u.pn * (BM / 2) + wc * 16) + bj * (HALF / 2)) = (u32x4){w[0], w[1], w[2], w[3]}; }
    }
};

struct SchedGrid {
    const char* A; const char* B; int nM, nN, G, c, lda, ldb;
    __device__ __forceinline__ bool next(int i, Unit& u) const { u.z = 0; u.hf = 0; return tile_order(i * G + c, nM, nN, u.pm, u.pn); }
    __device__ __forceinline__ const char* a_ptr(const Unit& u) const { return A + (size_t)u.pm * BM * lda; }
    __device__ __forceinline__ const char* b_ptr(const Unit& u) const { return B + (size_t)u.pn * BM * ldb; }
};
struct SchedInprojR {
    const char* A; const char* B; int pn0, nN, G, c, rowb; bool ctxkv; int nfull, cmin;
    static __host__ __device__ __forceinline__ int nkv(int p0, int n) { const int lo = p0 > 8 ? p0 : 8, hi = (p0 + n) < 12 ? (p0 + n) : 12; return (hi > lo ? hi - lo : 0) + ((p0 <= 14 && 14 < p0 + n) ? 1 : 0); }
    __device__ __forceinline__ bool next(int i, Unit& u) const { u.z = 0; u.hf = 0; if (i >= nfull && c < cmin) return false;
        const int L = i < nfull ? i * G + c : nfull * G + (i - nfull) * (G - cmin) + (c - cmin), nM = ctxkv ? NLAT / BM : NTOK / BM, nl = nM * nN;
        if (L < nl) { const bool ok = tile_order(L, nM, nN, u.pm, u.pn); u.pn += pn0; return ok; }
        if (!ctxkv) return false;
        const int j = L - nl, lo = pn0 > 8 ? pn0 : 8, hi = (pn0 + nN) < 12 ? (pn0 + nN) : 12, n1 = hi > lo ? hi - lo : 0, nk = nkv(pn0, nN); if (nk == 0 || j >= (NCTX / BM) * nk) return false;
        u.pm = NLAT / BM + j / nk; const int q = j % nk; u.pn = q < n1 ? lo + q : 14; return true; }
    __device__ __forceinline__ const char* a_ptr(const Unit& u) const { return A + (size_t)u.pm * BM * rowb; }
    __device__ __forceinline__ const char* b_ptr(const Unit& u) const { return B + (size_t)u.pn * BM * rowb; }
};
__device__ __forceinline__ bool mo_tile(int T, bool ctx, Unit& u) {
    u.hf = 0; if (T < (NLAT / BM) * 4) return tile_order(T, NLAT / BM, 4, u.pm, u.pn);
    const int j = T - (NLAT / BM) * 4; if (!ctx || j >= (NCTX / BM) * 8) return false;
    u.pm = NLAT / BM + (j >> 3); u.pn = (j >> 1) & 3; u.hf = 1 + (j & 1); return true; }
struct SchedMerge {
    const char* Y; const char* W; bool ctx; int G, c;
    __device__ __forceinline__ bool next(int i, Unit& u) const { u.z = i % 3; return mo_tile((i / 3) * G + c, ctx, u); }
    __device__ __forceinline__ const char* a_ptr(const Unit& u) const { return Y + ((size_t)(u.pm * BM + (u.hf == 2 ? HALF : 0)) * 1536 + u.z * 512) * 2; }
    __device__ __forceinline__ const char* b_ptr(const Unit& u) const { return W + ((size_t)u.z * D * 512 + (size_t)u.pn * BM * 512) * 2; }
};
struct SchedOut {
    const char* A; const char* B; bool ctx; int G, c;
    __device__ __forceinline__ bool next(int i, Unit& u) const { u.z = 0; return mo_tile(i * G + c, ctx, u); }
    __device__ __forceinline__ const char* a_ptr(const Unit& u) const { return A + (size_t)(u.pm * BM + (u.hf == 2 ? HALF : 0)) * D * 2; }
    __device__ __forceinline__ const char* b_ptr(const Unit& u) const { return B + (size_t)u.pn * BM * D * 2; }
};
struct SchedMoe {
    const char* A; const char* W; const LAS int* eoff; int nN, G, c; size_t wstride; int rowb; bool gather;
    __device__ __forceinline__ bool next(int i, Unit& u) const {
        const int npan = eoff[NE] / BM;
        if (G == 256) { const int x = c & 7, r = c >> 3, ppx = 32 / nN; u.pm = (i * 8 + x) * ppx + r / nN; u.pn = r % nN; if (u.pm >= npan) return false; }
        else { const int L = i * G + c; if (L >= npan * nN) return false; u.pm = L / nN; u.pn = L % nN; }
        int e = 0; const int row = u.pm * BM;
#pragma unroll
        for (int s = 16; s >= 1; s >>= 1) { if (__builtin_amdgcn_readfirstlane(eoff[e + s]) <= row) e += s; }
        u.z = e; u.hf = 0; return true; }
    __device__ __forceinline__ const char* a_ptr(const Unit& u) const { return gather ? A : A + (size_t)u.pm * BM * rowb; }
    __device__ __forceinline__ const char* b_ptr(const Unit& u) const { return W + (size_t)u.z * wstride + (size_t)u.pn * BM * rowb; }
};
}

#define XB_TMO      128
#define XB_XCNT(j)  (256  + 64 * (j))
#define XB_XSUB(j)  (1280 + 64 * (j))
#define XB_XGEN(j)  (2304 + 64 * (j))
#define XB_TOP      3328
#define XB_TOPGEN   3392
#define XCD_BAR_WORDS 3456
#define XB_SPIN_CAP (1u << 20)
__device__ __forceinline__ unsigned xb_ld(unsigned* p)              { return __hip_atomic_load(p, __ATOMIC_RELAXED, __HIP_MEMORY_SCOPE_AGENT); }
__device__ __forceinline__ unsigned xb_add(unsigned* p, unsigned v) { return __hip_atomic_fetch_add(p, v, __ATOMIC_RELAXED, __HIP_MEMORY_SCOPE_AGENT); }
__device__ __forceinline__ unsigned xb_xcc_id() { return (unsigned)__builtin_amdgcn_s_getreg((3 << 11) | 20) & 0xFu; }
#define XB_SPIN(cond, bar) do { unsigned _sp = 0; while (cond) { __builtin_amdgcn_s_sleep(1); \
    if ((++_sp & 255u) == 0u) { if (xb_ld(&(bar)[XB_TMO])) break; if (_sp > XB_SPIN_CAP) { atomicAdd(&(bar)[XB_TMO], 1u); break; } } } } while (0)
struct XcdBarrier { unsigned* bar; unsigned x; volatile LAS unsigned* st; };
__device__ __forceinline__ XcdBarrier xcd_barrier_post(unsigned* bar, volatile LAS unsigned* st) {
    XcdBarrier b; b.bar = bar; b.x = xb_xcc_id(); b.st = st;
    if (threadIdx.x == 0) (void)xb_add(&bar[XB_XCNT(b.x)], 1u);
    return b;
}
__device__ __forceinline__ void xcd_barrier_complete(unsigned* bar, unsigned x, unsigned& nloc, unsigned& nx) {
    const unsigned G = gridDim.x * gridDim.y * gridDim.z;
    unsigned sum, cnt, mine, sp = 0u;
    for (;;) {
        sum = 0u; cnt = 0u; mine = 0u;
#pragma unroll 1
        for (unsigned j = 0; j < 16; ++j) { const unsigned c = xb_ld(&bar[XB_XCNT(j)]); sum += c; cnt += (c > 0u) ? 1u : 0u; mine = (j == x) ? c : mine; }
        if (sum == G) break;
        __builtin_amdgcn_s_sleep(1);
        if ((++sp & 255u) == 0u) { if (xb_ld(&bar[XB_TMO])) break; if (sp > XB_SPIN_CAP) { atomicAdd(&bar[XB_TMO], 1u); break; } }
    }
    nloc = mine > 0u ? mine : 1u; nx = cnt > 0u ? cnt : 1u;
}
__device__ __forceinline__ void xcd_barrier(const XcdBarrier& b, int wvid) {
    asm volatile("s_waitcnt vmcnt(0)" ::: "memory");
    __syncthreads();
    if (opaque_tid(wvid) == 0) {
        unsigned* bar = b.bar;
        __builtin_amdgcn_s_waitcnt(0);
        unsigned nloc = b.st[0], nx = b.st[1];
        if (nloc == 0u) { xcd_barrier_complete(bar, b.x, nloc, nx); b.st[0] = nloc; b.st[1] = nx; }
        const unsigned old = xb_add(&bar[XB_XSUB(b.x)], 1u);
        const unsigned gen = old / nloc;
        if (old + 1u == (gen + 1u) * nloc) {
            __builtin_amdgcn_fence(__ATOMIC_RELEASE, "agent");
            asm volatile("s_waitcnt vmcnt(0)" ::: "memory");
            const unsigned og = xb_add(&bar[XB_TOP], 1u);
            const unsigned tg = og / nx;
            if (og + 1u == (tg + 1u) * nx) xb_add(&bar[XB_TOPGEN], 1u);
            else XB_SPIN(xb_ld(&bar[XB_TOPGEN]) == tg, bar);
            __builtin_amdgcn_fence(__ATOMIC_ACQUIRE, "agent");
            xb_add(&bar[XB_XGEN(b.x)], 1u);
            asm volatile("s_waitcnt vmcnt(0)" ::: "memory");
        } else {
            XB_SPIN(xb_ld(&bar[XB_XGEN(b.x)]) == gen, bar);
            __builtin_amdgcn_fence(__ATOMIC_ACQUIRE, "agent");
            asm volatile("s_waitcnt vmcnt(0)" ::: "memory");
        }
    }
    __syncthreads();
}

#include <hip/hip_bf16.h>
#include <cmath>
namespace attn_body {
using bf16=__hip_bfloat16;
using bf16x8=__attribute__((ext_vector_type(8)))short;
using s16x4=__attribute__((ext_vector_type(4)))short;
using f32x16=__attribute__((ext_vector_type(16)))float;
using u32x4=__attribute__((ext_vector_type(4)))unsigned;
constexpr int D=64;
constexpr int NW=8,QBLK=32,QB=QBLK*NW,KVBLK=64;
constexpr int ATTN_UNIT_ROWS=QB;
__device__ __forceinline__ int crow(int r,int hi){return (r&3)+8*(r>>2)+4*hi;}
#define SBAR() __builtin_amdgcn_sched_barrier(0)
constexpr int NSLOT=3, SLOTB=8192;
constexpr int LDS_K=0, LDS_V=NSLOT*SLOTB, LDS_WS=2*NSLOT*SLOTB, LDS_OST=LDS_WS+NW*64*4, LDS_BYTES=LDS_OST+NW*4096;
constexpr float C2=0.125f*1.4426950408889634f;
__device__ __forceinline__ void glds16(const void*gsrc,unsigned lds_dst){unsigned keep;
  asm volatile("s_mov_b32 %0, m0\n\ts_mov_b32 m0, %2\n\ts_nop 0\n\tglobal_load_lds_dwordx4 %1, off\n\ts_mov_b32 m0, %0":"=&s"(keep):"v"(gsrc),"s"(lds_dst):"memory");}
__device__ __forceinline__ float max3f(float a,float b,float c){float r;asm("v_max3_f32 %0, %1, %2, %3":"=v"(r):"v"(a),"v"(b),"v"(c));return r;}
__device__ __forceinline__ float max2f(float a,float b){float r;asm("v_max_f32_e32 %0, %1, %2":"=v"(r):"v"(a),"v"(b));return r;}
__device__ __forceinline__ float fadd_s(float a,float b){float r;asm("v_add_f32_e32 %0, %1, %2":"=v"(r):"v"(a),"v"(b));return r;}
__device__ __forceinline__ float fsub_s(float a,float b){float r;asm("v_sub_f32_e32 %0, %1, %2":"=v"(r):"v"(a),"v"(b));return r;}
typedef float f32x2_t __attribute__((ext_vector_type(2))); typedef __bf16 bf16x2_t __attribute__((ext_vector_type(2)));
__device__ __forceinline__ unsigned cvtpk_s(float lo,float hi){f32x2_t v={lo,hi};bf16x2_t b=__builtin_convertvector(v,bf16x2_t);return __builtin_bit_cast(unsigned,b);}
#define WAIT_BAR(N) asm volatile("s_waitcnt vmcnt(" #N ") lgkmcnt(0)\n\ts_barrier":::"memory")

__device__ __forceinline__ void qkt(f32x16&p0,f32x16&p1,const char*Kslot,const bf16x8*qr,const f32x16&negm,int r32,int hi){
  const char*kb=Kslot+hi*1024+r32*16;
  #pragma unroll
  for(int d0=0;d0<4;++d0){
    const bf16x8 b0=*reinterpret_cast<const bf16x8*>(kb+d0*2048);
    const bf16x8 b1=*reinterpret_cast<const bf16x8*>(kb+d0*2048+512);
    if(d0==0){p0=__builtin_amdgcn_mfma_f32_32x32x16_bf16(b0,qr[0],negm,0,0,0);p1=__builtin_amdgcn_mfma_f32_32x32x16_bf16(b1,qr[0],negm,0,0,0);}
    else{p0=__builtin_amdgcn_mfma_f32_32x32x16_bf16(b0,qr[d0],p0,0,0,0);p1=__builtin_amdgcn_mfma_f32_32x32x16_bf16(b1,qr[d0],p1,0,0,0);}}
}
typedef __attribute__((address_space(3))) const char* lds_cptr;
typedef short v4i16_t __attribute__((ext_vector_type(4)));
__device__ __forceinline__ void kload8(bf16x8*kf,lds_cptr kp){
  kf[0]=*(const __attribute__((address_space(3))) bf16x8*)(kp);      kf[1]=*(const __attribute__((address_space(3))) bf16x8*)(kp+512);
  kf[2]=*(const __attribute__((address_space(3))) bf16x8*)(kp+2048); kf[3]=*(const __attribute__((address_space(3))) bf16x8*)(kp+2560);
  kf[4]=*(const __attribute__((address_space(3))) bf16x8*)(kp+4096); kf[5]=*(const __attribute__((address_space(3))) bf16x8*)(kp+4608);
  kf[6]=*(const __attribute__((address_space(3))) bf16x8*)(kp+6144); kf[7]=*(const __attribute__((address_space(3))) bf16x8*)(kp+6656);
}
__device__ __forceinline__ void kload2(bf16x8*kf,lds_cptr kp,int j){ kf[2*j]=*(const __attribute__((address_space(3))) bf16x8*)(kp+j*2048); kf[2*j+1]=*(const __attribute__((address_space(3))) bf16x8*)(kp+j*2048+512); }
__device__ __forceinline__ s16x4 vtr(lds_cptr p){ return __builtin_bit_cast(s16x4,__builtin_amdgcn_ds_read_tr16_b64_v4i16((__attribute__((address_space(3))) v4i16_t*)p)); }
__device__ __forceinline__ float rowmax(const f32x16&p0,const f32x16&p1){
  float a=max3f(p0[0],p0[1],p1[0]),b=max3f(p0[2],p0[3],p1[1]);a=max3f(a,p1[2],p1[3]);
  #pragma unroll
  for(int r=4;r<16;r+=4){a=max3f(a,p0[r],p0[r+1]);b=max3f(b,p0[r+2],p0[r+3]);a=max3f(a,p1[r],p1[r+1]);b=max3f(b,p1[r+2],p1[r+3]);}
  const float m=max2f(a,b);
  auto rr=__builtin_amdgcn_permlane32_swap(__float_as_uint(m),__float_as_uint(m),false,false);
  return max2f(__uint_as_float(rr[0]),__uint_as_float(rr[1]));
}
__device__ __forceinline__ void pv(f32x16*o,int vb,bf16x8 pa0,bf16x8 pa1,bf16x8 pa2,bf16x8 pa3){
  #pragma unroll
  for(int d0=0;d0<2;++d0){s16x4 lo[4],hi[4];
    #pragma unroll
    for(int ks=0;ks<4;++ks){
      asm volatile("ds_read_b64_tr_b16 %0,%1 offset:%c2":"=&v"(lo[ks]):"v"(vb),"i"(d0*4096+ks*1024):"memory");
      asm volatile("ds_read_b64_tr_b16 %0,%1 offset:%c2":"=&v"(hi[ks]):"v"(vb),"i"(d0*4096+ks*1024+512):"memory");}
    asm volatile("s_waitcnt lgkmcnt(0)":::"memory");SBAR();
    #define PK(k) (bf16x8){lo[k][0],lo[k][1],lo[k][2],lo[k][3],hi[k][0],hi[k][1],hi[k][2],hi[k][3]}
    o[d0]=__builtin_amdgcn_mfma_f32_32x32x16_bf16(pa0,PK(0),o[d0],0,0,0);
    o[d0]=__builtin_amdgcn_mfma_f32_32x32x16_bf16(pa1,PK(1),o[d0],0,0,0);
    o[d0]=__builtin_amdgcn_mfma_f32_32x32x16_bf16(pa2,PK(2),o[d0],0,0,0);
    o[d0]=__builtin_amdgcn_mfma_f32_32x32x16_bf16(pa3,PK(3),o[d0],0,0,0);
    #undef PK
  }
}

#ifndef ATTN_STORE16
#define ATTN_STORE16(p,v) (*(u32x4*)(p)=(v))
#endif
struct NaArgs { long trow_ctx, trow_band; int R0, rs0; const float* natab; };
template<int THRL,bool NA> __device__ __forceinline__ void attn_unit(const bf16*Qw0,int QP,const bf16*__restrict__ Kh,int KP,const bf16*__restrict__ Vh,int VP,bf16*Ow0,int OP,int NT,char*shm,const NaArgs na,int wvid,int qmode=0,const float*qgain=nullptr,int tq0=0){
  const int tid=opaque_tid(wvid),lane=tid&63,r32=lane&31,hi=lane>>5; const int wid=__builtin_amdgcn_readfirstlane(tid>>6);
  if(wid>=4)__builtin_amdgcn_s_setprio(1);
  const bf16*Qw=Qw0+(long)(wid*QBLK)*QP;
  const unsigned lds0=(unsigned)(uintptr_t)shm;
  float*wsf=(float*)(shm+LDS_WS)+wid*64;
  const bf16*ksrc=Kh+(long)lane*KP+wid*8;
  const bf16*vsrc=Vh+(long)(16*(wid&3)+(lane>>2))*VP+(wid>>2)*32+(lane&3)*8;
  const unsigned kdst=lds0+LDS_K+wid*1024, vdst=lds0+LDS_V+wid*1024;
  #define TROW(t) (NA ? ((t)<4 ? na.trow_ctx+(long)(t)*KVBLK : na.trow_band+(long)((t)-4)*KVBLK) : (long)(t)*KVBLK)
  #define DMA_K(t,slot) glds16(ksrc+TROW(t)*KP,(unsigned)__builtin_amdgcn_readfirstlane(kdst+(slot)))
  #define DMA_V(t,slot) glds16(vsrc+TROW(t)*VP,(unsigned)__builtin_amdgcn_readfirstlane(vdst+(slot)))
  const int vb0=(int)(lds0+LDS_V)+((lane>>4)&1)*32+(lane&3)*8+(4*hi+((lane&15)>>2))*64;
  const char*Kbase=shm+LDS_K; bf16x8 kf[8];
  const lds_cptr shm3=(lds_cptr)shm; const lds_cptr kp0=shm3+LDS_K+hi*1024+r32*16; const lds_cptr vp0=shm3+LDS_V+((lane>>4)&1)*32+(lane&3)*8+(4*hi+((lane&15)>>2))*64;
  DMA_K(0,0);DMA_V(0,0);DMA_K(1,SLOTB);
  bf16x8 qr[4];
  #pragma unroll
  for(int d0=0;d0<4;++d0)qr[d0]=*reinterpret_cast<const bf16x8*>(&Qw[(long)r32*QP+d0*16+hi*8]);
  if(qmode!=0){
    float v[32]; float ss=0.f;
    #pragma unroll
    for(int d0=0;d0<4;++d0)
      #pragma unroll
      for(int j=0;j<8;++j){const float x=__uint_as_float(((unsigned)(unsigned short)qr[d0][j])<<16); v[8*d0+j]=x; ss+=x*x;}
    {auto rr=__builtin_amdgcn_permlane32_swap(__float_as_uint(ss),__float_as_uint(ss),false,false); ss=__uint_as_float(rr[0])+__uint_as_float(rr[1]);}
    const float rn=rsqrtf(ss*(1.f/64.f)+EPS);
    #pragma unroll
    for(int d0=0;d0<4;++d0){const float4 g0=*(const float4*)(qgain+16*d0+8*hi),g1=*(const float4*)(qgain+16*d0+8*hi+4);
      v[8*d0+0]=v[8*d0+0]*rn*g0.x;v[8*d0+1]=v[8*d0+1]*rn*g0.y;v[8*d0+2]=v[8*d0+2]*rn*g0.z;v[8*d0+3]=v[8*d0+3]*rn*g0.w;
      v[8*d0+4]=v[8*d0+4]*rn*g1.x;v[8*d0+5]=v[8*d0+5]*rn*g1.y;v[8*d0+6]=v[8*d0+6]*rn*g1.z;v[8*d0+7]=v[8*d0+7]*rn*g1.w;}
    if(qmode==1){const int tq=tq0+wid*QBLK+r32; const float pr=(float)(tq/64),pc=(float)(tq%64);
      #pragma unroll
      for(int j=0;j<8;++j){const float inv=exp2f(-(float)(8*hi+j)*0.8304820237218406f);
        {float cs,sn;sincos_small(pr*inv,sn,cs);const float x1=v[j],x2=v[8+j];v[j]=x1*cs-x2*sn;v[8+j]=x1*sn+x2*cs;}
        {float cs,sn;sincos_small(pc*inv,sn,cs);const float x1=v[16+j],x2=v[24+j];v[16+j]=x1*cs-x2*sn;v[24+j]=x1*sn+x2*cs;}}}
    #pragma unroll
    for(int d0=0;d0<4;++d0)
      #pragma unroll
      for(int j=0;j<8;++j)qr[d0][j]=(short)f2bf(v[8*d0+j]*C2);
  }
  float mhat=0.f,l_reg=0.f;f32x16 o[2];o[0]=f32x16{};o[1]=f32x16{};f32x16 negm=f32x16{};asm volatile("":"+v"(negm));
  const int na_qr=na.R0+(wid>>1), na_rsq=min(max(na_qr-4,0),56), na_qc=(wid&1)*32+r32, na_cs=min(max(na_qc-8,0),48);
  unsigned na_w0=0u,na_w1=0u;
  if(NA){
    #pragma unroll
    for(int r=0;r<16;++r){const int kv=(r&3)+8*(r>>2)+4*hi; if((unsigned)(kv-na_cs)<16u)na_w0|=1u<<r; if((unsigned)(kv+32-na_cs)<16u)na_w1|=1u<<r;}
    const float*gt=na.natab; float*lt=(float*)(shm+LDS_BYTES)+64;
    for(int i=tid;i<15*31;i+=NW*64)lt[i]=gt[i]*1.4426950408889634f;
  }
  const float*na_tb=(const float*)(shm+LDS_BYTES)+64+(15-na_qc)+4*hi;
  #define CMASK(P0,P1,t) do{ if(NA&&(t)>=4){ const int kr_=na.rs0+(t)-4; const float rowneg_=((unsigned)(kr_-na_rsq)>=8u)?-INFINITY:0.f;     \
      const float*tb_=na_tb+min(max(kr_-na_qr+7,0),14)*31; int d0_=4*hi-na_cs; asm volatile("":"+v"(d0_));   \
      _Pragma("unroll") for(int r=0;r<16;++r){ const int c_=(r&3)+8*(r>>2); const float b0_=tb_[c_]+rowneg_,b1_=tb_[32+c_]+rowneg_; \
        P0[r]=((unsigned)(d0_+c_)<16u)?P0[r]+b0_:-INFINITY; P1[r]=((unsigned)(d0_+c_+32)<16u)?P1[r]+b1_:-INFINITY; } } }while(0)
  bool resc=false;
  #define START(P0,P1) do{ const float rm=rowmax(P0,P1); resc=false; \
    { const float dl=rm; mhat=fadd_s(mhat,dl); \
      _Pragma("unroll") for(int r=0;r<16;++r){P0[r]=fsub_s(P0[r],dl);P1[r]=fsub_s(P1[r],dl);} \
      _Pragma("unroll") for(int r=0;r<16;++r)negm[r]=-mhat; asm volatile("":"+v"(negm)); } \
    _Pragma("unroll") for(int r=0;r<16;++r)P0[r]=__builtin_amdgcn_exp2f(P0[r]); }while(0)
  #define RESC() do{ if(resc){ asm volatile("s_waitcnt lgkmcnt(0)":::"memory"); \
      _Pragma("unroll") for(int d_=0;d_<2;++d_) _Pragma("unroll") for(int r=0;r<16;++r)o[d_][r]*=wsf[crow(r,hi)]; } }while(0)
  f32x16 pA0,pA1,pB0,pB1;
  int sl_prev=0,sl_cur=0,sl_next=SLOTB;
  #define ROT() do{sl_prev=sl_cur;sl_cur=sl_next;sl_next=(sl_next==(NSLOT-1)*SLOTB)?0:sl_next+SLOTB;}while(0)
  DMA_K(2,2*SLOTB);
  WAIT_BAR(3);
  qkt(pA0,pA1,Kbase,qr,negm,r32,hi);asm volatile("s_nop 15\n\ts_nop 7":"+v"(pA0),"+v"(pA1));CMASK(pA0,pA1,0);
  START(pA0,pA1);
  _Pragma("unroll") for(int r=0;r<16;++r)pA1[r]=__builtin_amdgcn_exp2f(pA1[r]);
  WAIT_BAR(0);
  DMA_K(3,0);DMA_V(1,SLOTB);
  ROT();
  kload8(kf,kp0+sl_cur);
  WAIT_BAR(2);
  s16x4 vlo[8],vhi[8]; u32x4 pw0,pw1,pw2,pw3;
  #define PKW(P,B) cvtpk_s(P[B],P[B+1])
  #define PAF(k) __builtin_bit_cast(bf16x8,pw##k)
  #define VFR(i) (bf16x8){vlo[i][0],vlo[i][1],vlo[i][2],vlo[i][3],vhi[i][0],vhi[i][1],vhi[i][2],vhi[i][3]}
  #define PIN(x) asm volatile("":"+v"(x))
  #define MX3(a,b,c) __builtin_fmaxf(__builtin_fmaxf((a),(b)),(c))
  #define GAPA(MF,A0,A1,A2,A3,W0,W1,PW) do{ MF; sacc+=A0; sacc+=A1; sacc+=A2; sacc+=A3; PIN(sacc); W0; W1; PIN(PW); SBAR(); }while(0)
  #define EX(v) __builtin_amdgcn_exp2f(v)
  #define GAPB(MF,X,B) do{ MF; X[B]=EX(X[B]); X[B+1]=EX(X[B+1]); X[B+2]=EX(X[B+2]); X[B+3]=EX(X[B+3]); PIN(X); SBAR(); }while(0)
  #define VRD(i) do{ vlo[i]=vtr(vp_+(((i)>>2)*4096+((i)&3)*1024)); vhi[i]=vtr(vp_+(((i)>>2)*4096+((i)&3)*1024+512)); }while(0)
  #define KRD(G,j) do{ if(G){ kload2(kf,kp0+sl_next,j); SBAR(); } }while(0)
  #define STEP(C0,C1,P0,P1,t,GK,GV,GL) do{ SBAR(); \
    const lds_cptr vp_=vp0+sl_prev; \
    VRD(0); SBAR(); float sacc=(P0[0]+P0[1]); \
    GAPA(C0=__builtin_amdgcn_mfma_f32_32x32x16_bf16(kf[0],qr[0],negm,0,0,0), P0[2],P0[3],P0[4],P0[5],     pw0[0]=PKW(P0,0), pw0[1]=PKW(P0,2), pw0); \
    VRD(4); SBAR(); GAPA(C1=__builtin_amdgcn_mfma_f32_32x32x16_bf16(kf[1],qr[0],negm,0,0,0), P0[6],P0[7],P0[8],P0[9],     pw0[2]=PKW(P0,4), pw0[3]=PKW(P0,6), pw0); \
    VRD(1); SBAR(); GAPA(C0=__builtin_amdgcn_mfma_f32_32x32x16_bf16(kf[2],qr[1],C0,0,0,0),   P0[10],P0[11],P0[12],P0[13], pw1[0]=PKW(P0,8), pw1[1]=PKW(P0,10), pw1); \
    VRD(5); SBAR(); GAPA(C1=__builtin_amdgcn_mfma_f32_32x32x16_bf16(kf[3],qr[1],C1,0,0,0),   P0[14],P0[15],P1[0],P1[1],   pw1[2]=PKW(P0,12),pw1[3]=PKW(P0,14), pw1); \
    VRD(2); SBAR(); GAPA(C0=__builtin_amdgcn_mfma_f32_32x32x16_bf16(kf[4],qr[2],C0,0,0,0),   P1[2],P1[3],P1[4],P1[5],     pw2[0]=PKW(P1,0), pw2[1]=PKW(P1,2), pw2); \
    VRD(6); SBAR(); GAPA(C1=__builtin_amdgcn_mfma_f32_32x32x16_bf16(kf[5],qr[2],C1,0,0,0),   P1[6],P1[7],P1[8],P1[9],     pw2[2]=PKW(P1,4), pw2[3]=PKW(P1,6), pw2); \
    VRD(3); SBAR(); GAPA(C0=__builtin_amdgcn_mfma_f32_32x32x16_bf16(kf[6],qr[3],C0,0,0,0),   P1[10],P1[11],P1[12],P1[13], pw3[0]=PKW(P1,8), pw3[1]=PKW(P1,10), pw3); \
    VRD(7); SBAR(); GAPA(C1=__builtin_amdgcn_mfma_f32_32x32x16_bf16(kf[7],qr[3],C1,0,0,0),   P1[14],P1[15],0.f,0.f,       pw3[2]=PKW(P1,12),pw3[3]=PKW(P1,14), pw3); \
    l_reg+=sacc; \
    if(GK){DMA_K((t)+3,sl_cur);} if(GV){DMA_V((t)+1,sl_next);} \
    CMASK(C0,C1,t); \
    { float a=MX3(C0[0],C0[1],C1[0]),b=MX3(C0[2],C0[3],C1[1]); a=MX3(a,C1[2],C1[3]); \
      _Pragma("unroll") for(int r=4;r<16;r+=4){a=MX3(a,C0[r],C0[r+1]);b=MX3(b,C0[r+2],C0[r+3]);a=MX3(a,C1[r],C1[r+1]);b=MX3(b,C1[r+2],C1[r+3]);} \
      float rm=__builtin_fmaxf(a,b); { auto rr=__builtin_amdgcn_permlane32_swap(__float_as_uint(rm),__float_as_uint(rm),false,false); rm=__builtin_fmaxf(__uint_as_float(rr[0]),__uint_as_float(rr[1])); } \
      resc=false; \
      if(__builtin_expect(__any(rm>(float)THRL),0)){ const float dl=__builtin_fmaxf(rm,0.f); mhat+=dl; \
        _Pragma("unroll") for(int r=0;r<16;++r){C0[r]-=dl;C1[r]-=dl;} \
        _Pragma("unroll") for(int r=0;r<16;++r)negm[r]=-mhat; asm volatile("":"+v"(negm)); \
        const float f=__builtin_amdgcn_exp2f(-dl); l_reg*=f; if(hi==0)wsf[r32]=f; resc=true; } } \
    SBAR(); \
    GAPB(o[0]=__builtin_amdgcn_mfma_f32_32x32x16_bf16(PAF(0),VFR(0),o[0],0,0,0), C0,0); \
    GAPB(o[1]=__builtin_amdgcn_mfma_f32_32x32x16_bf16(PAF(0),VFR(4),o[1],0,0,0), C0,4); \
    KRD(GL,0); GAPB(o[0]=__builtin_amdgcn_mfma_f32_32x32x16_bf16(PAF(1),VFR(1),o[0],0,0,0), C0,8); \
    KRD(GL,1); GAPB(o[1]=__builtin_amdgcn_mfma_f32_32x32x16_bf16(PAF(1),VFR(5),o[1],0,0,0), C0,12); \
    KRD(GL,2); GAPB(o[0]=__builtin_amdgcn_mfma_f32_32x32x16_bf16(PAF(2),VFR(2),o[0],0,0,0), C1,0); \
    KRD(GL,3); GAPB(o[1]=__builtin_amdgcn_mfma_f32_32x32x16_bf16(PAF(2),VFR(6),o[1],0,0,0), C1,4); \
    GAPB(o[0]=__builtin_amdgcn_mfma_f32_32x32x16_bf16(PAF(3),VFR(3),o[0],0,0,0), C1,8); \
    GAPB(o[1]=__builtin_amdgcn_mfma_f32_32x32x16_bf16(PAF(3),VFR(7),o[1],0,0,0), C1,12); \
    }while(0)
  int t=1;
  for(;t+5<NT;t+=2){
    STEP(pB0,pB1,pA0,pA1,t,true,true,true);     WAIT_BAR(2); RESC(); ROT();
    STEP(pA0,pA1,pB0,pB1,t+1,true,true,true);   WAIT_BAR(2); RESC(); ROT();
  }
  #define ENDW(tt) do{ if((tt)+3<NT){WAIT_BAR(2);} else if((tt)+2<NT){WAIT_BAR(1);} else {WAIT_BAR(0);} }while(0)
  for(;t+1<NT;t+=2){
    STEP(pB0,pB1,pA0,pA1,t,(t+3<NT),(t+1<NT),(t+1<NT));       ENDW(t);   RESC(); ROT();
    STEP(pA0,pA1,pB0,pB1,t+1,(t+4<NT),(t+2<NT),(t+2<NT));     ENDW(t+1); RESC(); ROT();
  }
  STEP(pB0,pB1,pA0,pA1,NT-1,false,false,false); RESC();
  { float sacc=pB0[0]+pB0[1]; _Pragma("unroll") for(int r=2;r<16;++r)sacc+=pB0[r]; _Pragma("unroll") for(int r=0;r<16;++r)sacc+=pB1[r]; l_reg+=sacc;
    pw0=(u32x4){PKW(pB0,0),PKW(pB0,2),PKW(pB0,4),PKW(pB0,6)};pw1=(u32x4){PKW(pB0,8),PKW(pB0,10),PKW(pB0,12),PKW(pB0,14)};pw2=(u32x4){PKW(pB1,0),PKW(pB1,2),PKW(pB1,4),PKW(pB1,6)};pw3=(u32x4){PKW(pB1,8),PKW(pB1,10),PKW(pB1,12),PKW(pB1,14)};
    SBAR(); pv(o,vb0+sl_cur,PAF(0),PAF(1),PAF(2),PAF(3)); }
  #undef PKW
  #undef PAF
  #undef VFR
  #undef PIN
  #undef MX3
  #undef GAPA
  #undef GAPB
  #undef EX
  #undef VRD
  #undef KRD
  #undef STEP
  #undef ENDW
  {auto rr=__builtin_amdgcn_permlane32_swap(__float_as_uint(l_reg),__float_as_uint(l_reg),false,false);l_reg=__uint_as_float(rr[0])+__uint_as_float(rr[1]);}
  if(hi==0)wsf[32+r32]=l_reg;asm volatile("s_waitcnt lgkmcnt(0)":::"memory");
  float rli[16];
  #pragma unroll
  for(int r=0;r<16;++r)rli[r]=__builtin_amdgcn_rcpf(wsf[32+crow(r,hi)]);
  bf16*Ow=Ow0+(long)(wid*QBLK)*OP;
  { bf16*stg=(bf16*)(shm+LDS_OST)+wid*2048;
    #pragma unroll
    for(int r=0;r<16;++r){const int orow=crow(r,hi);
      #pragma unroll
      for(int d0=0;d0<2;++d0)stg[orow*64+d0*32+r32]=__float2bfloat16(o[d0][r]*rli[r]);}
    asm volatile("s_waitcnt lgkmcnt(0)":::"memory");
    #pragma unroll
    for(int i=0;i<4;++i){const int row=i*8+(lane>>3),ch=lane&7; const u32x4 v=*(const u32x4*)(stg+row*64+ch*8); ATTN_STORE16(Ow+(long)row*OP+ch*8,v);} }
  __builtin_amdgcn_s_setprio(0);
  asm volatile("s_waitcnt lgkmcnt(0)\n\ts_barrier":::"memory");
  #undef DMA_K
  #undef DMA_V
  #undef TROW
  #undef CMASK
  #undef START
  #undef RESC
  #undef ROT
}
constexpr int ATTN_LDS_BYTES=LDS_BYTES+(64+15*31+64+3)/4*4*4;
#undef SBAR
#undef WAIT_BAR
}
#ifndef MK_PHMASK
#define MK_PHMASK 0xffffffff
#endif
#ifndef MK_REPEAT
#define MK_REPEAT 0
#endif
#define REPS(b) for (int rep_ = 0; rep_ < 1 + ((MK_REPEAT >> (b)) & 1); ++rep_)
constexpr int NWAVES = 8;
constexpr int RING_BYTES = 131072, LDSCTL_OFF = RING_BYTES, MISC_OFF = LDSCTL_OFF + 320, EOFF_OFF = LDSCTL_OFF + 1024, HIST_OFF = LDSCTL_OFF + 1280, SC_PART_OFF = LDSCTL_OFF + 1536,
              SC_TOT_OFF = LDSCTL_OFF + 5632, SC_BASE_OFF = LDSCTL_OFF + 5760, SC_EOFF_OFF = LDSCTL_OFF + 5888, SC_WCNT_OFF = LDSCTL_OFF + 6144, SC_SLOT_OFF = LDSCTL_OFF + 8192, PTAB_OFF = LDSCTL_OFF + 512, GTAB_OFF = LDSCTL_OFF + 12288, LBIAS_OFF = LDSCTL_OFF + 14336, LDS_BYTES = 147456;
enum { PH_PRE0 = 0, PH_PRE1 = 1, PH_L0 = 2, PHL_INPROJ = 0, PHL_MIX1 = 1, PHL_MIX2 = 2, PHL_MERGE = 3, PHL_OUT = 4, PHL_ROUTE = 5, PHL_SCAN = 6, PHL_GEMM1 = 7, PHL_GEMM2 = 8, PHL_COMB = 9, PHL_N = 10, PH_END = PH_L0 + 2 * PHL_N };
struct MkArgs { Ptrs p; int ph_lo, ph_hi; };

__device__ __forceinline__ void cvt_item(const float* W, int K, int N, bf16_t* WT, bool deint, LAS float* scr, int item, int lane) {
    const int nblk = N / 32, kb = item / nblk, nb = item % nblk, k0 = 64 * kb, n0 = 32 * nb;
#pragma unroll 8
    for (int i = 0; i < 32; ++i) { const int kk = 2 * i + (lane >> 5); scr[kk * 33 + (lane & 31)] = W[(size_t)(k0 + kk) * N + n0 + (lane & 31)]; }
    asm volatile("s_waitcnt lgkmcnt(0)" ::: "memory");
    const int c = lane & 7;
#pragma unroll
    for (int j = 0; j < 4; ++j) { const int n = (lane >> 3) + 8 * j; const LAS float* s = scr + (8 * c) * 33 + n;
        pg8::u32x4 o; o.x = pk2(s[0 * 33], s[1 * 33]); o.y = pk2(s[2 * 33], s[3 * 33]); o.z = pk2(s[4 * 33], s[5 * 33]); o.w = pk2(s[6 * 33], s[7 * 33]);
        const int no = n0 + n, nd = deint ? ((no & ~7) | ((no & 1) << 2) | ((no & 7) >> 1)) : no;
        *(pg8::u32x4*)(WT + (size_t)nd * K + k0 + 8 * c) = o; }
    asm volatile("s_waitcnt lgkmcnt(0)" ::: "memory");
}

__device__ __forceinline__ void cvt_item_fp8(const float* W, int K, int N, unsigned char* WT, bool deint, LAS float* scr, int item, int lane) {
    const int nblk = N / 32, kb = item / nblk, nb = item % nblk, k0 = 64 * kb, n0 = 32 * nb;
#pragma unroll 8
    for (int i = 0; i < 32; ++i) { const int kk = 2 * i + (lane >> 5); scr[kk * 33 + (lane & 31)] = W[(size_t)(k0 + kk) * N + n0 + (lane & 31)]; }
    asm volatile("s_waitcnt lgkmcnt(0)" ::: "memory");
    const int c = lane & 7;
#pragma unroll
    for (int j = 0; j < 4; ++j) { const int n = (lane >> 3) + 8 * j; const LAS float* s = scr + (8 * c) * 33 + n;
        int lo = __builtin_amdgcn_cvt_pk_fp8_f32(64.f * s[0 * 33], 64.f * s[1 * 33], 0, false); lo = __builtin_amdgcn_cvt_pk_fp8_f32(64.f * s[2 * 33], 64.f * s[3 * 33], lo, true);
        int hi = __builtin_amdgcn_cvt_pk_fp8_f32(64.f * s[4 * 33], 64.f * s[5 * 33], 0, false); hi = __builtin_amdgcn_cvt_pk_fp8_f32(64.f * s[6 * 33], 64.f * s[7 * 33], hi, true);
        const int no = n0 + n, nd = deint ? ((no & ~7) | ((no & 1) << 2) | ((no & 7) >> 1)) : no;
        *(pg8::u32x2*)(WT + (size_t)nd * K + k0 + 8 * c) = (pg8::u32x2){(unsigned)lo, (unsigned)hi}; }
    asm volatile("s_waitcnt lgkmcnt(0)" ::: "memory");
}

struct CvtJob { const float* W; unsigned char* WT; int K, N, item, mode, ldw; };
__device__ __forceinline__ void cvt_load(const CvtJob& j, int lane, float4 (&wv)[8]) {
    const int nblk = j.N / 32, kb = j.item / nblk, nb = j.item % nblk, k0 = 64 * kb, n0 = 32 * nb;
#pragma unroll
    for (int i = 0; i < 8; ++i) wv[i] = *(const float4*)(j.W + (size_t)(k0 + 8 * i + (lane >> 3)) * j.ldw + n0 + 4 * (lane & 7));
}
__device__ __forceinline__ void cvt_finish(const CvtJob& j, const float4 (&wv)[8], LAS float* scr, int lane, bool st = true) {
    const int nblk = j.N / 32, kb = j.item / nblk, nb = j.item % nblk, k0 = 64 * kb, n0 = 32 * nb;
#pragma unroll
    for (int i = 0; i < 8; ++i) { LAS float* d = scr + (8 * i + (lane >> 3)) * 33 + 4 * (lane & 7); d[0] = wv[i].x; d[1] = wv[i].y; d[2] = wv[i].z; d[3] = wv[i].w; }
    asm volatile("s_waitcnt lgkmcnt(0)" ::: "memory");
    const int c = lane & 7;
    if (j.mode == 0) {
#pragma unroll
        for (int jj = 0; jj < 4; ++jj) { const int n = (lane >> 3) + 8 * jj; const LAS float* s = scr + (8 * c) * 33 + n; const int nd = n0 + n;
            pg8::u32x4 o; o.x = pg8::cvt_pk_bf16(s[0 * 33], s[1 * 33]); o.y = pg8::cvt_pk_bf16(s[2 * 33], s[3 * 33]); o.z = pg8::cvt_pk_bf16(s[4 * 33], s[5 * 33]); o.w = pg8::cvt_pk_bf16(s[6 * 33], s[7 * 33]);
            if (st || o.x == 0x12345u) *(pg8::u32x4*)((bf16_t*)j.WT + (size_t)nd * j.K + k0 + 8 * c) = o; }
    } else {
#pragma unroll
        for (int jj = 0; jj < 4; ++jj) { const int n = (lane >> 3) + 8 * jj; const LAS float* s = scr + (8 * c) * 33 + n;
            const int no = n0 + n, nd = j.mode == 2 ? ((no & ~7) | ((no & 1) << 2) | ((no & 7) >> 1)) : no;
            int lo = __builtin_amdgcn_cvt_pk_fp8_f32(64.f * s[0 * 33], 64.f * s[1 * 33], 0, false); lo = __builtin_amdgcn_cvt_pk_fp8_f32(64.f * s[2 * 33], 64.f * s[3 * 33], lo, true);
            int hi = __builtin_amdgcn_cvt_pk_fp8_f32(64.f * s[4 * 33], 64.f * s[5 * 33], 0, false); hi = __builtin_amdgcn_cvt_pk_fp8_f32(64.f * s[6 * 33], 64.f * s[7 * 33], hi, true);
            if (st || lo == 0x12345) *(pg8::u32x2*)(j.WT + (size_t)nd * j.K + k0 + 8 * c) = (pg8::u32x2){(unsigned)lo, (unsigned)hi}; }
    }
    asm volatile("s_waitcnt lgkmcnt(0)" ::: "memory");
}

__global__ void __launch_bounds__(NWAVES * 64, 2) mk_fwd(MkArgs args) {
    extern __shared__ __attribute__((aligned(16))) unsigned char lds_raw[];
    LAS unsigned char* lds = (LAS unsigned char*)lds_raw;
    volatile LAS unsigned* MISC = (volatile LAS unsigned*)(lds + MISC_OFF);
    const Ptrs& p = args.p; unsigned char* const ws0_ = p.ws;
    const int G = gridDim.x, bx = blockIdx.x, wv_ = __builtin_amdgcn_readfirstlane((int)threadIdx.x >> 6);
    { const int tid0 = threadIdx.x; for (int u = tid0; u < (LDS_BYTES - LDSCTL_OFF) / 4; u += NWAVES * 64) ((LAS unsigned*)(lds + LDSCTL_OFF))[u] = 0u;
 }
    __syncthreads();
    const int lo = args.ph_lo, hi = args.ph_hi;
    unsigned* const barw = (unsigned*)(ws0_ + WS_CTL) + CW_BAR;
    XcdBarrier bar; bar.bar = barw; bar.x = 0; bar.st = nullptr;
    if (hi - lo > 1) bar = xcd_barrier_post(barw, MISC + 8);
#define IN(k) (lo <= (k) && (k) < hi)
#define SEAM(k) do { if (IN(k) && IN((k) + 1)) { xcd_barrier(bar, wv_); if ((MK_REPEAT >> 13) & 1) xcd_barrier(bar, wv_); } } while (0)
#define PHASE_WS unsigned long long wsa_ = (unsigned long long)ws0_; asm volatile("" : "+s"(wsa_)); unsigned char* const ws = (unsigned char*)(GAS unsigned char*)wsa_
#define PHASE_IDS PHASE_WS; const int tid = opaque_tid(wv_), lane = tid & 63, wave = __builtin_amdgcn_readfirstlane(tid >> 6), gw = bx * NWAVES + wave, NGW = G * NWAVES; (void)lane; (void)gw; (void)NGW

    if (IN(PH_PRE0) && (MK_PHMASK & 1)) {
        PHASE_IDS;
        LAS float* scr = (LAS float*)(lds + wave * 8448); LAS float* sil = (LAS float*)(lds + 8 * 8448);
        constexpr int I_MOD = 2 * (MODW / 32);
        if (bx * NWAVES < I_MOD) { for (int i = tid; i < 9 * D; i += NWAVES * 64) { const int r = i >> 10, k = i & 1023; const float v = r < 8 ? p.c[r * D + k] : p.c_ctx[k]; sil[i] = v / (1.f + expf(-v)); } }
        __syncthreads();
        constexpr int I_INB = (D / 64) * (IP_S * 8), I_IN8 = (D / 64) * ((27 - IP_S) * 8), I_BR = (512 / 64) * (D / 32), I_OUT = (D / 64) * (D / 32), I_GU = (D / 64) * (2048 / 32), I_DN = (D / 64) * (D / 32);
        constexpr int T_INB = 2 * I_INB, T_IN8 = 2 * I_IN8, T_BR = 6 * I_BR, T_OUT = 2 * I_OUT, T_GU = 64 * I_GU, T_DN = 64 * I_DN, NITEMS = I_MOD + T_INB + T_IN8 + T_BR + T_OUT + T_GU + T_DN;
        auto decode = [&](int r) -> CvtJob {
            if (r < T_INB) { const int l = r / (I_INB > 0 ? I_INB : 1); return CvtJob{p.w_in + (size_t)l * D * INC, ws + WS_WIN + (size_t)l * INC * D * 2, D, IP_S * 256, r % (I_INB > 0 ? I_INB : 1), 0, INC}; } r -= T_INB;
            if (r < T_IN8) { const int l = r / (I_IN8 > 0 ? I_IN8 : 1); return CvtJob{p.w_in + (size_t)l * D * INC + IP_S * 256, ws + WS_WIN8 + ((size_t)l * INC + IP_S * 256) * D, D, (27 - IP_S) * 256, r % (I_IN8 > 0 ? I_IN8 : 1), 1, INC}; } r -= T_IN8;
            if (r < T_BR) { const int q = r / I_BR, l = q / 3, br = q % 3; const float* src = (br == 0 ? p.w_br_conv : br == 1 ? p.w_br_na : p.w_br_gqa) + (size_t)l * 512 * D;
                return CvtJob{src, ws + WS_WMG + (size_t)q * D * 512 * 2, 512, D, r % I_BR, 0, D}; } r -= T_BR;
            if (r < T_OUT) { const int l = r / I_OUT; return CvtJob{p.w_out + (size_t)l * D * D, ws + WS_WOUT + (size_t)l * D * D * 2, D, D, r % I_OUT, 0, D}; } r -= T_OUT;
            if (r < T_GU) { const int q = r / I_GU; return CvtJob{p.w_gu + (size_t)q * D * 2048, ws + WS_WGU + (size_t)q * 2048 * D, D, 2048, r % I_GU, 2, 2048}; } r -= T_GU;
            const int q = r / I_DN; return CvtJob{p.w_down + (size_t)q * D * D, ws + WS_WDN + (size_t)q * D * D, D, D, r % I_DN, 1, D}; };
        REPS(0) { int it = gw; const bool st_ = !(((MK_REPEAT >> 20) & 1) && rep_ == 1);
            if (it < I_MOD) { if (!(((MK_REPEAT >> 21) & 1) && rep_ == 1)) mod_item(p, it, lane, sil); it += NGW; }
            if (it < NITEMS) {
                auto J = [&](int x) -> CvtJob { return decode(min(x, NITEMS - 1) - I_MOD); };
                CvtJob ja = J(it), jb = J(it + NGW), jc = ja; float4 wa[8], wb[8], wc[8];
                cvt_load(ja, lane, wa); cvt_load(jb, lane, wb);
                for (;;) {
                    jc = J(it + 2 * NGW); cvt_load(jc, lane, wc); cvt_finish(ja, wa, scr, lane, st_); it += NGW; if (it >= NITEMS) break;
                    ja = J(it + 2 * NGW); cvt_load(ja, lane, wa); cvt_finish(jb, wb, scr, lane, st_); it += NGW; if (it >= NITEMS) break;
                    jb = J(it + 2 * NGW); cvt_load(jb, lane, wb); cvt_finish(jc, wc, scr, lane, st_); it += NGW; if (it >= NITEMS) break;
                } } }
        for (int i = bx * 512 + tid; i < 2 * NE * D; i += G * 512) { const int ll = i >> 15, e = (i >> 10) & 31, k = i & 1023; ((_Float16*)(ws + WS_WRT))[i] = (_Float16)p.router_w[(size_t)ll * D * NE + k * NE + e]; }
        for (int i = bx * 512 + tid; i < 2 * NE * 2048; i += G * 512) { const int no = i & 2047, nd = (no & ~7) | ((no & 1) << 2) | ((no & 7) >> 1); ((float*)(ws + WS_BGU))[(i & ~2047) + nd] = p.b_gu[i]; }
        __syncthreads();
    }
    SEAM(PH_PRE0);
    if (IN(PH_PRE1) && (MK_PHMASK & 1)) {
        PHASE_IDS;
        REPS(12) for (int rowb = gw; rowb < NTOK; rowb += 4 * NGW) {
            float4 v[4][4];
#pragma unroll
            for (int q = 0; q < 4; ++q) { const int row = rowb + q * NGW; if (row < NTOK) { const float4* xr = (const float4*)(row < NLAT ? p.x + (size_t)row * D : p.ctx + (size_t)(row - NLAT) * D);
#pragma unroll
                for (int i = 0; i < 4; ++i) v[q][i] = xr[lane + 64 * i]; } }
#pragma unroll
            for (int q = 0; q < 4; ++q) { const int row = rowb + q * NGW; if (row < NTOK) { float ss = 0.f;
#pragma unroll
                for (int i = 0; i < 4; ++i) ss += v[q][i].x * v[q][i].x + v[q][i].y * v[q][i].y + v[q][i].z * v[q][i].z + v[q][i].w * v[q][i].w;
                const float r = rsqrtf(wave_sum(ss, lane) * (1.f / D) + EPS);
                { uint2* xo = (uint2*)((bf16_t*)(ws + WS_X) + (size_t)row * D);
#pragma unroll
                  for (int i = 0; i < 4; ++i) xo[lane + 64 * i] = make_uint2(pk2(v[q][i].x, v[q][i].y), pk2(v[q][i].z, v[q][i].w)); }
                norm_mod_store(v[q], r, p.norm1_g, (const float*)(ws + WS_MOD) + (size_t)mod_row(row) * MODW, ws, row, lane); } }
        }
    }
    SEAM(PH_PRE1);
#pragma unroll 1
    for (int l = 0; l < 2; ++l) {
        const int pb = PH_L0 + l * PHL_N; const bool lastl = (l == 1); const int nrows = lastl ? NLAT : NTOK;
        if (IN(pb + PHL_INPROJ) && (MK_PHMASK & 2)) {
            PHASE_WS;
            pg8::EpiStoreBf16<false> E{(bf16_t*)(ws + WS_P), INC, nullptr, 0, ATT_C2, O_NAQ / 256, O_NAK / 256, O_BGC / 256};
            constexpr int NB16 = IP_S, N8 = 27 - IP_S;
            const int t16 = lastl ? (NLAT / 256) * NB16 + (NCTX / 256) * pg8::SchedInprojR::nkv(0, NB16) : (NTOK / 256) * NB16;
            const int t8 = lastl ? (NLAT / 256) * N8 + (NCTX / 256) * pg8::SchedInprojR::nkv(NB16, N8) : (NTOK / 256) * N8;
            const int cmin = t16 % G, nf0 = t8 / G - (cmin > 0 ? 1 : 0), nfull = nf0 > 0 ? nf0 : 0;
            if (NB16 > 0) { pg8::SchedInprojR S{(const char*)(ws + WS_H), (const char*)(ws + WS_WIN) + (size_t)l * INC * D * 2, 0, NB16, G, bx, D * 2, lastl, 1 << 30, 0};
                REPS(1) pg8::gemm_phase<pg8::EpiStoreBf16<false>, pg8::SchedInprojR, true, true>(lds, pg8::Gemm{D * 2, D * 2, D * 2, 0, 0}, S, E, wv_); }
            if (N8 > 0) { pg8::SchedInprojR S{(const char*)(ws + WS_H8), (const char*)(ws + WS_WIN8) + (size_t)l * INC * D, NB16, N8, G, bx, D, lastl, nfull, cmin};
                REPS(1) pg8::gemm_phase<pg8::EpiStoreBf16<false>, pg8::SchedInprojR, true, true, true>(lds, pg8::Gemm{D, D, D, 0x7f7f7f7f, 0x79797979}, S, E, wv_); }
        }
        SEAM(pb + PHL_INPROJ);
        if (IN(pb + PHL_MIX1) && (MK_PHMASK & 64)) {
            PHASE_IDS;
            REPS(9) for (int i = bx * 512 + tid; i < nrows * 16; i += G * 512) conv_item4(p, l, i);
            REPS(9) for (int i = bx * 512 + tid; i < NTOK * 2; i += G * 512) kprep_item(p, l, i);
            __syncthreads();
            typedef attn_body::bf16 abf;
            const abf* Pq = (const abf*)(ws + WS_P); abf* Yo = (abf*)(ws + WS_Y);
            REPS(2) { const int b = bx & 7, j = bx >> 3;
#pragma unroll 1
                for (int i = 0; i < 4; ++i) { const int u = j * 4 + i, h = u >> 4, R0 = (u & 15) * 4; const size_t row0 = (size_t)b * SEQ + R0 * 64;
                    const int rs0 = min(max(R0 - 4, 0), 56), rlast = min(max(R0 - 1, 0), 56) + 7; int NT = 4 + (rlast - rs0 + 1); NT += NT & 1;
                    const attn_body::NaArgs na{(long)NLAT + (long)b * CTXL, (long)b * SEQ + (long)rs0 * 64, R0, rs0, p.na_rpb + ((size_t)l * 8 + h) * 465};
                    attn_body::attn_unit<8, true>(Pq + row0 * INC + O_NAQ + h * 64, INC, Pq + O_NAK + h * 64, INC, Pq + O_NAV + h * 64, INC, Yo + row0 * 1536 + 512 + h * 64, 1536, NT, (char*)lds_raw, na, wv_); } }
        }
        SEAM(pb + PHL_MIX1);
        if (IN(pb + PHL_MIX2) && (MK_PHMASK & 128)) {
            PHASE_WS;
            typedef attn_body::bf16 abf;
            const abf* Pq = (const abf*)(ws + WS_P); const abf* Kg = (const abf*)(ws + WS_KG); const abf* Vg = (const abf*)(ws + WS_VG); abf* Yo = (abf*)(ws + WS_Y);
            REPS(3) { const int b = bx & 7, j = bx >> 3;
#pragma unroll 1
                for (int i = 0; i < 4; ++i) { const int u = j * 4 + i, h = u >> 4, qb = u & 15; const size_t row0 = (size_t)b * SEQ + qb * 256;
                    attn_body::attn_unit<8, false>(Pq + row0 * INC + O_GQ + h * 64, INC, Kg + ((size_t)b * KVLEN * 2 + (h >> 2)) * 64, 128, Vg + ((size_t)b * KVLEN * 2 + (h >> 2)) * 64, 128,
                                            Yo + row0 * 1536 + 1024 + h * 64, 1536, KVLEN / 64, (char*)lds_raw, attn_body::NaArgs{}, wv_, 1, p.q_norm_g + l * 64, qb * 256); } }
            if (!lastl && bx < 128) {
                const int kind = bx >> 6, b = (bx >> 3) & 7, h = bx & 7; const size_t row0 = (size_t)NLAT + (size_t)b * CTXL;
                if (kind == 0) attn_body::attn_unit<8, false>(Pq + row0 * INC + O_GQ + h * 64, INC, Kg + (((size_t)b * KVLEN + SEQ) * 2 + (h >> 2)) * 64, 128, Vg + (((size_t)b * KVLEN + SEQ) * 2 + (h >> 2)) * 64, 128,
                                                       Yo + row0 * 1536 + 1024 + h * 64, 1536, CTXL / 64, (char*)lds_raw, attn_body::NaArgs{}, wv_, 2, p.q_norm_g + l * 64, 0);
                else attn_body::attn_unit<8, false>(Pq + row0 * INC + O_NAQ + h * 64, INC, Pq + row0 * INC + O_NAK + h * 64, INC, Pq + row0 * INC + O_NAV + h * 64, INC,
                                             Yo + row0 * 1536 + 512 + h * 64, 1536, CTXL / 64, (char*)lds_raw, attn_body::NaArgs{}, wv_);
            }
        }
        SEAM(pb + PHL_MIX2);
        if (IN(pb + PHL_MERGE) && (MK_PHMASK & 4)) {
            PHASE_WS;
            pg8::SchedMerge S{(const char*)(ws + WS_Y), (const char*)(ws + WS_WMG) + (size_t)l * 3 * D * 512 * 2, !lastl, G, bx};
            pg8::EpiMergeF E{(const bf16_t*)(ws + WS_P), (bf16_t*)(ws + WS_M)};
            REPS(14) pg8::gemm_phase<pg8::EpiMergeF, pg8::SchedMerge, true, true, false, false, true>(lds, pg8::Gemm{512 * 2, 1536 * 2, 512 * 2, 0, 0}, S, E, wv_);
            if ((MK_REPEAT >> 4) & 1) { pg8::EpiNull EN{(float*)(ws + WS_CTL) + 8000}; pg8::gemm_phase<pg8::EpiNull, pg8::SchedMerge, true, true, false, false, true>(lds, pg8::Gemm{512 * 2, 1536 * 2, 512 * 2, 0, 0}, S, EN, wv_); }
        }
        SEAM(pb + PHL_MERGE);
        if (IN(pb + PHL_OUT) && (MK_PHMASK & 8)) {
            PHASE_WS;
            pg8::SchedOut S{(const char*)(ws + WS_M), (const char*)(ws + WS_WOUT) + (size_t)l * D * D * 2, !lastl, G, bx};
            REPS(10) { pg8::EpiOutF E{(bf16_t*)(ws + WS_X), (const float*)(ws + WS_MOD) + (size_t)l * 9 * MODW, rep_ ? 0.f : 1.f};
                pg8::gemm_phase<pg8::EpiOutF, pg8::SchedOut, true, true, false, false, true>(lds, pg8::Gemm{D * 2, D * 2, D * 2, 0, 0}, S, E, wv_); }
        }
        SEAM(pb + PHL_OUT);
        if (IN(pb + PHL_ROUTE) && (MK_PHMASK & 256)) {
            PHASE_IDS;
            typedef _Float16 h8 __attribute__((ext_vector_type(8))); typedef _Float16 h2v __attribute__((ext_vector_type(2)));
            const int tpb = nrows / NRB, nblk = tpb / 4; LAS int* hist = (LAS int*)(lds + HIST_OFF);
            if (tid < 32) hist[tid] = 0;
            { const pg8::u32x4* src = (const pg8::u32x4*)((const _Float16*)(ws + WS_WRT) + (size_t)l * NE * D);
                for (int c = tid; c < NE * 128; c += NWAVES * 64) { const int e = c >> 7, ch = c & 127; *(LAS pg8::u32x4*)(lds + 65536 + e * 2048 + ((ch ^ (e & 15)) << 4)) = src[c]; } }
            __syncthreads();
            LAS unsigned char* hs = lds + wave * 8192;
            LAS float* ls = (LAS float*)(lds + LDSCTL_OFF + 8192) + wave * 128;
            const float* gain = p.norm2_g + l * D; const int r16 = lane & 15, kq = lane >> 4, arow = r16 & 3;
            REPS(7) { uint2 xw[4][4];
#define ROUTE_LOAD(b_) do { const int rb_ = bx * tpb + min((b_), nblk - 1) * 4; _Pragma("unroll") for (int rr = 0; rr < 4; ++rr) { const uint2* xr = (const uint2*)((const bf16_t*)(ws + WS_X) + (size_t)(rb_ + rr) * D); \
                    _Pragma("unroll") for (int i = 0; i < 4; ++i) xw[rr][i] = xr[lane + 64 * i]; } } while (0)
              ROUTE_LOAD(wave);
              for (int blk = wave; blk < nblk; blk += NWAVES) {
                const int row0 = bx * tpb + blk * 4;
#pragma unroll
                for (int rr = 0; rr < 4; ++rr) { const int row = row0 + rr; float ss = 0.f; float4 xv[4];
#pragma unroll
                    for (int i = 0; i < 4; ++i) { const uint2 w = xw[rr][i]; xv[i] = make_float4(bf2f(w.x & 0xffff), bf2f(w.x >> 16), bf2f(w.y & 0xffff), bf2f(w.y >> 16)); ss += xv[i].x * xv[i].x + xv[i].y * xv[i].y + xv[i].z * xv[i].z + xv[i].w * xv[i].w; }
                    const float r = rsqrtf(wave_sum(ss, lane) * (1.f / D) + EPS);
                    const float* m = (const float*)(ws + WS_MOD) + ((size_t)l * 9 + mod_row(row)) * MODW + 3 * D; int* ho = (int*)(ws + WS_H + (size_t)row * D);
#pragma unroll
                    for (int i = 0; i < 4; ++i) { const int c4 = lane + 64 * i; const float4 g = ((const float4*)gain)[c4], sh = ((const float4*)m)[c4], sc = ((const float4*)(m + D))[c4]; const float4 v = xv[i];
                        const float h0 = v.x * r * g.x * (1.f + sc.x) + sh.x, h1 = v.y * r * g.y * (1.f + sc.y) + sh.y, h2 = v.z * r * g.z * (1.f + sc.z) + sh.z, h3 = v.w * r * g.w * (1.f + sc.w) + sh.w;
                        { int w8 = __builtin_amdgcn_cvt_pk_fp8_f32(h0, h1, 0, false); w8 = __builtin_amdgcn_cvt_pk_fp8_f32(h2, h3, w8, true); ho[c4] = w8; }
                        const h2v f01 = {(_Float16)h0, (_Float16)h1}, f23 = {(_Float16)h2, (_Float16)h3};
                        *(LAS pg8::u32x2*)(hs + rr * 2048 + ((((c4 >> 1) ^ rr)) << 4) + (c4 & 1) * 8) = (pg8::u32x2){__builtin_bit_cast(unsigned, f01), __builtin_bit_cast(unsigned, f23)}; } }
                asm volatile("s_waitcnt lgkmcnt(0)" ::: "memory");
                ROUTE_LOAD(blk + NWAVES);
                float zr_; asm volatile("v_mov_b32 %0, 0" : "=v"(zr_)); pg8::f32x4 acc0 = {zr_, zr_, zr_, zr_}, acc1 = {zr_, zr_, zr_, zr_};
#pragma unroll 8
                for (int s = 0; s < 32; ++s) { const int ch = 4 * s + kq;
                    const h8 a = *(const LAS h8*)(hs + arow * 2048 + ((ch ^ arow) << 4));
                    const h8 b0 = *(const LAS h8*)(lds + 65536 + r16 * 2048 + ((ch ^ r16) << 4)), b1 = *(const LAS h8*)(lds + 65536 + (r16 + 16) * 2048 + ((ch ^ r16) << 4));
                    acc0 = __builtin_amdgcn_mfma_f32_16x16x32_f16(a, b0, acc0, 0, 0, 0); acc1 = __builtin_amdgcn_mfma_f32_16x16x32_f16(a, b1, acc1, 0, 0, 0); }
                if (kq == 0) {
#pragma unroll
                    for (int reg = 0; reg < 4; ++reg) { ls[reg * 32 + r16] = acc0[reg]; ls[reg * 32 + 16 + r16] = acc1[reg]; } }
                asm volatile("s_waitcnt lgkmcnt(0)" ::: "memory");
                if (lane < 4) { float lg[32];
#pragma unroll
                    for (int e = 0; e < 32; ++e) lg[e] = ls[lane * 32 + e] + p.router_b[l * NE + e];
                    const unsigned es = top4_store(p, row0 + lane, lg);
                    if (rep_ == 0) {
#pragma unroll
                        for (int k = 0; k < 4; ++k) __hip_atomic_fetch_add(hist + ((es >> (8 * k)) & 255u), 1, __ATOMIC_RELAXED, __HIP_MEMORY_SCOPE_WORKGROUP); } }
                asm volatile("s_waitcnt lgkmcnt(0)" ::: "memory");
              }
#undef ROUTE_LOAD
            }
            __syncthreads();
            if (tid < 32) ((int*)(ws + WS_BCNT))[(l * NRB + bx) * 32 + tid] = hist[tid];
        }
        SEAM(pb + PHL_ROUTE);
        if (IN(pb + PHL_SCAN) && (MK_PHMASK & 512)) {
            PHASE_IDS;
            const int tpb = nrows / NRB, nent = tpb * 4;
            LAS int* part = (LAS int*)(lds + SC_PART_OFF); LAS int* tot = (LAS int*)(lds + SC_TOT_OFF); LAS int* base = (LAS int*)(lds + SC_BASE_OFF); LAS int* seoff = (LAS int*)(lds + SC_EOFF_OFF);
            LAS int* wcnt = (LAS int*)(lds + SC_WCNT_OFF); LAS int* sslot = (LAS int*)(lds + SC_SLOT_OFF);
            const int* bc = (const int*)(ws + WS_BCNT) + l * NRB * 32;
            { const int e = tid & 31, ch = tid >> 5; int sa = 0, sb = 0;
                for (int i = 0; i < 16; ++i) { const int b = ch * 16 + i; const int c = bc[b * 32 + e]; sa += c; sb += (b < bx) ? c : 0; }
                part[ch * 32 + e] = sa; part[512 + ch * 32 + e] = sb; }
            __syncthreads();
            if (tid < 32) { int ta = 0, tb = 0; for (int ch = 0; ch < 16; ++ch) { ta += part[ch * 32 + tid]; tb += part[512 + ch * 32 + tid]; } tot[tid] = ta; base[tid] = tb; }
            __syncthreads();
            if (tid == 0) { int o = 0; for (int i = 0; i < 32; ++i) { seoff[i] = o; o += (tot[i] + 255) & ~255; } seoff[32] = o; }
            __syncthreads();
            if (bx == 0 && tid <= 32) ((int*)(ws + WS_EOFF))[l * 64 + tid] = seoff[tid];
            const int* te = (const int*)(ws + WS_TOKE) + (size_t)bx * nent; int* ts = (int*)(ws + WS_TOKS) + (size_t)bx * nent;
            int mye[2], myrank[2];
#pragma unroll
            for (int rep = 0; rep < 2; ++rep) { const int chunk = wave + 8 * rep, i = chunk * 64 + lane; int e = -1, rank = 0;
                if (chunk * 64 < nent) { if (i < nent) e = te[i];
                    for (int ee = 0; ee < 32; ++ee) { const unsigned long long mk = __ballot(e == ee); if (e == ee) rank = __popcll(mk & ((1ull << lane) - 1ull)); if (lane == 0) wcnt[chunk * 32 + ee] = __popcll(mk); } }
                mye[rep] = e; myrank[rep] = rank; }
            __syncthreads();
#pragma unroll
            for (int rep = 0; rep < 2; ++rep) if (mye[rep] >= 0) { const int chunk = wave + 8 * rep, i = chunk * 64 + lane, e = mye[rep]; int cb = 0;
                for (int c = 0; c < chunk; ++c) cb += wcnt[c * 32 + e];
                const int slot = seoff[e] + base[e] + cb + myrank[rep]; ts[i] = slot; ((int*)(ws + WS_STOK))[slot] = bx * tpb + (i >> 2); }
            __syncthreads();
            if (bx < NE) { const int s0 = seoff[bx] + tot[bx], s1 = seoff[bx + 1]; for (int s = s0 + tid; s < s1; s += NWAVES * 64) ((int*)(ws + WS_STOK))[s] = 0; }
        }
        SEAM(pb + PHL_SCAN);
        if ((IN(pb + PHL_GEMM1) || IN(pb + PHL_GEMM2)) && (MK_PHMASK & 48)) {
            PHASE_WS;
            const int tid0 = opaque_tid(wv_);
            if (tid0 < 64) ((LAS int*)(lds + EOFF_OFF))[tid0] = tid0 <= NE ? (int)__hip_atomic_load((unsigned*)(ws + WS_EOFF) + l * 64 + tid0, __ATOMIC_RELAXED, __HIP_MEMORY_SCOPE_AGENT) : 0;
            __syncthreads();
        }
        if (IN(pb + PHL_GEMM1) && (MK_PHMASK & 16)) {
            PHASE_WS;
            pg8::SchedMoe S{(const char*)(ws + WS_H), (const char*)(ws + WS_WGU) + (size_t)l * NE * 2048 * D, (const LAS int*)(lds + EOFF_OFF), 8, G, bx, (size_t)2048 * D, D, true};
            pg8::EpiGUF E{ws + WS_A, (const float*)(ws + WS_BGU) + (size_t)l * NE * 2048, false};
            if ((MK_REPEAT >> 17) & 3) { pg8::EpiGUF E0{ws + WS_A, (const float*)(ws + WS_BGU) + (size_t)l * NE * 2048, ((MK_REPEAT >> 17) & 3) == 2};
                pg8::gemm_phase<pg8::EpiGUF, pg8::SchedMoe, true, true, true, true>(lds, pg8::Gemm{D, D, D, 0x7f7f7f7f, 0x79797979}, S, E0, wv_, (const int*)(ws + WS_STOK), (LAS int*)(lds + GTAB_OFF), (LAS float*)(lds + LBIAS_OFF)); }
            REPS(5) pg8::gemm_phase<pg8::EpiGUF, pg8::SchedMoe, true, true, true, true>(lds, pg8::Gemm{D, D, D, 0x7f7f7f7f, 0x79797979}, S, E, wv_, (const int*)(ws + WS_STOK), (LAS int*)(lds + GTAB_OFF), (LAS float*)(lds + LBIAS_OFF));
        }
        SEAM(pb + PHL_GEMM1);
        if (IN(pb + PHL_GEMM2) && (MK_PHMASK & 32)) {
            PHASE_WS;
            pg8::SchedMoe S{(const char*)(ws + WS_A), (const char*)(ws + WS_WDN) + (size_t)l * NE * D * D, (const LAS int*)(lds + EOFF_OFF), 4, G, bx, (size_t)D * D, D, false};
            pg8::EpiStoreF8 E{ws + WS_YB, D, p.b_down + (size_t)l * NE * D, D, YB_SCALE};
            REPS(6) pg8::gemm_phase<pg8::EpiStoreF8, pg8::SchedMoe, true, true, true>(lds, pg8::Gemm{D, D, D, 0x7d7d7d7d, 0x79797979}, S, E, wv_, nullptr, nullptr, (LAS float*)(lds + LBIAS_OFF));
        }
        SEAM(pb + PHL_GEMM2);
        if (IN(pb + PHL_COMB) && (MK_PHMASK & 1024)) {
            PHASE_IDS;
            REPS(11) for (int row = gw; row < nrows; row += 3 * NGW) combine_rows<3>(p, l, lastl ? 1 : 0, row, NGW, nrows, lane, rep_ ? 0.f : 1.f);
        }
        SEAM(pb + PHL_COMB);
    }
#undef IN
#undef SEAM
#undef PHASE_IDS
}

#ifndef MK_N_LAUNCHES
#define MK_N_LAUNCHES 1
#endif
static int g_grid = 0;
static void launch_mk(const Ptrs& p, int lo, int hi, hipStream_t stream) {
    MkArgs a{}; a.p = p; a.ph_lo = lo; a.ph_hi = hi;
    hipLaunchKernelGGL(mk_fwd, dim3(g_grid), dim3(NWAVES * 64), LDS_BYTES, stream, a);
    const hipError_t le = hipPeekAtLastError();
    if (le != hipSuccess) fprintf(stderr, "kernel_launch: mk_fwd[%d,%d) launch failed: %s\n", lo, hi, hipGetErrorName(le));
}
extern "C" void kernel_launch(void* const* d_in, const int* in_sizes, int n_in, void* d_out, int out_size, void* d_ws, size_t ws_size, hipStream_t stream) {
    if (n_in != 24 || ws_size < WS_END) { fprintf(stderr, "kernel_launch: unexpected n_in %d / ws %zu (need %zu)\n", n_in, ws_size, (size_t)WS_END); return; }
    if (g_grid == 0) {
        int dev = 0, cus = 0, per_cu = 0;
        if (hipGetDevice(&dev) != hipSuccess || hipDeviceGetAttribute(&cus, hipDeviceAttributeMultiprocessorCount, dev) != hipSuccess) { fprintf(stderr, "kernel_launch: device query failed\n"); g_grid = -1; return; }
        if (hipFuncSetAttribute((const void*)mk_fwd, hipFuncAttributeMaxDynamicSharedMemorySize, LDS_BYTES) != hipSuccess) { fprintf(stderr, "kernel_launch: hipFuncSetAttribute failed\n"); g_grid = -1; return; }
        if (hipOccupancyMaxActiveBlocksPerMultiprocessor(&per_cu, (const void*)mk_fwd, NWAVES * 64, LDS_BYTES) != hipSuccess || per_cu < 1) fprintf(stderr, "kernel_launch: occupancy query reports %d\n", per_cu);
        (void)hipGetLastError();
        g_grid = cus;
        if (g_grid != NRB) { fprintf(stderr, "kernel_launch: %d CUs, this kernel is written for %d\n", cus, NRB); g_grid = NRB; }
    }
    if (g_grid < 0) return;
    Ptrs p{};
    const float** pp = (const float**)&p; for (int i = 0; i < 24; ++i) pp[i] = (const float*)d_in[i];
    p.out = (float*)d_out; p.ws = (unsigned char*)d_ws;
    (void)hipMemsetAsync(p.ws + WS_CTL, 0, 65536, stream);
    if (MK_N_LAUNCHES == 1) launch_mk(p, 0, PH_END, stream);
    else for (int ph = 0; ph < PH_END; ++ph) launch_mk(p, ph, ph + 1, stream);
}
```

```cpp
#include <hip/hip_runtime.h>
#include <stdint.h>
#include <stdio.h>

typedef unsigned short bf16_t;
#define LAS __attribute__((address_space(3)))
#define GAS __attribute__((address_space(1)))
__device__ __forceinline__ float bf2f(unsigned b) { return __uint_as_float(b << 16); }
__device__ __forceinline__ unsigned f2bf(float f) { unsigned u = __float_as_uint(f); return (u + 0x7fffu + ((u >> 16) & 1u)) >> 16; }
__device__ __forceinline__ unsigned pk2(float lo, float hi) { return f2bf(lo) | (f2bf(hi) << 16); }

constexpr int D = 1024, NB = 8, SEQ = 4096, CTXL = 256, NLAT = NB * SEQ, NCTX = NB * CTXL, NTOK = NLAT + NCTX;
constexpr int INC = 6912, MODW = 6144;
constexpr int O_CB = 0, O_CC = 512, O_CX = 1024, O_NAQ = 1536, O_NAK = 2048, O_NAV = 2560, O_GQ = 3072, O_GK = 3584, O_GV = 3712, O_BGC = 3840, O_BGN = 4864, O_BGG = 5888;
constexpr int NE = 32, TOPK = 4, KVLEN = SEQ + CTXL;
constexpr int MPAD = 147456;
constexpr int NRB = 256;
constexpr float EPS = 1e-6f;
constexpr float YB_SCALE = 8.f;

constexpr size_t al256(size_t x) { return (x + 255) & ~(size_t)255; }
constexpr size_t WS_CTL = 0;
constexpr int CW_BAR = 4096;
constexpr size_t WS_MOD = 1 << 20;
constexpr size_t WS_TOKE = WS_MOD + al256(2 * 9 * MODW * 4);
constexpr size_t WS_TOKG = WS_TOKE + al256((size_t)NTOK * 16);
constexpr size_t WS_TOKS = WS_TOKG + al256((size_t)NTOK * 16);
constexpr size_t WS_BCNT = WS_TOKS + al256((size_t)NTOK * 16);
constexpr size_t WS_EOFF = WS_BCNT + al256(2 * NRB * 32 * 4);
constexpr size_t WS_STOK = al256(WS_EOFF + 512);
constexpr size_t WS_X = al256(WS_STOK + (size_t)MPAD * 4);
constexpr size_t WS_H = WS_X + (size_t)NTOK * D * 4;
constexpr size_t WS_KG = WS_H + (size_t)NTOK * D * 2;
constexpr size_t WS_VG = WS_KG + (size_t)NB * KVLEN * 128 * 2;
constexpr size_t WS_R1 = WS_VG + (size_t)NB * KVLEN * 128 * 2;
constexpr size_t WS_P = WS_R1;
constexpr size_t WS_Y = WS_P + (size_t)NTOK * INC * 2;
constexpr size_t WS_M = WS_Y + (size_t)NTOK * 1536 * 2;
constexpr size_t WS_XG = WS_R1;
constexpr size_t WS_A = WS_XG + (size_t)MPAD * D;
constexpr size_t WS_YB = WS_A + (size_t)MPAD * D;
constexpr size_t WS_R1_END = (WS_M + (size_t)NTOK * D * 2) > (WS_YB + (size_t)MPAD * D * 2) ? (WS_M + (size_t)NTOK * D * 2) : (WS_YB + (size_t)MPAD * D * 2);
constexpr size_t WS_WIN = al256(WS_R1_END);
constexpr size_t WS_WMG = WS_WIN + (size_t)2 * INC * D * 2;
constexpr size_t WS_WOUT = WS_WMG + (size_t)2 * 3 * D * 512 * 2;
constexpr size_t WS_WGU = WS_WOUT + (size_t)2 * D * D * 2;
constexpr size_t WS_WDN = WS_WGU + (size_t)2 * NE * 2048 * D;
constexpr size_t WS_BGU = WS_WDN + (size_t)2 * NE * D * D;
constexpr size_t WS_WRT = WS_BGU + (size_t)2 * NE * 2048 * 4;
constexpr size_t WS_H8 = al256(WS_WRT + (size_t)2 * NE * D * 2);
constexpr size_t WS_WIN8 = WS_H8 + (size_t)NTOK * D;
constexpr size_t WS_END = WS_WIN8 + (size_t)2 * INC * D;
#ifndef INPROJ_SPLIT
#define INPROJ_SPLIT 6
#endif
constexpr int IP_S = INPROJ_SPLIT;

struct Ptrs {
    const float *x, *c, *ctx, *c_ctx, *ada_w, *ada_b, *norm1_g, *norm2_g, *w_in, *conv_w, *na_rpb, *q_norm_g, *k_norm_g;
    const float *w_br_conv, *w_br_na, *w_br_gqa, *w_out, *router_w, *router_b, *w_gu, *b_gu, *w_down, *b_down, *final_g;
    float* out; unsigned char* ws;
};

__device__ __forceinline__ int mod_row(int row) { return row < NLAT ? row / SEQ : 8; }
__device__ __forceinline__ float lane_xor(float v, int lane, int o) { return __int_as_float(__builtin_amdgcn_ds_bpermute((lane ^ o) << 2, __float_as_int(v))); }
__device__ __forceinline__ float wave_sum(float v, int lane) {
#pragma unroll
    for (int o = 1; o < 64; o <<= 1) v += lane_xor(v, lane, o);
    return v;
}
__device__ __forceinline__ int opaque_tid(int wv) { int l; asm volatile("v_mbcnt_lo_u32_b32 %0, -1, 0\n\tv_mbcnt_hi_u32_b32 %0, -1, %0" : "=v"(l)); return wv * 64 + l; }

__device__ __forceinline__ void sincos_small(float a, float& s, float& c) {
    const float k = rintf(a * 0.6366197723675814f); const float r = ((a - k * 1.5703125f) - k * 4.837512969970703125e-4f) - k * 7.54978995489188216e-8f; const float r2 = r * r;
    const float sr = r + r * r2 * (-1.6666654611e-1f + r2 * (8.3321608736e-3f + r2 * (-1.9515295891e-4f)));
    const float cr = 1.f - 0.5f * r2 + r2 * r2 * (4.166664568298827e-2f + r2 * (-1.388731625493765e-3f + r2 * 2.443315711809948e-5f));
    const int q = ((int)k) & 3; s = (q == 0) ? sr : (q == 1) ? cr : (q == 2) ? -sr : -cr; c = (q == 0) ? cr : (q == 1) ? -sr : (q == 2) ? -cr : sr;
}
__device__ __forceinline__ void head_norm_rope(float (&v)[64], const float* g, bool rope, int t) {
    float ss = 0.f;
#pragma unroll
    for (int d = 0; d < 64; ++d) ss += v[d] * v[d];
    const float r = rsqrtf(ss * (1.f / 64.f) + EPS);
#pragma unroll
    for (int d = 0; d < 64; ++d) v[d] = v[d] * r * g[d];
    if (rope) {
        const float pr = (float)(t / 64), pc = (float)(t % 64);
#pragma unroll
        for (int i = 0; i < 16; ++i) { const float inv = exp2f(-(float)i * 0.8304820237218406f);
            { float cs, sn; sincos_small(pr * inv, sn, cs); const float x1 = v[i], x2 = v[16 + i]; v[i] = x1 * cs - x2 * sn; v[16 + i] = x1 * sn + x2 * cs; }
            { float cs, sn; sincos_small(pc * inv, sn, cs); const float x1 = v[32 + i], x2 = v[48 + i]; v[32 + i] = x1 * cs - x2 * sn; v[48 + i] = x1 * sn + x2 * cs; } }
    }
}
__device__ __forceinline__ void load64(float (&v)[64], const bf16_t* src) {
#pragma unroll
    for (int i = 0; i < 8; ++i) { const uint4 w = ((const uint4*)src)[i];
        v[8 * i + 0] = bf2f(w.x & 0xffff); v[8 * i + 1] = bf2f(w.x >> 16); v[8 * i + 2] = bf2f(w.y & 0xffff); v[8 * i + 3] = bf2f(w.y >> 16);
        v[8 * i + 4] = bf2f(w.z & 0xffff); v[8 * i + 5] = bf2f(w.z >> 16); v[8 * i + 6] = bf2f(w.w & 0xffff); v[8 * i + 7] = bf2f(w.w >> 16); }
}
__device__ __forceinline__ void store64(bf16_t* dst, const float (&v)[64]) {
#pragma unroll
    for (int i = 0; i < 8; ++i) { uint4 w; w.x = pk2(v[8 * i], v[8 * i + 1]); w.y = pk2(v[8 * i + 2], v[8 * i + 3]); w.z = pk2(v[8 * i + 4], v[8 * i + 5]); w.w = pk2(v[8 * i + 6], v[8 * i + 7]); ((uint4*)dst)[i] = w; }
}

__device__ __forceinline__ void norm_mod_store(const float4 (&v)[4], float r, const float* gain, const float* m, unsigned char* ws_, int row, int lane) {
    uint2* hb = (uint2*)((bf16_t*)(ws_ + WS_H) + (size_t)row * D); int* ho = (int*)(ws_ + WS_H8 + (size_t)row * D);
#pragma unroll
    for (int i = 0; i < 4; ++i) { const int c4 = lane + 64 * i; const float4 g = ((const float4*)gain)[c4], sh = ((const float4*)m)[c4], sc = ((const float4*)(m + D))[c4];
        const float h0 = v[i].x * r * g.x * (1.f + sc.x) + sh.x, h1 = v[i].y * r * g.y * (1.f + sc.y) + sh.y, h2 = v[i].z * r * g.z * (1.f + sc.z) + sh.z, h3 = v[i].w * r * g.w * (1.f + sc.w) + sh.w;
        if (IP_S > 0) { uint2 o; o.x = pk2(h0, h1); o.y = pk2(h2, h3); hb[c4] = o; }
        if (IP_S < 27) { int w8 = __builtin_amdgcn_cvt_pk_fp8_f32(h0, h1, 0, false); w8 = __builtin_amdgcn_cvt_pk_fp8_f32(h2, h3, w8, true); ho[c4] = w8; } }
}
__device__ __forceinline__ void mod_item(const Ptrs& p, int item, int lane, const LAS float* sil) {
    const int l = item / (MODW / 32), cb = item % (MODW / 32), kq = lane >> 3, cq = lane & 7;
    const float* w = p.ada_w + (size_t)l * D * MODW + cb * 32 + cq * 4;
    float4 acc[9];
#pragma unroll
    for (int r = 0; r < 9; ++r) acc[r] = make_float4(0.f, 0.f, 0.f, 0.f);
#pragma unroll 16
    for (int k = kq; k < D; k += 8) { const float4 wv = *(const float4*)(w + (size_t)k * MODW);
#pragma unroll
        for (int r = 0; r < 9; ++r) { const float s = sil[r * D + k]; acc[r].x += s * wv.x; acc[r].y += s * wv.y; acc[r].z += s * wv.z; acc[r].w += s * wv.w; } }
#pragma unroll
    for (int r = 0; r < 9; ++r)
#pragma unroll
        for (int o = 8; o < 64; o <<= 1) { acc[r].x += lane_xor(acc[r].x, lane, o); acc[r].y += lane_xor(acc[r].y, lane, o); acc[r].z += lane_xor(acc[r].z, lane, o); acc[r].w += lane_xor(acc[r].w, lane, o); }
    if (kq == 0) { const float4 b = *(const float4*)(p.ada_b + l * MODW + cb * 32 + cq * 4);
#pragma unroll
        for (int r = 0; r < 9; ++r) *(float4*)((float*)(p.ws + WS_MOD) + ((size_t)l * 9 + r) * MODW + cb * 32 + cq * 4) = make_float4(acc[r].x + b.x, acc[r].y + b.y, acc[r].z + b.z, acc[r].w + b.w); }
}
__device__ __forceinline__ void conv_item4(const Ptrs& p, int layer, int item) {
    const int row0 = (item >> 6) * 4, c8 = (item & 63) * 8;
    const bf16_t* P = (const bf16_t*)(p.ws + WS_P); const float* w = p.conv_w + layer * 3 * 512 + c8;
    int t0, T; if (row0 < NLAT) { t0 = row0 % SEQ; T = SEQ; } else { t0 = (row0 - NLAT) % CTXL; T = CTXL; }
    const bf16_t* pr = P + (size_t)row0 * INC + c8;
    const uint4 z4 = make_uint4(0, 0, 0, 0);
    uint4 cc[6], cx[6], cb[4];
#pragma unroll
    for (int j = 0; j < 6; ++j) { const bool ok = (j > 0 || t0 > 0) && (j < 5 || t0 + 4 < T); cc[j] = ok ? *(const uint4*)(pr + (j - 1) * INC + O_CC) : z4; cx[j] = ok ? *(const uint4*)(pr + (j - 1) * INC + O_CX) : z4; }
#pragma unroll
    for (int j = 0; j < 4; ++j) cb[j] = *(const uint4*)(pr + j * INC + O_CB);
    float u[6][8];
#pragma unroll
    for (int j = 0; j < 6; ++j) { const unsigned a[4] = {cc[j].x, cc[j].y, cc[j].z, cc[j].w}, x[4] = {cx[j].x, cx[j].y, cx[j].z, cx[j].w};
#pragma unroll
        for (int q = 0; q < 4; ++q) { u[j][2 * q] = bf2f(a[q] & 0xffff) * bf2f(x[q] & 0xffff); u[j][2 * q + 1] = bf2f(a[q] >> 16) * bf2f(x[q] >> 16); } }
    float w0[8], w1[8], w2[8];
#pragma unroll
    for (int c = 0; c < 8; ++c) { w0[c] = w[c]; w1[c] = w[512 + c]; w2[c] = w[1024 + c]; }
#pragma unroll
    for (int j = 0; j < 4; ++j) { const unsigned bw[4] = {cb[j].x, cb[j].y, cb[j].z, cb[j].w}; unsigned o[4];
#pragma unroll
        for (int q = 0; q < 4; ++q) { const float r0 = bf2f(bw[q] & 0xffff) * (w0[2 * q] * u[j][2 * q] + w1[2 * q] * u[j + 1][2 * q] + w2[2 * q] * u[j + 2][2 * q]);
            const float r1 = bf2f(bw[q] >> 16) * (w0[2 * q + 1] * u[j][2 * q + 1] + w1[2 * q + 1] * u[j + 1][2 * q + 1] + w2[2 * q + 1] * u[j + 2][2 * q + 1]); o[q] = pk2(r0, r1); }
        *(uint4*)((bf16_t*)(p.ws + WS_Y) + (size_t)(row0 + j) * 1536 + c8) = make_uint4(o[0], o[1], o[2], o[3]); }
}
__device__ __forceinline__ void kprep_item(const Ptrs& p, int layer, int i) {
    const int row = i >> 1, kvh = i & 1;
    const bf16_t* pr = (const bf16_t*)(p.ws + WS_P) + (size_t)row * INC;
    int b, pos, t; if (row < NLAT) { b = row / SEQ; t = row % SEQ; pos = t; } else { b = (row - NLAT) / CTXL; t = 0; pos = SEQ + (row - NLAT) % CTXL; }
    float v[64]; load64(v, pr + O_GK + kvh * 64); head_norm_rope(v, p.k_norm_g + layer * 64, row < NLAT, t);
    const size_t o = (((size_t)b * KVLEN + pos) * 2 + kvh) * 64;
    store64((bf16_t*)(p.ws + WS_KG) + o, v);
    const uint4* s = (const uint4*)(pr + O_GV + kvh * 64); uint4* d = (uint4*)((bf16_t*)(p.ws + WS_VG) + o);
#pragma unroll
    for (int j = 0; j < 8; ++j) d[j] = s[j];
}
constexpr float ATT_C2 = 0.125f * 1.4426950408889634f;
__device__ __forceinline__ void qprep_item(const Ptrs& p, int layer, int i) {
    const int row = i >> 3, h = i & 7; bf16_t* pr = (bf16_t*)(p.ws + WS_P) + (size_t)row * INC;
    float v[64]; load64(v, pr + O_GQ + h * 64); head_norm_rope(v, p.q_norm_g + layer * 64, row < NLAT, row < NLAT ? row % SEQ : 0);
#pragma unroll
    for (int d = 0; d < 64; ++d) v[d] *= ATT_C2;
    store64(pr + O_GQ + h * 64, v);
}
#define ATT_STEP(kp, vp, bias) do { float kv_[64]; load64(kv_, kp); float s_ = 0.f; _Pragma("unroll") for (int d = 0; d < 64; ++d) s_ += q[d] * kv_[d]; s_ = s_ * 0.125f + (bias); \
    const float mn_ = fmaxf(mx, s_), cr_ = __expf(mx - mn_), pp_ = __expf(s_ - mn_); l = l * cr_ + pp_; mx = mn_; load64(kv_, vp); _Pragma("unroll") for (int d = 0; d < 64; ++d) o[d] = o[d] * cr_ + pp_ * kv_[d]; } while (0)
__device__ __forceinline__ void gqa_ref_item(const Ptrs& p, int layer, int i) {
    const int t = i & (SEQ - 1), h = (i >> 12) & 7, b = i >> 15, row = b * SEQ + t;
    float q[64]; load64(q, (const bf16_t*)(p.ws + WS_P) + (size_t)row * INC + O_GQ + h * 64); head_norm_rope(q, p.q_norm_g + layer * 64, true, t);
    float o[64]; float mx = -1e30f, l = 0.f;
#pragma unroll
    for (int d = 0; d < 64; ++d) o[d] = 0.f;
    const bf16_t* kb = (const bf16_t*)(p.ws + WS_KG) + ((size_t)b * KVLEN * 2 + (h >> 2)) * 64; const bf16_t* vb = (const bf16_t*)(p.ws + WS_VG) + ((size_t)b * KVLEN * 2 + (h >> 2)) * 64;
    for (int j = 0; j < KVLEN; ++j) ATT_STEP(kb + (size_t)j * 128, vb + (size_t)j * 128, 0.f);
    const float il = 1.f / l;
#pragma unroll
    for (int d = 0; d < 64; ++d) o[d] *= il;
    store64((bf16_t*)(p.ws + WS_Y) + (size_t)row * 1536 + 1024 + h * 64, o);
}
__device__ __forceinline__ void na_ref_item(const Ptrs& p, int layer, int i) {
    const int t = i & (SEQ - 1), h = (i >> 12) & 7, b = i >> 15, row = b * SEQ + t;
    const bf16_t* P = (const bf16_t*)(p.ws + WS_P);
    float q[64]; load64(q, P + (size_t)row * INC + O_NAQ + h * 64);
    float o[64]; float mx = -1e30f, l = 0.f;
#pragma unroll
    for (int d = 0; d < 64; ++d) o[d] = 0.f;
    const int r = t >> 6, c = t & 63; const int rs = min(max(r - 4, 0), 56), cs = min(max(c - 8, 0), 48);
    const float* rpb = p.na_rpb + ((size_t)layer * 8 + h) * 15 * 31;
    for (int ii = 0; ii < 8; ++ii) for (int j = 0; j < 16; ++j) { const int kr = rs + ii, kc = cs + j; const bf16_t* kp = P + (size_t)(b * SEQ + kr * 64 + kc) * INC;
        ATT_STEP(kp + O_NAK + h * 64, kp + O_NAV + h * 64, rpb[(kr - r + 7) * 31 + (kc - c + 15)]); }
    for (int j = 0; j < CTXL; ++j) { const bf16_t* kp = P + (size_t)(NLAT + b * CTXL + j) * INC; ATT_STEP(kp + O_NAK + h * 64, kp + O_NAV + h * 64, 0.f); }
    const float il = 1.f / l;
#pragma unroll
    for (int d = 0; d < 64; ++d) o[d] *= il;
    store64((bf16_t*)(p.ws + WS_Y) + (size_t)row * 1536 + 512 + h * 64, o);
}
__device__ __forceinline__ void ctx_ref_item(const Ptrs& p, int layer, int i, int which) {
    const int h = i & 7, cr = i >> 3, row = NLAT + cr, b = cr / CTXL; const bf16_t* P = (const bf16_t*)(p.ws + WS_P);
    float q[64]; float o[64]; float mx = -1e30f, l = 0.f;
#pragma unroll
    for (int d = 0; d < 64; ++d) o[d] = 0.f;
    if (which == 0) { load64(q, P + (size_t)row * INC + O_NAQ + h * 64);
        for (int j = 0; j < CTXL; ++j) { const bf16_t* kp = P + (size_t)(NLAT + b * CTXL + j) * INC; ATT_STEP(kp + O_NAK + h * 64, kp + O_NAV + h * 64, 0.f); } }
    else { load64(q, P + (size_t)row * INC + O_GQ + h * 64); head_norm_rope(q, p.q_norm_g + layer * 64, false, 0);
        const bf16_t* kb = (const bf16_t*)(p.ws + WS_KG) + (((size_t)b * KVLEN + SEQ) * 2 + (h >> 2)) * 64; const bf16_t* vb = (const bf16_t*)(p.ws + WS_VG) + (((size_t)b * KVLEN + SEQ) * 2 + (h >> 2)) * 64;
        for (int j = 0; j < CTXL; ++j) ATT_STEP(kb + (size_t)j * 128, vb + (size_t)j * 128, 0.f); }
    const float il = 1.f / l;
#pragma unroll
    for (int d = 0; d < 64; ++d) o[d] *= il;
    store64((bf16_t*)(p.ws + WS_Y) + (size_t)row * 1536 + (which ? 1024 : 512) + h * 64, o);
}
__device__ __forceinline__ unsigned top4_store(const Ptrs& p, int row, const float (&lg)[32]) {
    int ie[4]; float ve[4];
#pragma unroll
    for (int k = 0; k < 4; ++k) { float bv = -3.0e38f; int bi = 0;
#pragma unroll
        for (int e = 0; e < 32; ++e) { const bool taken = (k > 0 && ie[0] == e) || (k > 1 && ie[1] == e) || (k > 2 && ie[2] == e); if (!taken && lg[e] > bv) { bv = lg[e]; bi = e; } }
        ie[k] = bi; ve[k] = bv; }
    const float e0 = 1.f, e1 = expf(ve[1] - ve[0]), e2 = expf(ve[2] - ve[0]), e3 = expf(ve[3] - ve[0]), is = 1.f / (e0 + e1 + e2 + e3);
    ((int4*)(p.ws + WS_TOKE))[row] = make_int4(ie[0], ie[1], ie[2], ie[3]); ((float4*)(p.ws + WS_TOKG))[row] = make_float4(e0 * is, e1 * is, e2 * is, e3 * is);
    return (unsigned)ie[0] | ((unsigned)ie[1] << 8) | ((unsigned)ie[2] << 16) | ((unsigned)ie[3] << 24);
}
template <int NR>
__device__ __forceinline__ void combine_rows(const Ptrs& p, int layer, int mode, int row0, int stride, int nrows, int lane, float gmul = 1.f) {
    typedef float v2f_ __attribute__((ext_vector_type(2)));
    int4 sl[NR]; float4 gg[NR]; unsigned yv[NR][4][4]; uint2 xv[NR][4];
#pragma unroll
    for (int q = 0; q < NR; ++q) { const int row = min(row0 + q * stride, nrows - 1); sl[q] = ((const int4*)(p.ws + WS_TOKS))[row]; gg[q] = ((const float4*)(p.ws + WS_TOKG))[row]; }
#pragma unroll
    for (int q = 0; q < NR; ++q) { const int row = min(row0 + q * stride, nrows - 1); const int sls[4] = {sl[q].x, sl[q].y, sl[q].z, sl[q].w}; const uint2* xr = (const uint2*)((const bf16_t*)(p.ws + WS_X) + (size_t)row * D);
#pragma unroll
        for (int i = 0; i < 4; ++i) { xv[q][i] = xr[lane + 64 * i];
#pragma unroll
            for (int k = 0; k < 4; ++k) yv[q][i][k] = ((const unsigned*)(p.ws + WS_YB + (size_t)sls[k] * D))[lane + 64 * i]; } }
#pragma unroll
    for (int q = 0; q < NR; ++q) { const int row = row0 + q * stride; if (row >= nrows) continue;
        const float gs[4] = {gg[q].x * (1.f / YB_SCALE), gg[q].y * (1.f / YB_SCALE), gg[q].z * (1.f / YB_SCALE), gg[q].w * (1.f / YB_SCALE)};
        uint2* xr = (uint2*)((bf16_t*)(p.ws + WS_X) + (size_t)row * D);
        const float* ml = (const float*)(p.ws + WS_MOD) + ((size_t)layer * 9 + mod_row(row)) * MODW;
        float4 v[4]; float ss = 0.f;
#pragma unroll
        for (int i = 0; i < 4; ++i) { const int c4 = lane + 64 * i; float4 a = make_float4(0, 0, 0, 0);
#pragma unroll
            for (int k = 0; k < 4; ++k) { const int w = (int)yv[q][i][k]; const v2f_ y01 = __builtin_amdgcn_cvt_pk_f32_fp8(w, false), y23 = __builtin_amdgcn_cvt_pk_f32_fp8(w, true);
                a.x += gs[k] * y01[0]; a.y += gs[k] * y01[1]; a.z += gs[k] * y23[0]; a.w += gs[k] * y23[1]; }
            const float4 g2 = ((const float4*)(ml + 5 * D))[c4]; const uint2 xw_ = xv[q][i]; float4 x = make_float4(bf2f(xw_.x & 0xffff), bf2f(xw_.x >> 16), bf2f(xw_.y & 0xffff), bf2f(xw_.y >> 16));
            x.x += gmul * g2.x * a.x; x.y += gmul * g2.y * a.y; x.z += gmul * g2.z * a.z; x.w += gmul * g2.w * a.w; v[i] = x; ss += x.x * x.x + x.y * x.y + x.z * x.z + x.w * x.w; }
        const float r = rsqrtf(wave_sum(ss, lane) * (1.f / D) + EPS);
        if (mode == 0) {
#pragma unroll
            for (int i = 0; i < 4; ++i) xr[lane + 64 * i] = make_uint2(pk2(v[i].x, v[i].y), pk2(v[i].z, v[i].w));
            norm_mod_store(v, r, p.norm1_g + (layer + 1) * D, (const float*)(p.ws + WS_MOD) + ((size_t)(layer + 1) * 9 + mod_row(row)) * MODW, p.ws, row, lane);
        } else {
            float4* orow = (float4*)(p.out + (size_t)row * D);
#pragma unroll
            for (int i = 0; i < 4; ++i) { const int c4 = lane + 64 * i; const float4 g = ((const float4*)p.final_g)[c4]; orow[c4] = make_float4(v[i].x * r * g.x, v[i].y * r * g.y, v[i].z * r * g.z, v[i].w * r * g.w); }
        }
    }
}

namespace pg8 {
typedef short bf16x8 __attribute__((ext_vector_type(8)));
typedef float f32x4 __attribute__((ext_vector_type(4)));
typedef unsigned u32x4 __attribute__((ext_vector_type(4)));
typedef unsigned u32x2 __attribute__((ext_vector_type(2)));
typedef int v4i __attribute__((ext_vector_type(4)));
typedef int v8i __attribute__((ext_vector_type(8)));
#ifndef PG8_WGM
#define PG8_WGM 8
#endif
constexpr int BM = 256, BK = 64, HALF = 128, HTB = HALF * BK * 2, STAGE_BYTES = 8 * HTB, NXCD = 8, WGM = PG8_WGM;
__host__ __device__ __forceinline__ int lds_byte(int r, int c) { const int st = (r >> 4) * 2 + (c >> 5), rr = r & 15, cc = c & 31, ob = rr * 64 + cc * 2; return st * 1024 + (ob ^ (((ob >> 9) & 1) << 5)); }
__host__ __device__ __forceinline__ void stage_rc(int b, int& R, int& C) { const int st = b / 1024, sb = b % 1024, swz = sb ^ (((sb >> 9) & 1) << 5); R = (st >> 1) * 16 + swz / 64; C = (st & 1) * 32 + (swz % 64) / 2; }
__host__ __device__ __forceinline__ int perm32(int rho) { const int n = rho >> 4, i = rho & 15; return 8 * (i >> 2) + 4 * n + (i & 3); }
struct Unit { int pm, pn, z, hf; };
struct Gemm { int Kb, lda, ldb; int scaleA, scaleB; };
__device__ __forceinline__ bool tile_order(int L, int nM, int nN, int& pm, int& pn) {
    const int nwg = nM * nN; if (L >= nwg) return false;
    int wgid = L; { const int q = nwg / NXCD, r = nwg % NXCD, xcd = wgid % NXCD, off = wgid / NXCD; wgid = (xcd < r ? xcd * (q + 1) : r * (q + 1) + (xcd - r) * q) + off; }
    const int nig = WGM * nN, gid = wgid / nig, fm = gid * WGM, gsz = (nM - fm) < WGM ? (nM - fm) : WGM;
    pm = fm + ((wgid % nig) % gsz); pn = (wgid % nig) / gsz; return true;
}
__device__ __forceinline__ unsigned cvt_pk_bf16(float lo, float hi) { unsigned r; asm volatile("v_cvt_pk_bf16_f32 %0, %1, %2" : "=v"(r) : "v"(lo), "v"(hi)); return r; }
__device__ __forceinline__ float fast_sigmoid(float v) { return __builtin_amdgcn_rcpf(1.f + __builtin_amdgcn_exp2f(-1.4426950408889634f * v)); }

template <class Epi, class Sched, bool ALIGN_EPI, bool SP2, bool FP8 = false, bool GATHER = false, bool HALFU = false>
__device__ __forceinline__ void gemm_phase(LAS unsigned char* lds, const Gemm g, const Sched& S, const Epi& E, int wvid, const int* gtab = nullptr, LAS int* ltab = nullptr, LAS float* lbias = nullptr) {
    const int tid_ = opaque_tid(wvid);
    const int tid = tid_, wid = __builtin_amdgcn_readfirstlane(tid >> 6), lane = tid & 63, wr = wid >> 2, wc = wid & 3, fr = lane & 15, fq = lane >> 4;
    const int nt = g.Kb / (BK * 2);
    unsigned voffA[2], voffB[2];
#pragma unroll
    for (int i = 0; i < 2; ++i) { int R, C; stage_rc(tid * 16 + i * 8192, R, C); const int Rb = Epi::PERM ? ((R & ~31) + perm32(R & 31)) : R;
        voffA[i] = (unsigned)(R * g.lda + C * 2); voffB[i] = (unsigned)(Rb * g.ldb + C * 2); }
    const size_t kstep = (size_t)(BK * 2);
    const size_t hstepA = (size_t)HALF * g.lda, hstepB = (size_t)HALF * g.ldb;
    const unsigned ldsw = (unsigned)wid * 1024u;
    const int aoff = lds_byte(wr * 64 + fr, fq * 8), boff = lds_byte(wc * 32 + fr, fq * 8);
#define PG8_SA(b, h) (((b) * 2 + (h)) * HTB)
#define PG8_SB(b, h) ((4 + (b) * 2 + (h)) * HTB)
#define PG8_STAGE(bufoff, gbase, voff) do { _Pragma("unroll") for (int _i = 0; _i < 2; ++_i) \
        __builtin_amdgcn_global_load_lds((const unsigned*)((const char*)(gbase) + (voff)[_i]), (LAS unsigned*)(lds + (bufoff) + ldsw + _i * 8192), 16, 0, 0); } while (0)
    unsigned vgC[2], vgN[2], gc2 = 0; (void)vgC; (void)vgN; (void)gc2;
    if constexpr (GATHER) { int R0_, C0_, R1_, C1_; stage_rc(tid * 16, R0_, C0_); stage_rc(tid * 16 + 8192, R1_, C1_); gc2 = (unsigned)(C0_ * 2) | ((unsigned)(C1_ * 2) << 8); }
#define PG8_GTAB_FETCH(u, buf) do { if (wid == 7) { int ln_; asm volatile("v_mbcnt_lo_u32_b32 %0, -1, 0\n\tv_mbcnt_hi_u32_b32 %0, -1, %0" : "=v"(ln_));   \
        __builtin_amdgcn_global_load_lds((const unsigned*)(gtab + (size_t)(u).pm * BM + ln_ * 4), (LAS unsigned*)(ltab + (buf) * BM), 16, 0, 0); } } while (0)
#define PG8_GTAB_READ(dst, buf) do { int tq_; asm volatile("v_mbcnt_lo_u32_b32 %0, -1, 0\n\tv_mbcnt_hi_u32_b32 %0, -1, %0" : "=v"(tq_)); tq_ += wid * 64;   \
        int Ra_, Ca_, Rb_, Cb_; stage_rc(tq_ * 16, Ra_, Ca_); stage_rc(tq_ * 16 + 8192, Rb_, Cb_); \
        _Pragma("unroll") for (int h_ = 0; h_ < 2; ++h_) dst[h_] = (unsigned)ltab[(buf) * BM + Ra_ + HALF * h_] | ((unsigned)ltab[(buf) * BM + Rb_ + HALF * h_] << 16); } while (0)
#define PG8_STAGE_A(bufoff, ptr, h, nx) do { if constexpr (GATHER) { const unsigned pk_ = (nx) ? vgN[h] : vgC[h]; unsigned vo_[2] = {(pk_ & 0xffffu) * (unsigned)g.lda + (gc2 & 0xffu), (pk_ >> 16) * (unsigned)g.lda + (gc2 >> 8)}; PG8_STAGE(bufoff, ptr, vo_); } \
        else PG8_STAGE(bufoff, (ptr) + (h) * hstepA, voffA); } while (0)
#define PG8_LD16(off) (*(const LAS v4i*)(lds + (off)))
#define PG8_LDA(dst, b, h) do { _Pragma("unroll") for (int m = 0; m < 4; ++m) { \
        if constexpr (FP8) dst##q[m] = __builtin_shufflevector(PG8_LD16(PG8_SA(b, h) + aoff + m * 2048), PG8_LD16(PG8_SA(b, h) + aoff + m * 2048 + 1024), 0, 1, 2, 3, 4, 5, 6, 7); \
        else { _Pragma("unroll") for (int k = 0; k < 2; ++k) dst[m][k] = *(const LAS bf16x8*)(lds + PG8_SA(b, h) + aoff + m * 2048 + k * 1024); } } } while (0)
#define PG8_LDB(dst, b, h) do { _Pragma("unroll") for (int n = 0; n < 2; ++n) { \
        if constexpr (FP8) dst##q[n] = __builtin_shufflevector(PG8_LD16(PG8_SB(b, h) + boff + n * 2048), PG8_LD16(PG8_SB(b, h) + boff + n * 2048 + 1024), 0, 1, 2, 3, 4, 5, 6, 7); \
        else { _Pragma("unroll") for (int k = 0; k < 2; ++k) dst[n][k] = *(const LAS bf16x8*)(lds + PG8_SB(b, h) + boff + n * 2048 + k * 1024); } } } while (0)
#define PG8_MMA(ai, bj, At, Bt) do { __builtin_amdgcn_s_setprio(1); _Pragma("unroll") for (int m = 0; m < 4; ++m) _Pragma("unroll") for (int n = 0; n < 2; ++n) { \
        if constexpr (FP8)   \
            asm volatile("v_mfma_scale_f32_16x16x128_f8f6f4 %0, %1, %2, %0, %3, %4 op_sel_hi:[0,0,0]" : "+v"(acc[ai][bj][m][n]) : "v"(Bt##q[n]), "v"(At##q[m]), "v"(scB_), "v"(scA_));   \
        else { _Pragma("unroll") for (int k = 0; k < 2; ++k) acc[ai][bj][m][n] = __builtin_amdgcn_mfma_f32_16x16x32_bf16(Bt[n][k], At[m][k], acc[ai][bj][m][n], 0, 0, 0); } } \
        __builtin_amdgcn_s_setprio(0); } while (0)
#define PG8_WAIT_V(n) asm volatile("s_waitcnt vmcnt(" #n ")" ::: "memory")
#define PG8_WAIT_L(n) asm volatile("s_waitcnt lgkmcnt(" #n ")" ::: "memory")
#define PG8_BAR __builtin_amdgcn_s_barrier()
#define PG8_SCHED __builtin_amdgcn_sched_barrier(0)
    Unit cur, nxt; int ui = 0;
    if (!S.next(0, cur)) return;
    f32x4 acc[2][2][4][2];
    float z0_; asm volatile("v_mov_b32 %0, 0" : "=v"(z0_));
#pragma unroll
    for (int a = 0; a < 2; ++a)
#pragma unroll
        for (int b = 0; b < 2; ++b)
#pragma unroll
            for (int m = 0; m < 4; ++m)
#pragma unroll
                for (int n = 0; n < 2; ++n) acc[a][b][m][n] = (f32x4){0.f, 0.f, 0.f, 0.f};
    const int scA_ = g.scaleA, scB_ = g.scaleB; (void)scA_; (void)scB_;
    const char* cA = S.a_ptr(cur); const char* cB = S.b_ptr(cur);
#define PG8_BIAS_FETCH(u, buf) do { if constexpr (Epi::BIAS_LDS) { if (wid == 6) { int lb_; asm volatile("v_mbcnt_lo_u32_b32 %0, -1, 0\n\tv_mbcnt_hi_u32_b32 %0, -1, %0" : "=v"(lb_));   \
        __builtin_amdgcn_global_load_lds((const unsigned*)(E.bias_src(u) + lb_ * 4), (LAS unsigned*)(lbias + (buf) * BM), 16, 0, 0); } } } while (0)
    PG8_BIAS_FETCH(cur, 0);
    if constexpr (GATHER) { PG8_GTAB_FETCH(cur, 0); PG8_WAIT_V(0); PG8_BAR; PG8_GTAB_READ(vgC, 0); }
    if constexpr (SP2) {
        PG8_STAGE(PG8_SB(0, 0), cB, voffB); PG8_STAGE(PG8_SB(0, 1), cB + hstepB, voffB); PG8_STAGE_A(PG8_SA(0, 0), cA, 0, false); PG8_STAGE_A(PG8_SA(0, 1), cA, 1, false);
        if (wr == 1) PG8_BAR;
        PG8_WAIT_V(2); PG8_BAR;
        PG8_STAGE(PG8_SB(1, 0), cB + kstep, voffB); PG8_STAGE_A(PG8_SA(1, 0), cA + kstep, 0, false); PG8_STAGE(PG8_SB(1, 1), cB + hstepB + kstep, voffB);
        PG8_WAIT_V(6); PG8_BAR;
    } else {
        PG8_STAGE(PG8_SB(0, 0), cB, voffB); PG8_STAGE(PG8_SA(0, 0), cA, voffA); PG8_STAGE(PG8_SB(0, 1), cB + hstepB, voffB); PG8_STAGE(PG8_SA(0, 1), cA + hstepA, voffA);
        if (wr == 1) PG8_BAR;
        PG8_WAIT_V(4); PG8_BAR;
        PG8_STAGE(PG8_SB(1, 0), cB + kstep, voffB); PG8_STAGE_A(PG8_SA(1, 0), cA + kstep, 0, false); PG8_STAGE(PG8_SB(1, 1), cB + hstepB + kstep, voffB);
        PG8_WAIT_V(6); PG8_BAR;
    }
    for (;;) {
        const bool has_next = S.next(ui + 1, nxt);
        const char* nA = has_next ? S.a_ptr(nxt) : cA; const char* nB = has_next ? S.b_ptr(nxt) : cB;
        if constexpr (GATHER) { if (has_next) PG8_GTAB_FETCH(nxt, (ui + 1) & 1); }
        if (ui > 0) PG8_BIAS_FETCH(cur, ui & 1);
        const bool hu = HALFU && cur.hf != 0;
        for (int t = 0; t < nt; t += 2) {
            const bool last = (t == nt - 2);
            if constexpr (GATHER) { if (last && has_next) PG8_GTAB_READ(vgN, (ui + 1) & 1); }
            const char* a1 = cA + (size_t)(t + 1) * kstep;
            const char* a2 = last ? nA : cA + (size_t)(t + 2) * kstep; const char* b2 = last ? nB : cB + (size_t)(t + 2) * kstep;
            const char* a3 = a2 + kstep; const char* b3 = b2 + kstep;
            bf16x8 At[4][2], B0[2][2], B1[2][2]; v8i Atq[4], B0q[2], B1q[2]; (void)At; (void)B0; (void)B1; (void)Atq; (void)B0q; (void)B1q;
            if constexpr (SP2) {
            PG8_LDB(B0, 0, 0); PG8_LDB(B1, 0, 1); PG8_SCHED; PG8_LDA(At, 0, 0); PG8_STAGE_A(PG8_SA(1, 1), a1, 1, false);
            PG8_WAIT_V(8); PG8_WAIT_L(0); PG8_BAR; PG8_MMA(0, 0, At, B0); PG8_MMA(0, 1, At, B1); PG8_BAR; PG8_SCHED;
            if (!hu) PG8_LDA(At, 0, 1); PG8_STAGE(PG8_SB(0, 0), b2, voffB); PG8_STAGE(PG8_SB(0, 1), b2 + hstepB, voffB); PG8_STAGE_A(PG8_SA(0, 0), a2, 0, last);
            PG8_WAIT_V(8); PG8_WAIT_L(0); PG8_BAR; if (!hu) { PG8_MMA(1, 0, At, B0); PG8_MMA(1, 1, At, B1); } PG8_BAR; PG8_SCHED;
            PG8_LDB(B0, 1, 0); PG8_LDB(B1, 1, 1); PG8_SCHED; PG8_LDA(At, 1, 0); PG8_STAGE_A(PG8_SA(0, 1), a2, 1, last);
            PG8_WAIT_V(8); PG8_WAIT_L(0); PG8_BAR; PG8_MMA(0, 0, At, B0); PG8_MMA(0, 1, At, B1); PG8_BAR; PG8_SCHED;
            if (!hu) PG8_LDA(At, 1, 1); PG8_STAGE(PG8_SB(1, 0), b3, voffB); PG8_STAGE(PG8_SB(1, 1), b3 + hstepB, voffB); PG8_STAGE_A(PG8_SA(1, 0), a3, 0, last);
            PG8_WAIT_V(8); PG8_WAIT_L(0); PG8_BAR; if (!hu) { PG8_MMA(1, 0, At, B0); PG8_MMA(1, 1, At, B1); } PG8_BAR; PG8_SCHED;
            } else {
            PG8_LDB(B0, 0, 0); PG8_SCHED; PG8_LDA(At, 0, 0); PG8_STAGE_A(PG8_SA(1, 1), a1, 1, false);
            PG8_WAIT_L(8); PG8_BAR; PG8_WAIT_L(0); PG8_MMA(0, 0, At, B0); PG8_BAR; PG8_SCHED;
            PG8_LDB(B1, 0, 1); PG8_STAGE(PG8_SB(0, 0), b2, voffB);
            PG8_BAR; PG8_WAIT_L(0); PG8_MMA(0, 1, At, B1); PG8_BAR;
            PG8_LDA(At, 0, 1); PG8_STAGE_A(PG8_SA(0, 0), a2, 0, last);
            PG8_BAR; PG8_WAIT_L(0); PG8_MMA(1, 0, At, B0); PG8_BAR; PG8_SCHED;
            PG8_STAGE(PG8_SB(0, 1), b2 + hstepB, voffB);
            PG8_WAIT_V(6); PG8_BAR; PG8_MMA(1, 1, At, B1); PG8_BAR;
            PG8_LDB(B0, 1, 0); PG8_SCHED; PG8_LDA(At, 1, 0); PG8_STAGE_A(PG8_SA(0, 1), a2, 1, last);
            PG8_WAIT_L(8); PG8_BAR; PG8_WAIT_L(0); PG8_MMA(0, 0, At, B0); PG8_BAR; PG8_SCHED;
            PG8_LDB(B1, 1, 1); PG8_STAGE(PG8_SB(1, 0), b3, voffB);
            PG8_BAR; PG8_WAIT_L(0); PG8_MMA(0, 1, At, B1); PG8_BAR;
            PG8_LDA(At, 1, 1); PG8_STAGE_A(PG8_SA(1, 0), a3, 0, last);
            PG8_BAR; PG8_WAIT_L(0); PG8_MMA(1, 0, At, B0); PG8_BAR; PG8_SCHED;
            PG8_STAGE(PG8_SB(1, 1), b3 + hstepB, voffB);
            PG8_WAIT_V(6); PG8_BAR; PG8_MMA(1, 1, At, B1); PG8_BAR;
            }
        }
        if constexpr (ALIGN_EPI) { if (wr == 0) PG8_BAR; }
        if constexpr (FP8) asm volatile("s_nop 15\n\ts_nop 15" ::: "memory");
        bool keep_ = false; if constexpr (Epi::CHAIN) keep_ = E.chain(acc, cur, wr, wc, fr, fq); else if constexpr (Epi::BIAS_LDS) E(acc, cur, wr, wc, fr, fq, lbias + (ui & 1) * BM); else E(acc, cur, wr, wc, fr, fq);
        if (!has_next) break;
        if (!keep_) {
#pragma unroll
        for (int a = 0; a < 2; ++a)
#pragma unroll
            for (int b = 0; b < 2; ++b)
#pragma unroll
                for (int m = 0; m < 4; ++m)
#pragma unroll
                    for (int n = 0; n < 2; ++n) acc[a][b][m][n] = (f32x4){z0_, z0_, z0_, z0_};
        }
        cur = nxt; cA = nA; cB = nB; ++ui;
        if constexpr (GATHER) {
#pragma unroll
            for (int h_ = 0; h_ < 2; ++h_) vgC[h_] = vgN[h_]; }
        if constexpr (ALIGN_EPI) { if (wr == 1) PG8_BAR; }
    }
    PG8_WAIT_V(0);
    if constexpr (!ALIGN_EPI) { if (wr == 0) PG8_BAR; }
    PG8_BAR;
#undef PG8_SA
#undef PG8_SB
#undef PG8_STAGE
#undef PG8_LDA
#undef PG8_LD16
#undef PG8_STAGE_A
#undef PG8_GTAB_FETCH
#undef PG8_GTAB_READ
#undef PG8_BIAS_FETCH
#undef PG8_LDB
#undef PG8_MMA
#undef PG8_WAIT_V
#undef PG8_WAIT_L
#undef PG8_BAR
#undef PG8_SCHED
}

template <bool HAS_BIAS> struct EpiStoreBf16 {
    static constexpr bool PERM = true, CHAIN = false, BIAS_LDS = HAS_BIAS;
    bf16_t* O; int ldc; const float* bias; int bias_stride; float scale; int sc_lo, sc_hi, ex_lo;
    __device__ __forceinline__ const float* bias_src(const Unit& u) const { return bias + (size_t)u.z * bias_stride + u.pn * BM; }
    __device__ __forceinline__ void operator()(const f32x4 (&acc)[2][2][4][2], const Unit& u, int wr, int wc, int fr, int fq, const LAS float* lb = nullptr) const {
        const int row0 = u.pm * BM + wr * 64 + fr, col0 = u.pn * BM + wc * 32 + 8 * fq; const float sc = (u.pn >= sc_lo && u.pn < sc_hi) ? scale : 1.f;
        f32x4 bv[2][2];
#pragma unroll
        for (int bj = 0; bj < 2; ++bj)
#pragma unroll
            for (int n = 0; n < 2; ++n) { if constexpr (HAS_BIAS) bv[bj][n] = *(const LAS f32x4*)(lb + wc * 32 + 8 * fq + bj * HALF + 4 * n); }
#pragma unroll
        for (int ai = 0; ai < 2; ++ai)
#pragma unroll
            for (int m = 0; m < 4; ++m) { bf16_t* rowp = O + (size_t)(row0 + ai * HALF + m * 16) * ldc + col0;
#pragma unroll
                for (int bj = 0; bj < 2; ++bj) { f32x4 v0 = acc[ai][bj][m][0], v1 = acc[ai][bj][m][1]; if constexpr (HAS_BIAS) { v0 += bv[bj][0]; v1 += bv[bj][1]; } v0 *= sc; v1 *= sc;
                    if (u.pn >= ex_lo) {
#pragma unroll
                        for (int j = 0; j < 4; ++j) { v0[j] = __builtin_amdgcn_exp2f(fminf(-1.4426950408889634f * v0[j], 8.75f)); v1[j] = __builtin_amdgcn_exp2f(fminf(-1.4426950408889634f * v1[j], 8.75f)); }
                        int lo = __builtin_amdgcn_cvt_pk_fp8_f32(v0[0], v0[1], 0, false); lo = __builtin_amdgcn_cvt_pk_fp8_f32(v0[2], v0[3], lo, true);
                        int hi = __builtin_amdgcn_cvt_pk_fp8_f32(v1[0], v1[1], 0, false); hi = __builtin_amdgcn_cvt_pk_fp8_f32(v1[2], v1[3], hi, true);
                        *(u32x2*)((unsigned char*)(rowp - col0) + ex_lo * BM * 2 + (col0 - ex_lo * BM) + bj * HALF) = (u32x2){(unsigned)lo, (unsigned)hi}; }
                    else { u32x4 w; w.x = cvt_pk_bf16(v0[0], v0[1]); w.y = cvt_pk_bf16(v0[2], v0[3]); w.z = cvt_pk_bf16(v1[0], v1[1]); w.w = cvt_pk_bf16(v1[2], v1[3]);
                        *(u32x4*)(rowp + bj * HALF) = w; } } }
    }
};
struct EpiStoreF8 {
    static constexpr bool PERM = true, CHAIN = false, BIAS_LDS = true;
    unsigned char* O; int ldc; const float* bias; int bias_stride; float scale;
    __device__ __forceinline__ const float* bias_src(const Unit& u) const { return bias + (size_t)u.z * bias_stride + u.pn * BM; }
    __device__ __forceinline__ void operator()(const f32x4 (&acc)[2][2][4][2], const Unit& u, int wr, int wc, int fr, int fq, const LAS float* lb) const {
        const int row0 = u.pm * BM + wr * 64 + fr, col0 = u.pn * BM + wc * 32 + 8 * fq;
        f32x4 bv[2][2];
#pragma unroll
        for (int bj = 0; bj < 2; ++bj)
#pragma unroll
            for (int n = 0; n < 2; ++n) bv[bj][n] = *(const LAS f32x4*)(lb + wc * 32 + 8 * fq + bj * HALF + 4 * n);
#pragma unroll
        for (int ai = 0; ai < 2; ++ai)
#pragma unroll
            for (int m = 0; m < 4; ++m) { unsigned char* rowp = O + (size_t)(row0 + ai * HALF + m * 16) * ldc + col0;
#pragma unroll
                for (int bj = 0; bj < 2; ++bj) { const f32x4 v0 = (acc[ai][bj][m][0] + bv[bj][0]) * scale, v1 = (acc[ai][bj][m][1] + bv[bj][1]) * scale;
                    int lo = __builtin_amdgcn_cvt_pk_fp8_f32(v0[0], v0[1], 0, false); lo = __builtin_amdgcn_cvt_pk_fp8_f32(v0[2], v0[3], lo, true);
                    int hi = __builtin_amdgcn_cvt_pk_fp8_f32(v1[0], v1[1], 0, false); hi = __builtin_amdgcn_cvt_pk_fp8_f32(v1[2], v1[3], hi, true);
                    *(u32x2*)(rowp + bj * HALF) = (u32x2){(unsigned)lo, (unsigned)hi}; } }
    }
};
struct EpiMergeF {
    static constexpr bool PERM = true, CHAIN = true, BIAS_LDS = false;
    const bf16_t* P; bf16_t* Mo;
    __device__ __forceinline__ bool chain(f32x4 (&acc)[2][2][4][2], const Unit& u, int wr, int wc, int fr, int fq) const {
        const int row0 = u.pm * BM + (u.hf == 2 ? HALF : 0) + wr * 64 + fr, col0 = u.pn * BM + wc * 32 + 8 * fq; const int ga = (u.z == 0 ? O_BGC : u.z == 1 ? O_BGN : O_BGG) + col0, gb = (u.z == 0 ? O_BGN : O_BGG) + col0;
        const bool last = (u.z == 2); const int nai = u.hf != 0 ? 1 : 2;
        u32x2 wa[2][4][2], wb[2][4][2];
#pragma unroll
        for (int ai = 0; ai < 2; ++ai) { if (ai < nai) {
#pragma unroll
            for (int m = 0; m < 4; ++m) { const unsigned char* gp = (const unsigned char*)(P + (size_t)(row0 + ai * HALF + m * 16) * INC + O_BGC);
#pragma unroll
                for (int bj = 0; bj < 2; ++bj) { wa[ai][m][bj] = *(const u32x2*)(gp + (ga - O_BGC) + bj * HALF); wb[ai][m][bj] = last ? wa[ai][m][bj] : *(const u32x2*)(gp + (gb - O_BGC) + bj * HALF); } } } }
        asm volatile("" ::: "memory");
#pragma unroll
        for (int ai = 0; ai < 2; ++ai) { if (ai < nai) {
#pragma unroll
            for (int m = 0; m < 4; ++m) { const size_t row = (size_t)(row0 + ai * HALF + m * 16);
#pragma unroll
                for (int bj = 0; bj < 2; ++bj) { typedef float v2f_ __attribute__((ext_vector_type(2))); float f[8];
#pragma unroll
                    for (int j = 0; j < 2; ++j) { const int w = (int)(j ? wa[ai][m][bj].y : wa[ai][m][bj].x); const v2f_ e01 = __builtin_amdgcn_cvt_pk_f32_fp8(w, false), e23 = __builtin_amdgcn_cvt_pk_f32_fp8(w, true);
                        f[4 * j] = __builtin_amdgcn_rcpf(1.f + e01[0]); f[4 * j + 1] = __builtin_amdgcn_rcpf(1.f + e01[1]); f[4 * j + 2] = __builtin_amdgcn_rcpf(1.f + e23[0]); f[4 * j + 3] = __builtin_amdgcn_rcpf(1.f + e23[1]); }
                    if (!last) {
#pragma unroll
                        for (int j = 0; j < 2; ++j) { const int w = (int)(j ? wb[ai][m][bj].y : wb[ai][m][bj].x); const v2f_ e01 = __builtin_amdgcn_cvt_pk_f32_fp8(w, false), e23 = __builtin_amdgcn_cvt_pk_f32_fp8(w, true);
                            f[4 * j] *= 1.f + e01[0]; f[4 * j + 1] *= 1.f + e01[1]; f[4 * j + 2] *= 1.f + e23[0]; f[4 * j + 3] *= 1.f + e23[1]; } }
                    f32x4& a0 = acc[ai][bj][m][0]; f32x4& a1 = acc[ai][bj][m][1];
                    a0[0] *= f[0]; a0[1] *= f[1]; a0[2] *= f[2]; a0[3] *= f[3]; a1[0] *= f[4]; a1[1] *= f[5]; a1[2] *= f[6]; a1[3] *= f[7];
                    if (last) { u32x4 w; w.x = cvt_pk_bf16(a0[0], a0[1]); w.y = cvt_pk_bf16(a0[2], a0[3]); w.z = cvt_pk_bf16(a1[0], a1[1]); w.w = cvt_pk_bf16(a1[2], a1[3]);
                        *(u32x4*)(Mo + row * D + col0 + bj * HALF) = w; } } } } }
        return !last;
    }
};
struct EpiNull { static constexpr bool PERM = true, CHAIN = false, BIAS_LDS = false; float* sink;
    __device__ __forceinline__ void operator()(const f32x4 (&acc)[2][2][4][2], const Unit& u, int wr, int wc, int fr, int fq) const { float s = 0.f;
#pragma unroll
        for (int a = 0; a < 2; ++a)
#pragma unroll
            for (int b = 0; b < 2; ++b)
#pragma unroll
                for (int m = 0; m < 4; ++m)
#pragma unroll
                    for (int n = 0; n < 2; ++n) s += acc[a][b][m][n][0];
        if (s == 1.2345e30f) sink[0] = s; } };
struct EpiOutF {
    static constexpr bool PERM = true, CHAIN = false, BIAS_LDS = false;
    bf16_t* X; const float* modl; float gmul;
    __device__ __forceinline__ void operator()(const f32x4 (&acc)[2][2][4][2], const Unit& u, int wr, int wc, int fr, int fq) const {
        const int row0 = u.pm * BM + (u.hf == 2 ? HALF : 0) + wr * 64 + fr, col0 = u.pn * BM + wc * 32 + 8 * fq; const bool lat = u.pm < NLAT / BM; const int mr = lat ? u.pm / (SEQ / BM) : 8;
        const float* gt = modl + (size_t)mr * MODW + 2 * D + col0;
        f32x4 gv[2][2];
#pragma unroll
        for (int bj = 0; bj < 2; ++bj)
#pragma unroll
            for (int n = 0; n < 2; ++n) gv[bj][n] = *(const f32x4*)(gt + bj * HALF + n * 4) * gmul;
#pragma unroll
        for (int ai = 0; ai < 2; ++ai) { if (ai == 1 && u.hf != 0) break;
            u32x4 xb[4][2];
#pragma unroll
            for (int m = 0; m < 4; ++m) { const bf16_t* srcp = X + (size_t)row0 * D + (size_t)(ai * HALF + m * 16) * D + col0;
#pragma unroll
                for (int bj = 0; bj < 2; ++bj) xb[m][bj] = *(const u32x4*)(srcp + bj * HALF); }
            asm volatile("" ::: "memory");
#pragma unroll
            for (int m = 0; m < 4; ++m) { bf16_t* rowp = X + (size_t)row0 * D + (size_t)(ai * HALF + m * 16) * D + col0;
#pragma unroll
                for (int bj = 0; bj < 2; ++bj) { const u32x4 w = xb[m][bj];
                    const f32x4 x0 = {bf2f(w.x & 0xffff), bf2f(w.x >> 16), bf2f(w.y & 0xffff), bf2f(w.y >> 16)}, x1 = {bf2f(w.z & 0xffff), bf2f(w.z >> 16), bf2f(w.w & 0xffff), bf2f(w.w >> 16)};
                    const f32x4 o0 = x0 + gv[bj][0] * acc[ai][bj][m][0], o1 = x1 + gv[bj][1] * acc[ai][bj][m][1];
                    *(u32x4*)(rowp + bj * HALF) = (u32x4){cvt_pk_bf16(o0[0], o0[1]), cvt_pk_bf16(o0[2], o0[3]), cvt_pk_bf16(o1[0], o1[1]), cvt_pk_bf16(o1[2], o1[3])}; } }
        }
    }
};
struct EpiGUF {
    static constexpr bool PERM = true, CHAIN = false, BIAS_LDS = true;
    unsigned char* Ao; const float* bias; bool nobias;
    __device__ __forceinline__ const float* bias_src(const Unit& u) const { return bias + (size_t)u.z * 2048 + u.pn * BM; }
    __device__ __forceinline__ void operator()(const f32x4 (&acc)[2][2][4][2], const Unit& u, int wr, int wc, int fr, int fq, const LAS float* lb) const {
        const int row0 = u.pm * BM + wr * 64 + fr;
        f32x4 bv[2][2];
#pragma unroll
        for (int bj = 0; bj < 2; ++bj)
#pragma unroll
            for (int n = 0; n < 2; ++n) { bv[bj][n] = nobias ? (f32x4){0.1f, 0.2f, 0.3f, 0.4f} : *(const LAS f32x4*)(lb + wc * 32 + 8 * fq + bj * HALF + 4 * n); if (n == 0) bv[bj][n] *= -1.702f * 1.4426950408889634f; }
        constexpr float C1 = -1.702f * 1.4426950408889634f, K4 = 4.f / C1;
#pragma unroll
        for (int ai = 0; ai < 2; ++ai)
#pragma unroll
            for (int bj = 0; bj < 2; ++bj) { unsigned w[4];
#pragma unroll
                for (int m = 0; m < 4; ++m) { float r[4];
#pragma unroll
                    for (int j = 0; j < 4; ++j) { const float t = fmaxf(fmaf(acc[ai][bj][m][0][j], C1, bv[bj][0][j]), 7.f * C1);
                        const float s = __builtin_amdgcn_rcpf(1.f + __builtin_amdgcn_exp2f(t));
                        const float uc = __builtin_amdgcn_fmed3f(acc[ai][bj][m][1][j] + bv[bj][1][j], -7.f, 7.f);
                        r[j] = fmaf(uc, K4, K4) * (t * s); }
                    int pk = __builtin_amdgcn_cvt_pk_fp8_f32(r[0], r[1], 0, false); pk = __builtin_amdgcn_cvt_pk_fp8_f32(r[2], r[3], pk, true); w[m] = (unsigned)pk; }
                { auto p02 = __builtin_amdgcn_permlane32_swap(w[0], w[2], false, false); auto p13 = __builtin_amdgcn_permlane32_swap(w[1], w[3], false, false);
                  auto q01 = __builtin_amdgcn_permlane16_swap(p02[0], p13[0], false, false); auto q23 = __builtin_amdgcn_permlane16_swap(p02[1], p13[1], false, false);
                  w[0] = q01[0]; w[1] = q01[1]; w[2] = q23[0]; w[3] = q23[1]; }
                *(u32x4*)(Ao + (size_t)(row0 + ai * HALF + fq * 16) * D + (u.pn * (BM / 2) + wc * 16) + bj * (HALF / 2)) = (u32x4){w[0], w[1], w[2], w[3]}; }
    }
};

struct SchedGrid {
    const char* A; const char* B; int nM, nN, G, c, lda, ldb;
    __device__ __forceinline__ bool next(int i, Unit& u) const { u.z = 0; u.hf = 0; return tile_order(i * G + c, nM, nN, u.pm, u.pn); }
    __device__ __forceinline__ const char* a_ptr(const Unit& u) const { return A + (size_t)u.pm * BM * lda; }
    __device__ __forceinline__ const char* b_ptr(const Unit& u) const { return B + (size_t)u.pn * BM * ldb; }
};
struct SchedInprojR {
    const char* A; const char* B; int pn0, nN, G, c, rowb; bool ctxkv; int nfull, cmin;
    static __host__ __device__ __forceinline__ int nkv(int p0, int n) { const int lo = p0 > 8 ? p0 : 8, hi = (p0 + n) < 12 ? (p0 + n) : 12; return (hi > lo ? hi - lo : 0) + ((p0 <= 14 && 14 < p0 + n) ? 1 : 0); }
    __device__ __forceinline__ bool next(int i, Unit& u) const { u.z = 0; u.hf = 0; if (i >= nfull && c < cmin) return false;
        const int L = i < nfull ? i * G + c : nfull * G + (i - nfull) * (G - cmin) + (c - cmin), nM = ctxkv ? NLAT / BM : NTOK / BM, nl = nM * nN;
        if (L < nl) { const bool ok = tile_order(L, nM, nN, u.pm, u.pn); u.pn += pn0; return ok; }
        if (!ctxkv) return false;
        const int j = L - nl, lo = pn0 > 8 ? pn0 : 8, hi = (pn0 + nN) < 12 ? (pn0 + nN) : 12, n1 = hi > lo ? hi - lo : 0, nk = nkv(pn0, nN); if (nk == 0 || j >= (NCTX / BM) * nk) return false;
        u.pm = NLAT / BM + j / nk; const int q = j % nk; u.pn = q < n1 ? lo + q : 14; return true; }
    __device__ __forceinline__ const char* a_ptr(const Unit& u) const { return A + (size_t)u.pm * BM * rowb; }
    __device__ __forceinline__ const char* b_ptr(const Unit& u) const { return B + (size_t)u.pn * BM * rowb; }
};
__device__ __forceinline__ bool mo_tile(int T, bool ctx, Unit& u) {
    u.hf = 0; if (T < (NLAT / BM) * 4) return tile_order(T, NLAT / BM, 4, u.pm, u.pn);
    const int j = T - (NLAT / BM) * 4; if (!ctx || j >= (NCTX / BM) * 8) return false;
    u.pm = NLAT / BM + (j >> 3); u.pn = (j >> 1) & 3; u.hf = 1 + (j & 1); return true; }
struct SchedMerge {
    const char* Y; const char* W; bool ctx; int G, c;
    __device__ __forceinline__ bool next(int i, Unit& u) const { u.z = i % 3; return mo_tile((i / 3) * G + c, ctx, u); }
    __device__ __forceinline__ const char* a_ptr(const Unit& u) const { return Y + ((size_t)(u.pm * BM + (u.hf == 2 ? HALF : 0)) * 1536 + u.z * 512) * 2; }
    __device__ __forceinline__ const char* b_ptr(const Unit& u) const { return W + ((size_t)u.z * D * 512 + (size_t)u.pn * BM * 512) * 2; }
};
struct SchedOut {
    const char* A; const char* B; bool ctx; int G, c;
    __device__ __forceinline__ bool next(int i, Unit& u) const { u.z = 0; return mo_tile(i * G + c, ctx, u); }
    __device__ __forceinline__ const char* a_ptr(const Unit& u) const { return A + (size_t)(u.pm * BM + (u.hf == 2 ? HALF : 0)) * D * 2; }
    __device__ __forceinline__ const char* b_ptr(const Unit& u) const { return B + (size_t)u.pn * BM * D * 2; }
};
struct SchedMoe {
    const char* A; const char* W; const LAS int* eoff; int nN, G, c; size_t wstride; int rowb; bool gather;
    __device__ __forceinline__ bool next(int i, Unit& u) const {
        const int npan = eoff[NE] / BM;
        if (G == 256) { const int x = c & 7, r = c >> 3, ppx = 32 / nN; u.pm = (i * 8 + x) * ppx + r / nN; u.pn = r % nN; if (u.pm >= npan) return false; }
        else { const int L = i * G + c; if (L >= npan * nN) return false; u.pm = L / nN; u.pn = L % nN; }
        int e = 0; const int row = u.pm * BM;
#pragma unroll
        for (int s = 16; s >= 1; s >>= 1) { if (__builtin_amdgcn_readfirstlane(eoff[e + s]) <= row) e += s; }
        u.z = e; u.hf = 0; return true; }
    __device__ __forceinline__ const char* a_ptr(const Unit& u) const { return gather ? A : A + (size_t)u.pm * BM * rowb; }
    __device__ __forceinline__ const char* b_ptr(const Unit& u) const { return W + (size_t)u.z * wstride + (size_t)u.pn * BM * rowb; }
};
}

#define XB_TMO      128
#define XB_XCNT(j)  (256  + 64 * (j))
#define XB_XSUB(j)  (1280 + 64 * (j))
#define XB_XGEN(j)  (2304 + 64 * (j))
#define XB_TOP      3328
#define XB_TOPGEN   3392
#define XCD_BAR_WORDS 3456
#define XB_SPIN_CAP (1u << 20)
__device__ __forceinline__ unsigned xb_ld(unsigned* p)              { return __hip_atomic_load(p, __ATOMIC_RELAXED, __HIP_MEMORY_SCOPE_AGENT); }
__device__ __forceinline__ unsigned xb_add(unsigned* p, unsigned v) { return __hip_atomic_fetch_add(p, v, __ATOMIC_RELAXED, __HIP_MEMORY_SCOPE_AGENT); }
__device__ __forceinline__ unsigned xb_xcc_id() { return (unsigned)__builtin_amdgcn_s_getreg((3 << 11) | 20) & 0xFu; }
#define XB_SPIN(cond, bar) do { unsigned _sp = 0; while (cond) { __builtin_amdgcn_s_sleep(1); \
    if ((++_sp & 255u) == 0u) { if (xb_ld(&(bar)[XB_TMO])) break; if (_sp > XB_SPIN_CAP) { atomicAdd(&(bar)[XB_TMO], 1u); break; } } } } while (0)
struct XcdBarrier { unsigned* bar; unsigned x; volatile LAS unsigned* st; };
__device__ __forceinline__ XcdBarrier xcd_barrier_post(unsigned* bar, volatile LAS unsigned* st) {
    XcdBarrier b; b.bar = bar; b.x = xb_xcc_id(); b.st = st;
    if (threadIdx.x == 0) (void)xb_add(&bar[XB_XCNT(b.x)], 1u);
    return b;
}
__device__ __forceinline__ void xcd_barrier_complete(unsigned* bar, unsigned x, unsigned& nloc, unsigned& nx) {
    const unsigned G = gridDim.x * gridDim.y * gridDim.z;
    unsigned sum, cnt, mine, sp = 0u;
    for (;;) {
        sum = 0u; cnt = 0u; mine = 0u;
#pragma unroll 1
        for (unsigned j = 0; j < 16; ++j) { const unsigned c = xb_ld(&bar[XB_XCNT(j)]); sum += c; cnt += (c > 0u) ? 1u : 0u; mine = (j == x) ? c : mine; }
        if (sum == G) break;
        __builtin_amdgcn_s_sleep(1);
        if ((++sp & 255u) == 0u) { if (xb_ld(&bar[XB_TMO])) break; if (sp > XB_SPIN_CAP) { atomicAdd(&bar[XB_TMO], 1u); break; } }
    }
    nloc = mine > 0u ? mine : 1u; nx = cnt > 0u ? cnt : 1u;
}
__device__ __forceinline__ void xcd_barrier(const XcdBarrier& b, int wvid) {
    asm volatile("s_waitcnt vmcnt(0)" ::: "memory");
    __syncthreads();
    if (opaque_tid(wvid) == 0) {
        unsigned* bar = b.bar;
        __builtin_amdgcn_s_waitcnt(0);
        unsigned nloc = b.st[0], nx = b.st[1];
        if (nloc == 0u) { xcd_barrier_complete(bar, b.x, nloc, nx); b.st[0] = nloc; b.st[1] = nx; }
        const unsigned old = xb_add(&bar[XB_XSUB(b.x)], 1u);
        const unsigned gen = old / nloc;
        if (old + 1u == (gen + 1u) * nloc) {
            __builtin_amdgcn_fence(__ATOMIC_RELEASE, "agent");
            asm volatile("s_waitcnt vmcnt(0)" ::: "memory");
            const unsigned og = xb_add(&bar[XB_TOP], 1u);
            const unsigned tg = og / nx;
            if (og + 1u == (tg + 1u) * nx) xb_add(&bar[XB_TOPGEN], 1u);
            else XB_SPIN(xb_ld(&bar[XB_TOPGEN]) == tg, bar);
            __builtin_amdgcn_fence(__ATOMIC_ACQUIRE, "agent");
            xb_add(&bar[XB_XGEN(b.x)], 1u);
            asm volatile("s_waitcnt vmcnt(0)" ::: "memory");
        } else {
            XB_SPIN(xb_ld(&bar[XB_XGEN(b.x)]) == gen, bar);
            __builtin_amdgcn_fence(__ATOMIC_ACQUIRE, "agent");
            asm volatile("s_waitcnt vmcnt(0)" ::: "memory");
        }
    }
    __syncthreads();
}

#include <hip/hip_bf16.h>
#include <cmath>
namespace attn_body {
using bf16=__hip_bfloat16;
using bf16x8=__attribute__((ext_vector_type(8)))short;
using s16x4=__attribute__((ext_vector_type(4)))short;
using f32x16=__attribute__((ext_vector_type(16)))float;
using u32x4=__attribute__((ext_vector_type(4)))unsigned;
constexpr int D=64;
constexpr int NW=8,QBLK=32,QB=QBLK*NW,KVBLK=64;
constexpr int ATTN_UNIT_ROWS=QB;
__device__ __forceinline__ int crow(int r,int hi){return (r&3)+8*(r>>2)+4*hi;}
#define SBAR() __builtin_amdgcn_sched_barrier(0)
constexpr int NSLOT=3, SLOTB=8192;
constexpr int LDS_K=0, LDS_V=NSLOT*SLOTB, LDS_WS=2*NSLOT*SLOTB, LDS_OST=LDS_WS+NW*64*4, LDS_BYTES=LDS_OST+NW*4096;
constexpr float C2=0.125f*1.4426950408889634f;
__device__ __forceinline__ void glds16(const void*gsrc,unsigned lds_dst){unsigned keep;
  asm volatile("s_mov_b32 %0, m0\n\ts_mov_b32 m0, %2\n\ts_nop 0\n\tglobal_load_lds_dwordx4 %1, off\n\ts_mov_b32 m0, %0":"=&s"(keep):"v"(gsrc),"s"(lds_dst):"memory");}
__device__ __forceinline__ float max3f(float a,float b,float c){float r;asm("v_max3_f32 %0, %1, %2, %3":"=v"(r):"v"(a),"v"(b),"v"(c));return r;}
__device__ __forceinline__ float max2f(float a,float b){float r;asm("v_max_f32_e32 %0, %1, %2":"=v"(r):"v"(a),"v"(b));return r;}
__device__ __forceinline__ float fadd_s(float a,float b){float r;asm("v_add_f32_e32 %0, %1, %2":"=v"(r):"v"(a),"v"(b));return r;}
__device__ __forceinline__ float fsub_s(float a,float b){float r;asm("v_sub_f32_e32 %0, %1, %2":"=v"(r):"v"(a),"v"(b));return r;}
typedef float f32x2_t __attribute__((ext_vector_type(2))); typedef __bf16 bf16x2_t __attribute__((ext_vector_type(2)));
__device__ __forceinline__ unsigned cvtpk_s(float lo,float hi){f32x2_t v={lo,hi};bf16x2_t b=__builtin_convertvector(v,bf16x2_t);return __builtin_bit_cast(unsigned,b);}
#define WAIT_BAR(N) asm volatile("s_waitcnt vmcnt(" #N ") lgkmcnt(0)\n\ts_barrier":::"memory")

__device__ __forceinline__ void qkt(f32x16&p0,f32x16&p1,const char*Kslot,const bf16x8*qr,const f32x16&negm,int r32,int hi){
  const char*kb=Kslot+hi*1024+r32*16;
  #pragma unroll
  for(int d0=0;d0<4;++d0){
    const bf16x8 b0=*reinterpret_cast<const bf16x8*>(kb+d0*2048);
    const bf16x8 b1=*reinterpret_cast<const bf16x8*>(kb+d0*2048+512);
    if(d0==0){p0=__builtin_amdgcn_mfma_f32_32x32x16_bf16(b0,qr[0],negm,0,0,0);p1=__builtin_amdgcn_mfma_f32_32x32x16_bf16(b1,qr[0],negm,0,0,0);}
    else{p0=__builtin_amdgcn_mfma_f32_32x32x16_bf16(b0,qr[d0],p0,0,0,0);p1=__builtin_amdgcn_mfma_f32_32x32x16_bf16(b1,qr[d0],p1,0,0,0);}}
}
typedef __attribute__((address_space(3))) const char* lds_cptr;
typedef short v4i16_t __attribute__((ext_vector_type(4)));
__device__ __forceinline__ void kload8(bf16x8*kf,lds_cptr kp){
  kf[0]=*(const __attribute__((address_space(3))) bf16x8*)(kp);      kf[1]=*(const __attribute__((address_space(3))) bf16x8*)(kp+512);
  kf[2]=*(const __attribute__((address_space(3))) bf16x8*)(kp+2048); kf[3]=*(const __attribute__((address_space(3))) bf16x8*)(kp+2560);
  kf[4]=*(const __attribute__((address_space(3))) bf16x8*)(kp+4096); kf[5]=*(const __attribute__((address_space(3))) bf16x8*)(kp+4608);
  kf[6]=*(const __attribute__((address_space(3))) bf16x8*)(kp+6144); kf[7]=*(const __attribute__((address_space(3))) bf16x8*)(kp+6656);
}
__device__ __forceinline__ void kload2(bf16x8*kf,lds_cptr kp,int j){ kf[2*j]=*(const __attribute__((address_space(3))) bf16x8*)(kp+j*2048); kf[2*j+1]=*(const __attribute__((address_space(3))) bf16x8*)(kp+j*2048+512); }
__device__ __forceinline__ s16x4 vtr(lds_cptr p){ return __builtin_bit_cast(s16x4,__builtin_amdgcn_ds_read_tr16_b64_v4i16((__attribute__((address_space(3))) v4i16_t*)p)); }
__device__ __forceinline__ float rowmax(const f32x16&p0,const f32x16&p1){
  float a=max3f(p0[0],p0[1],p1[0]),b=max3f(p0[2],p0[3],p1[1]);a=max3f(a,p1[2],p1[3]);
  #pragma unroll
  for(int r=4;r<16;r+=4){a=max3f(a,p0[r],p0[r+1]);b=max3f(b,p0[r+2],p0[r+3]);a=max3f(a,p1[r],p1[r+1]);b=max3f(b,p1[r+2],p1[r+3]);}
  const float m=max2f(a,b);
  auto rr=__builtin_amdgcn_permlane32_swap(__float_as_uint(m),__float_as_uint(m),false,false);
  return max2f(__uint_as_float(rr[0]),__uint_as_float(rr[1]));
}
__device__ __forceinline__ void pv(f32x16*o,int vb,bf16x8 pa0,bf16x8 pa1,bf16x8 pa2,bf16x8 pa3){
  #pragma unroll
  for(int d0=0;d0<2;++d0){s16x4 lo[4],hi[4];
    #pragma unroll
    for(int ks=0;ks<4;++ks){
      asm volatile("ds_read_b64_tr_b16 %0,%1 offset:%c2":"=&v"(lo[ks]):"v"(vb),"i"(d0*4096+ks*1024):"memory");
      asm volatile("ds_read_b64_tr_b16 %0,%1 offset:%c2":"=&v"(hi[ks]):"v"(vb),"i"(d0*4096+ks*1024+512):"memory");}
    asm volatile("s_waitcnt lgkmcnt(0)":::"memory");SBAR();
    #define PK(k) (bf16x8){lo[k][0],lo[k][1],lo[k][2],lo[k][3],hi[k][0],hi[k][1],hi[k][2],hi[k][3]}
    o[d0]=__builtin_amdgcn_mfma_f32_32x32x16_bf16(pa0,PK(0),o[d0],0,0,0);
    o[d0]=__builtin_amdgcn_mfma_f32_32x32x16_bf16(pa1,PK(1),o[d0],0,0,0);
    o[d0]=__builtin_amdgcn_mfma_f32_32x32x16_bf16(pa2,PK(2),o[d0],0,0,0);
    o[d0]=__builtin_amdgcn_mfma_f32_32x32x16_bf16(pa3,PK(3),o[d0],0,0,0);
    #undef PK
  }
}

#ifndef ATTN_STORE16
#define ATTN_STORE16(p,v) (*(u32x4*)(p)=(v))
#endif
struct NaArgs { long trow_ctx, trow_band; int R0, rs0; const float* natab; };
template<int THRL,bool NA> __device__ __forceinline__ void attn_unit(const bf16*Qw0,int QP,const bf16*__restrict__ Kh,int KP,const bf16*__restrict__ Vh,int VP,bf16*Ow0,int OP,int NT,char*shm,const NaArgs na,int wvid,int qmode=0,const float*qgain=nullptr,int tq0=0){
  const int tid=opaque_tid(wvid),lane=tid&63,r32=lane&31,hi=lane>>5; const int wid=__builtin_amdgcn_readfirstlane(tid>>6);
  if(wid>=4)__builtin_amdgcn_s_setprio(1);
  const bf16*Qw=Qw0+(long)(wid*QBLK)*QP;
  const unsigned lds0=(unsigned)(uintptr_t)shm;
  float*wsf=(float*)(shm+LDS_WS)+wid*64;
  const bf16*ksrc=Kh+(long)lane*KP+wid*8;
  const bf16*vsrc=Vh+(long)(16*(wid&3)+(lane>>2))*VP+(wid>>2)*32+(lane&3)*8;
  const unsigned kdst=lds0+LDS_K+wid*1024, vdst=lds0+LDS_V+wid*1024;
  #define TROW(t) (NA ? ((t)<4 ? na.trow_ctx+(long)(t)*KVBLK : na.trow_band+(long)((t)-4)*KVBLK) : (long)(t)*KVBLK)
  #define DMA_K(t,slot) glds16(ksrc+TROW(t)*KP,(unsigned)__builtin_amdgcn_readfirstlane(kdst+(slot)))
  #define DMA_V(t,slot) glds16(vsrc+TROW(t)*VP,(unsigned)__builtin_amdgcn_readfirstlane(vdst+(slot)))
  const int vb0=(int)(lds0+LDS_V)+((lane>>4)&1)*32+(lane&3)*8+(4*hi+((lane&15)>>2))*64;
  const char*Kbase=shm+LDS_K; bf16x8 kf[8];
  const lds_cptr shm3=(lds_cptr)shm; const lds_cptr kp0=shm3+LDS_K+hi*1024+r32*16; const lds_cptr vp0=shm3+LDS_V+((lane>>4)&1)*32+(lane&3)*8+(4*hi+((lane&15)>>2))*64;
  DMA_K(0,0);DMA_V(0,0);DMA_K(1,SLOTB);
  bf16x8 qr[4];
  #pragma unroll
  for(int d0=0;d0<4;++d0)qr[d0]=*reinterpret_cast<const bf16x8*>(&Qw[(long)r32*QP+d0*16+hi*8]);
  if(qmode!=0){
    float v[32]; float ss=0.f;
    #pragma unroll
    for(int d0=0;d0<4;++d0)
      #pragma unroll
      for(int j=0;j<8;++j){const float x=__uint_as_float(((unsigned)(unsigned short)qr[d0][j])<<16); v[8*d0+j]=x; ss+=x*x;}
    {auto rr=__builtin_amdgcn_permlane32_swap(__float_as_uint(ss),__float_as_uint(ss),false,false); ss=__uint_as_float(rr[0])+__uint_as_float(rr[1]);}
    const float rn=rsqrtf(ss*(1.f/64.f)+EPS);
    #pragma unroll
    for(int d0=0;d0<4;++d0){const float4 g0=*(const float4*)(qgain+16*d0+8*hi),g1=*(const float4*)(qgain+16*d0+8*hi+4);
      v[8*d0+0]=v[8*d0+0]*rn*g0.x;v[8*d0+1]=v[8*d0+1]*rn*g0.y;v[8*d0+2]=v[8*d0+2]*rn*g0.z;v[8*d0+3]=v[8*d0+3]*rn*g0.w;
      v[8*d0+4]=v[8*d0+4]*rn*g1.x;v[8*d0+5]=v[8*d0+5]*rn*g1.y;v[8*d0+6]=v[8*d0+6]*rn*g1.z;v[8*d0+7]=v[8*d0+7]*rn*g1.w;}
    if(qmode==1){const int tq=tq0+wid*QBLK+r32; const float pr=(float)(tq/64),pc=(float)(tq%64);
      #pragma unroll
      for(int j=0;j<8;++j){const float inv=exp2f(-(float)(8*hi+j)*0.8304820237218406f);
        {float cs,sn;sincos_small(pr*inv,sn,cs);const float x1=v[j],x2=v[8+j];v[j]=x1*cs-x2*sn;v[8+j]=x1*sn+x2*cs;}
        {float cs,sn;sincos_small(pc*inv,sn,cs);const float x1=v[16+j],x2=v[24+j];v[16+j]=x1*cs-x2*sn;v[24+j]=x1*sn+x2*cs;}}}
    #pragma unroll
    for(int d0=0;d0<4;++d0)
      #pragma unroll
      for(int j=0;j<8;++j)qr[d0][j]=(short)f2bf(v[8*d0+j]*C2);
  }
  float mhat=0.f,l_reg=0.f;f32x16 o[2];o[0]=f32x16{};o[1]=f32x16{};f32x16 negm=f32x16{};asm volatile("":"+v"(negm));
  const int na_qr=na.R0+(wid>>1), na_rsq=min(max(na_qr-4,0),56), na_qc=(wid&1)*32+r32, na_cs=min(max(na_qc-8,0),48);
  unsigned na_w0=0u,na_w1=0u;
  if(NA){
    #pragma unroll
    for(int r=0;r<16;++r){const int kv=(r&3)+8*(r>>2)+4*hi; if((unsigned)(kv-na_cs)<16u)na_w0|=1u<<r; if((unsigned)(kv+32-na_cs)<16u)na_w1|=1u<<r;}
    const float*gt=na.natab; float*lt=(float*)(shm+LDS_BYTES)+64;
    for(int i=tid;i<15*31;i+=NW*64)lt[i]=gt[i]*1.4426950408889634f;
  }
  const float*na_tb=(const float*)(shm+LDS_BYTES)+64+(15-na_qc)+4*hi;
  #define CMASK(P0,P1,t) do{ if(NA&&(t)>=4){ const int kr_=na.rs0+(t)-4; const float rowneg_=((unsigned)(kr_-na_rsq)>=8u)?-INFINITY:0.f;     \
      const float*tb_=na_tb+min(max(kr_-na_qr+7,0),14)*31; int d0_=4*hi-na_cs; asm volatile("":"+v"(d0_));   \
      _Pragma("unroll") for(int r=0;r<16;++r){ const int c_=(r&3)+8*(r>>2); const float b0_=tb_[c_]+rowneg_,b1_=tb_[32+c_]+rowneg_; \
        P0[r]=((unsigned)(d0_+c_)<16u)?P0[r]+b0_:-INFINITY; P1[r]=((unsigned)(d0_+c_+32)<16u)?P1[r]+b1_:-INFINITY; } } }while(0)
  bool resc=false;
  #define START(P0,P1) do{ const float rm=rowmax(P0,P1); resc=false; \
    { const float dl=rm; mhat=fadd_s(mhat,dl); \
      _Pragma("unroll") for(int r=0;r<16;++r){P0[r]=fsub_s(P0[r],dl);P1[r]=fsub_s(P1[r],dl);} \
      _Pragma("unroll") for(int r=0;r<16;++r)negm[r]=-mhat; asm volatile("":"+v"(negm)); } \
    _Pragma("unroll") for(int r=0;r<16;++r)P0[r]=__builtin_amdgcn_exp2f(P0[r]); }while(0)
  #define RESC() do{ if(resc){ asm volatile("s_waitcnt lgkmcnt(0)":::"memory"); \
      _Pragma("unroll") for(int d_=0;d_<2;++d_) _Pragma("unroll") for(int r=0;r<16;++r)o[d_][r]*=wsf[crow(r,hi)]; } }while(0)
  f32x16 pA0,pA1,pB0,pB1;
  int sl_prev=0,sl_cur=0,sl_next=SLOTB;
  #define ROT() do{sl_prev=sl_cur;sl_cur=sl_next;sl_next=(sl_next==(NSLOT-1)*SLOTB)?0:sl_next+SLOTB;}while(0)
  DMA_K(2,2*SLOTB);
  WAIT_BAR(3);
  qkt(pA0,pA1,Kbase,qr,negm,r32,hi);asm volatile("s_nop 15\n\ts_nop 7":"+v"(pA0),"+v"(pA1));CMASK(pA0,pA1,0);
  START(pA0,pA1);
  _Pragma("unroll") for(int r=0;r<16;++r)pA1[r]=__builtin_amdgcn_exp2f(pA1[r]);
  WAIT_BAR(0);
  DMA_K(3,0);DMA_V(1,SLOTB);
  ROT();
  kload8(kf,kp0+sl_cur);
  WAIT_BAR(2);
  s16x4 vlo[8],vhi[8]; u32x4 pw0,pw1,pw2,pw3;
  #define PKW(P,B) cvtpk_s(P[B],P[B+1])
  #define PAF(k) __builtin_bit_cast(bf16x8,pw##k)
  #define VFR(i) (bf16x8){vlo[i][0],vlo[i][1],vlo[i][2],vlo[i][3],vhi[i][0],vhi[i][1],vhi[i][2],vhi[i][3]}
  #define PIN(x) asm volatile("":"+v"(x))
  #define MX3(a,b,c) __builtin_fmaxf(__builtin_fmaxf((a),(b)),(c))
  #define GAPA(MF,A0,A1,A2,A3,W0,W1,PW) do{ MF; sacc+=A0; sacc+=A1; sacc+=A2; sacc+=A3; PIN(sacc); W0; W1; PIN(PW); SBAR(); }while(0)
  #define EX(v) __builtin_amdgcn_exp2f(v)
  #define GAPB(MF,X,B) do{ MF; X[B]=EX(X[B]); X[B+1]=EX(X[B+1]); X[B+2]=EX(X[B+2]); X[B+3]=EX(X[B+3]); PIN(X); SBAR(); }while(0)
  #define VRD(i) do{ vlo[i]=vtr(vp_+(((i)>>2)*4096+((i)&3)*1024)); vhi[i]=vtr(vp_+(((i)>>2)*4096+((i)&3)*1024+512)); }while(0)
  #define KRD(G,j) do{ if(G){ kload2(kf,kp0+sl_next,j); SBAR(); } }while(0)
  #define STEP(C0,C1,P0,P1,t,GK,GV,GL) do{ SBAR(); \
    const lds_cptr vp_=vp0+sl_prev; \
    VRD(0); SBAR(); float sacc=(P0[0]+P0[1]); \
    GAPA(C0=__builtin_amdgcn_mfma_f32_32x32x16_bf16(kf[0],qr[0],negm,0,0,0), P0[2],P0[3],P0[4],P0[5],     pw0[0]=PKW(P0,0), pw0[1]=PKW(P0,2), pw0); \
    VRD(4); SBAR(); GAPA(C1=__builtin_amdgcn_mfma_f32_32x32x16_bf16(kf[1],qr[0],negm,0,0,0), P0[6],P0[7],P0[8],P0[9],     pw0[2]=PKW(P0,4), pw0[3]=PKW(P0,6), pw0); \
    VRD(1); SBAR(); GAPA(C0=__builtin_amdgcn_mfma_f32_32x32x16_bf16(kf[2],qr[1],C0,0,0,0),   P0[10],P0[11],P0[12],P0[13], pw1[0]=PKW(P0,8), pw1[1]=PKW(P0,10), pw1); \
    VRD(5); SBAR(); GAPA(C1=__builtin_amdgcn_mfma_f32_32x32x16_bf16(kf[3],qr[1],C1,0,0,0),   P0[14],P0[15],P1[0],P1[1],   pw1[2]=PKW(P0,12),pw1[3]=PKW(P0,14), pw1); \
    VRD(2); SBAR(); GAPA(C0=__builtin_amdgcn_mfma_f32_32x32x16_bf16(kf[4],qr[2],C0,0,0,0),   P1[2],P1[3],P1[4],P1[5],     pw2[0]=PKW(P1,0), pw2[1]=PKW(P1,2), pw2); \
    VRD(6); SBAR(); GAPA(C1=__builtin_amdgcn_mfma_f32_32x32x16_bf16(kf[5],qr[2],C1,0,0,0),   P1[6],P1[7],P1[8],P1[9],     pw2[2]=PKW(P1,4), pw2[3]=PKW(P1,6), pw2); \
    VRD(3); SBAR(); GAPA(C0=__builtin_amdgcn_mfma_f32_32x32x16_bf16(kf[6],qr[3],C0,0,0,0),   P1[10],P1[11],P1[12],P1[13], pw3[0]=PKW(P1,8), pw3[1]=PKW(P1,10), pw3); \
    VRD(7); SBAR(); GAPA(C1=__builtin_amdgcn_mfma_f32_32x32x16_bf16(kf[7],qr[3],C1,0,0,0),   P1[14],P1[15],0.f,0.f,       pw3[2]=PKW(P1,12),pw3[3]=PKW(P1,14), pw3); \
    l_reg+=sacc; \
    if(GK){DMA_K((t)+3,sl_cur);} if(GV){DMA_V((t)+1,sl_next);} \
    CMASK(C0,C1,t); \
    { float a=MX3(C0[0],C0[1],C1[0]),b=MX3(C0[2],C0[3],C1[1]); a=MX3(a,C1[2],C1[3]); \
      _Pragma("unroll") for(int r=4;r<16;r+=4){a=MX3(a,C0[r],C0[r+1]);b=MX3(b,C0[r+2],C0[r+3]);a=MX3(a,C1[r],C1[r+1]);b=MX3(b,C1[r+2],C1[r+3]);} \
      float rm=__builtin_fmaxf(a,b); { auto rr=__builtin_amdgcn_permlane32_swap(__float_as_uint(rm),__float_as_uint(rm),false,false); rm=__builtin_fmaxf(__uint_as_float(rr[0]),__uint_as_float(rr[1])); } \
      resc=false; \
      if(__builtin_expect(__any(rm>(float)THRL),0)){ const float dl=__builtin_fmaxf(rm,0.f); mhat+=dl; \
        _Pragma("unroll") for(int r=0;r<16;++r){C0[r]-=dl;C1[r]-=dl;} \
        _Pragma("unroll") for(int r=0;r<16;++r)negm[r]=-mhat; asm volatile("":"+v"(negm)); \
        const float f=__builtin_amdgcn_exp2f(-dl); l_reg*=f; if(hi==0)wsf[r32]=f; resc=true; } } \
    SBAR(); \
    GAPB(o[0]=__builtin_amdgcn_mfma_f32_32x32x16_bf16(PAF(0),VFR(0),o[0],0,0,0), C0,0); \
    GAPB(o[1]=__builtin_amdgcn_mfma_f32_32x32x16_bf16(PAF(0),VFR(4),o[1],0,0,0), C0,4); \
    KRD(GL,0); GAPB(o[0]=__builtin_amdgcn_mfma_f32_32x32x16_bf16(PAF(1),VFR(1),o[0],0,0,0), C0,8); \
    KRD(GL,1); GAPB(o[1]=__builtin_amdgcn_mfma_f32_32x32x16_bf16(PAF(1),VFR(5),o[1],0,0,0), C0,12); \
    KRD(GL,2); GAPB(o[0]=__builtin_amdgcn_mfma_f32_32x32x16_bf16(PAF(2),VFR(2),o[0],0,0,0), C1,0); \
    KRD(GL,3); GAPB(o[1]=__builtin_amdgcn_mfma_f32_32x32x16_bf16(PAF(2),VFR(6),o[1],0,0,0), C1,4); \
    GAPB(o[0]=__builtin_amdgcn_mfma_f32_32x32x16_bf16(PAF(3),VFR(3),o[0],0,0,0), C1,8); \
    GAPB(o[1]=__builtin_amdgcn_mfma_f32_32x32x16_bf16(PAF(3),VFR(7),o[1],0,0,0), C1,12); \
    }while(0)
  int t=1;
  for(;t+5<NT;t+=2){
    STEP(pB0,pB1,pA0,pA1,t,true,true,true);     WAIT_BAR(2); RESC(); ROT();
    STEP(pA0,pA1,pB0,pB1,t+1,true,true,true);   WAIT_BAR(2); RESC(); ROT();
  }
  #define ENDW(tt) do{ if((tt)+3<NT){WAIT_BAR(2);} else if((tt)+2<NT){WAIT_BAR(1);} else {WAIT_BAR(0);} }while(0)
  for(;t+1<NT;t+=2){
    STEP(pB0,pB1,pA0,pA1,t,(t+3<NT),(t+1<NT),(t+1<NT));       ENDW(t);   RESC(); ROT();
    STEP(pA0,pA1,pB0,pB1,t+1,(t+4<NT),(t+2<NT),(t+2<NT));     ENDW(t+1); RESC(); ROT();
  }
  STEP(pB0,pB1,pA0,pA1,NT-1,false,false,false); RESC();
  { float sacc=pB0[0]+pB0[1]; _Pragma("unroll") for(int r=2;r<16;++r)sacc+=pB0[r]; _Pragma("unroll") for(int r=0;r<16;++r)sacc+=pB1[r]; l_reg+=sacc;
    pw0=(u32x4){PKW(pB0,0),PKW(pB0,2),PKW(pB0,4),PKW(pB0,6)};pw1=(u32x4){PKW(pB0,8),PKW(pB0,10),PKW(pB0,12),PKW(pB0,14)};pw2=(u32x4){PKW(pB1,0),PKW(pB1,2),PKW(pB1,4),PKW(pB1,6)};pw3=(u32x4){PKW(pB1,8),PKW(pB1,10),PKW(pB1,12),PKW(pB1,14)};
    SBAR(); pv(o,vb0+sl_cur,PAF(0),PAF(1),PAF(2),PAF(3)); }
  #undef PKW
  #undef PAF
  #undef VFR
  #undef PIN
  #undef MX3
  #undef GAPA
  #undef GAPB
  #undef EX
  #undef VRD
  #undef KRD
  #undef STEP
  #undef ENDW
  {auto rr=__builtin_amdgcn_permlane32_swap(__float_as_uint(l_reg),__float_as_uint(l_reg),false,false);l_reg=__uint_as_float(rr[0])+__uint_as_float(rr[1]);}
  if(hi==0)wsf[32+r32]=l_reg;asm volatile("s_waitcnt lgkmcnt(0)":::"memory");
  float rli[16];
  #pragma unroll
  for(int r=0;r<16;++r)rli[r]=__builtin_amdgcn_rcpf(wsf[32+crow(r,hi)]);
  bf16*Ow=Ow0+(long)(wid*QBLK)*OP;
  { bf16*stg=(bf16*)(shm+LDS_OST)+wid*2048;
    #pragma unroll
    for(int r=0;r<16;++r){const int orow=crow(r,hi);
      #pragma unroll
      for(int d0=0;d0<2;++d0)stg[orow*64+d0*32+r32]=__float2bfloat16(o[d0][r]*rli[r]);}
    asm volatile("s_waitcnt lgkmcnt(0)":::"memory");
    #pragma unroll
    for(int i=0;i<4;++i){const int row=i*8+(lane>>3),ch=lane&7; const u32x4 v=*(const u32x4*)(stg+row*64+ch*8); ATTN_STORE16(Ow+(long)row*OP+ch*8,v);} }
  __builtin_amdgcn_s_setprio(0);
  asm volatile("s_waitcnt lgkmcnt(0)\n\ts_barrier":::"memory");
  #undef DMA_K
  #undef DMA_V
  #undef TROW
  #undef CMASK
  #undef START
  #undef RESC
  #undef ROT
}
constexpr int ATTN_LDS_BYTES=LDS_BYTES+(64+15*31+64+3)/4*4*4;
#undef SBAR
#undef WAIT_BAR
}
#ifndef MK_PHMASK
#define MK_PHMASK 0xffffffff
#endif
#ifndef MK_REPEAT
#define MK_REPEAT 0
#endif
#define REPS(b) for (int rep_ = 0; rep_ < 1 + ((MK_REPEAT >> (b)) & 1); ++rep_)
constexpr int NWAVES = 8;
constexpr int RING_BYTES = 131072, LDSCTL_OFF = RING_BYTES, MISC_OFF = LDSCTL_OFF + 320, EOFF_OFF = LDSCTL_OFF + 1024, HIST_OFF = LDSCTL_OFF + 1280, SC_PART_OFF = LDSCTL_OFF + 1536,
              SC_TOT_OFF = LDSCTL_OFF + 5632, SC_BASE_OFF = LDSCTL_OFF + 5760, SC_EOFF_OFF = LDSCTL_OFF + 5888, SC_WCNT_OFF = LDSCTL_OFF + 6144, SC_SLOT_OFF = LDSCTL_OFF + 8192, PTAB_OFF = LDSCTL_OFF + 512, GTAB_OFF = LDSCTL_OFF + 12288, LBIAS_OFF = LDSCTL_OFF + 14336, LDS_BYTES = 147456;
enum { PH_PRE0 = 0, PH_PRE1 = 1, PH_L0 = 2, PHL_INPROJ = 0, PHL_MIX1 = 1, PHL_MIX2 = 2, PHL_MERGE = 3, PHL_OUT = 4, PHL_ROUTE = 5, PHL_SCAN = 6, PHL_GEMM1 = 7, PHL_GEMM2 = 8, PHL_COMB = 9, PHL_N = 10, PH_END = PH_L0 + 2 * PHL_N };
struct MkArgs { Ptrs p; int ph_lo, ph_hi; };

__device__ __forceinline__ void cvt_item(const float* W, int K, int N, bf16_t* WT, bool deint, LAS float* scr, int item, int lane) {
    const int nblk = N / 32, kb = item / nblk, nb = item % nblk, k0 = 64 * kb, n0 = 32 * nb;
#pragma unroll 8
    for (int i = 0; i < 32; ++i) { const int kk = 2 * i + (lane >> 5); scr[kk * 33 + (lane & 31)] = W[(size_t)(k0 + kk) * N + n0 + (lane & 31)]; }
    asm volatile("s_waitcnt lgkmcnt(0)" ::: "memory");
    const int c = lane & 7;
#pragma unroll
    for (int j = 0; j < 4; ++j) { const int n = (lane >> 3) + 8 * j; const LAS float* s = scr + (8 * c) * 33 + n;
        pg8::u32x4 o; o.x = pk2(s[0 * 33], s[1 * 33]); o.y = pk2(s[2 * 33], s[3 * 33]); o.z = pk2(s[4 * 33], s[5 * 33]); o.w = pk2(s[6 * 33], s[7 * 33]);
        const int no = n0 + n, nd = deint ? ((no & ~7) | ((no & 1) << 2) | ((no & 7) >> 1)) : no;
        *(pg8::u32x4*)(WT + (size_t)nd * K + k0 + 8 * c) = o; }
    asm volatile("s_waitcnt lgkmcnt(0)" ::: "memory");
}

__device__ __forceinline__ void cvt_item_fp8(const float* W, int K, int N, unsigned char* WT, bool deint, LAS float* scr, int item, int lane) {
    const int nblk = N / 32, kb = item / nblk, nb = item % nblk, k0 = 64 * kb, n0 = 32 * nb;
#pragma unroll 8
    for (int i = 0; i < 32; ++i) { const int kk = 2 * i + (lane >> 5); scr[kk * 33 + (lane & 31)] = W[(size_t)(k0 + kk) * N + n0 + (lane & 31)]; }
    asm volatile("s_waitcnt lgkmcnt(0)" ::: "memory");
    const int c = lane & 7;
#pragma unroll
    for (int j = 0; j < 4; ++j) { const int n = (lane >> 3) + 8 * j; const LAS float* s = scr + (8 * c) * 33 + n;
        int lo = __builtin_amdgcn_cvt_pk_fp8_f32(64.f * s[0 * 33], 64.f * s[1 * 33], 0, false); lo = __builtin_amdgcn_cvt_pk_fp8_f32(64.f * s[2 * 33], 64.f * s[3 * 33], lo, true);
        int hi = __builtin_amdgcn_cvt_pk_fp8_f32(64.f * s[4 * 33], 64.f * s[5 * 33], 0, false); hi = __builtin_amdgcn_cvt_pk_fp8_f32(64.f * s[6 * 33], 64.f * s[7 * 33], hi, true);
        const int no = n0 + n, nd = deint ? ((no & ~7) | ((no & 1) << 2) | ((no & 7) >> 1)) : no;
        *(pg8::u32x2*)(WT + (size_t)nd * K + k0 + 8 * c) = (pg8::u32x2){(unsigned)lo, (unsigned)hi}; }
    asm volatile("s_waitcnt lgkmcnt(0)" ::: "memory");
}

struct CvtJob { const float* W; unsigned char* WT; int K, N, item, mode, ldw; };
__device__ __forceinline__ void cvt_load(const CvtJob& j, int lane, float4 (&wv)[8]) {
    const int nblk = j.N / 32, kb = j.item / nblk, nb = j.item % nblk, k0 = 64 * kb, n0 = 32 * nb;
#pragma unroll
    for (int i = 0; i < 8; ++i) wv[i] = *(const float4*)(j.W + (size_t)(k0 + 8 * i + (lane >> 3)) * j.ldw + n0 + 4 * (lane & 7));
}
__device__ __forceinline__ void cvt_finish(const CvtJob& j, const float4 (&wv)[8], LAS float* scr, int lane, bool st = true) {
    const int nblk = j.N / 32, kb = j.item / nblk, nb = j.item % nblk, k0 = 64 * kb, n0 = 32 * nb;
#pragma unroll
    for (int i = 0; i < 8; ++i) { LAS float* d = scr + (8 * i + (lane >> 3)) * 33 + 4 * (lane & 7); d[0] = wv[i].x; d[1] = wv[i].y; d[2] = wv[i].z; d[3] = wv[i].w; }
    asm volatile("s_waitcnt lgkmcnt(0)" ::: "memory");
    const int c = lane & 7;
    if (j.mode == 0) {
#pragma unroll
        for (int jj = 0; jj < 4; ++jj) { const int n = (lane >> 3) + 8 * jj; const LAS float* s = scr + (8 * c) * 33 + n; const int nd = n0 + n;
            pg8::u32x4 o; o.x = pg8::cvt_pk_bf16(s[0 * 33], s[1 * 33]); o.y = pg8::cvt_pk_bf16(s[2 * 33], s[3 * 33]); o.z = pg8::cvt_pk_bf16(s[4 * 33], s[5 * 33]); o.w = pg8::cvt_pk_bf16(s[6 * 33], s[7 * 33]);
            if (st || o.x == 0x12345u) *(pg8::u32x4*)((bf16_t*)j.WT + (size_t)nd * j.K + k0 + 8 * c) = o; }
    } else {
#pragma unroll
        for (int jj = 0; jj < 4; ++jj) { const int n = (lane >> 3) + 8 * jj; const LAS float* s = scr + (8 * c) * 33 + n;
            const int no = n0 + n, nd = j.mode == 2 ? ((no & ~7) | ((no & 1) << 2) | ((no & 7) >> 1)) : no;
            int lo = __builtin_amdgcn_cvt_pk_fp8_f32(64.f * s[0 * 33], 64.f * s[1 * 33], 0, false); lo = __builtin_amdgcn_cvt_pk_fp8_f32(64.f * s[2 * 33], 64.f * s[3 * 33], lo, true);
            int hi = __builtin_amdgcn_cvt_pk_fp8_f32(64.f * s[4 * 33], 64.f * s[5 * 33], 0, false); hi = __builtin_amdgcn_cvt_pk_fp8_f32(64.f * s[6 * 33], 64.f * s[7 * 33], hi, true);
            if (st || lo == 0x12345) *(pg8::u32x2*)(j.WT + (size_t)nd * j.K + k0 + 8 * c) = (pg8::u32x2){(unsigned)lo, (unsigned)hi}; }
    }
    asm volatile("s_waitcnt lgkmcnt(0)" ::: "memory");
}

__global__ void __launch_bounds__(NWAVES * 64, 2) mk_fwd(MkArgs args) {
    extern __shared__ __attribute__((aligned(16))) unsigned char lds_raw[];
    LAS unsigned char* lds = (LAS unsigned char*)lds_raw;
    volatile LAS unsigned* MISC = (volatile LAS unsigned*)(lds + MISC_OFF);
    const Ptrs& p = args.p; unsigned char* const ws0_ = p.ws;
    const int G = gridDim.x, bx = blockIdx.x, wv_ = __builtin_amdgcn_readfirstlane((int)threadIdx.x >> 6);
    { const int tid0 = threadIdx.x; for (int u = tid0; u < (LDS_BYTES - LDSCTL_OFF) / 4; u += NWAVES * 64) ((LAS unsigned*)(lds + LDSCTL_OFF))[u] = 0u;
 }
    __syncthreads();
    const int lo = args.ph_lo, hi = args.ph_hi;
    unsigned* const barw = (unsigned*)(ws0_ + WS_CTL) + CW_BAR;
    XcdBarrier bar; bar.bar = barw; bar.x = 0; bar.st = nullptr;
    if (hi - lo > 1) bar = xcd_barrier_post(barw, MISC + 8);
#define IN(k) (lo <= (k) && (k) < hi)
#define SEAM(k) do { if (IN(k) && IN((k) + 1)) { xcd_barrier(bar, wv_); if ((MK_REPEAT >> 13) & 1) xcd_barrier(bar, wv_); } } while (0)
#define PHASE_WS unsigned long long wsa_ = (unsigned long long)ws0_; asm volatile("" : "+s"(wsa_)); unsigned char* const ws = (unsigned char*)(GAS unsigned char*)wsa_
#define PHASE_IDS PHASE_WS; const int tid = opaque_tid(wv_), lane = tid & 63, wave = __builtin_amdgcn_readfirstlane(tid >> 6), gw = bx * NWAVES + wave, NGW = G * NWAVES; (void)lane; (void)gw; (void)NGW

    if (IN(PH_PRE0) && (MK_PHMASK & 1)) {
        PHASE_IDS;
        LAS float* scr = (LAS float*)(lds + wave * 8448); LAS float* sil = (LAS float*)(lds + 8 * 8448);
        constexpr int I_MOD = 2 * (MODW / 32);
        if (bx * NWAVES < I_MOD) { for (int i = tid; i < 9 * D; i += NWAVES * 64) { const int r = i >> 10, k = i & 1023; const float v = r < 8 ? p.c[r * D + k] : p.c_ctx[k]; sil[i] = v / (1.f + expf(-v)); } }
        __syncthreads();
        constexpr int I_INB = (D / 64) * (IP_S * 8), I_IN8 = (D / 64) * ((27 - IP_S) * 8), I_BR = (512 / 64) * (D / 32), I_OUT = (D / 64) * (D / 32), I_GU = (D / 64) * (2048 / 32), I_DN = (D / 64) * (D / 32);
        constexpr int T_INB = 2 * I_INB, T_IN8 = 2 * I_IN8, T_BR = 6 * I_BR, T_OUT = 2 * I_OUT, T_GU = 64 * I_GU, T_DN = 64 * I_DN, NITEMS = I_MOD + T_INB + T_IN8 + T_BR + T_OUT + T_GU + T_DN;
        auto decode = [&](int r) -> CvtJob {
            if (r < T_INB) { const int l = r / (I_INB > 0 ? I_INB : 1); return CvtJob{p.w_in + (size_t)l * D * INC, ws + WS_WIN + (size_t)l * INC * D * 2, D, IP_S * 256, r % (I_INB > 0 ? I_INB : 1), 0, INC}; } r -= T_INB;
            if (r < T_IN8) { const int l = r / (I_IN8 > 0 ? I_IN8 : 1); return CvtJob{p.w_in + (size_t)l * D * INC + IP_S * 256, ws + WS_WIN8 + ((size_t)l * INC + IP_S * 256) * D, D, (27 - IP_S) * 256, r % (I_IN8 > 0 ? I_IN8 : 1), 1, INC}; } r -= T_IN8;
            if (r < T_BR) { const int q = r / I_BR, l = q / 3, br = q % 3; const float* src = (br == 0 ? p.w_br_conv : br == 1 ? p.w_br_na : p.w_br_gqa) + (size_t)l * 512 * D;
                return CvtJob{src, ws + WS_WMG + (size_t)q * D * 512 * 2, 512, D, r % I_BR, 0, D}; } r -= T_BR;
            if (r < T_OUT) { const int l = r / I_OUT; return CvtJob{p.w_out + (size_t)l * D * D, ws + WS_WOUT + (size_t)l * D * D * 2, D, D, r % I_OUT, 0, D}; } r -= T_OUT;
            if (r < T_GU) { const int q = r / I_GU; return CvtJob{p.w_gu + (size_t)q * D * 2048, ws + WS_WGU + (size_t)q * 2048 * D, D, 2048, r % I_GU, 2, 2048}; } r -= T_GU;
            const int q = r / I_DN; return CvtJob{p.w_down + (size_t)q * D * D, ws + WS_WDN + (size_t)q * D * D, D, D, r % I_DN, 1, D}; };
        REPS(0) { int it = gw; const bool st_ = !(((MK_REPEAT >> 20) & 1) && rep_ == 1);
            if (it < I_MOD) { if (!(((MK_REPEAT >> 21) & 1) && rep_ == 1)) mod_item(p, it, lane, sil); it += NGW; }
            if (it < NITEMS) {
                auto J = [&](int x) -> CvtJob { return decode(min(x, NITEMS - 1) - I_MOD); };
                CvtJob ja = J(it), jb = J(it + NGW), jc = ja; float4 wa[8], wb[8], wc[8];
                cvt_load(ja, lane, wa); cvt_load(jb, lane, wb);
                for (;;) {
                    jc = J(it + 2 * NGW); cvt_load(jc, lane, wc); cvt_finish(ja, wa, scr, lane, st_); it += NGW; if (it >= NITEMS) break;
                    ja = J(it + 2 * NGW); cvt_load(ja, lane, wa); cvt_finish(jb, wb, scr, lane, st_); it += NGW; if (it >= NITEMS) break;
                    jb = J(it + 2 * NGW); cvt_load(jb, lane, wb); cvt_finish(jc, wc, scr, lane, st_); it += NGW; if (it >= NITEMS) break;
                } } }
        for (int i = bx * 512 + tid; i < 2 * NE * D; i += G * 512) { const int ll = i >> 15, e = (i >> 10) & 31, k = i & 1023; ((_Float16*)(ws + WS_WRT))[i] = (_Float16)p.router_w[(size_t)ll * D * NE + k * NE + e]; }
        for (int i = bx * 512 + tid; i < 2 * NE * 2048; i += G * 512) { const int no = i & 2047, nd = (no & ~7) | ((no & 1) << 2) | ((no & 7) >> 1); ((float*)(ws + WS_BGU))[(i & ~2047) + nd] = p.b_gu[i]; }
        __syncthreads();
    }
    SEAM(PH_PRE0);
    if (IN(PH_PRE1) && (MK_PHMASK & 1)) {
        PHASE_IDS;
        REPS(12) for (int rowb = gw; rowb < NTOK; rowb += 4 * NGW) {
            float4 v[4][4];
#pragma unroll
            for (int q = 0; q < 4; ++q) { const int row = rowb + q * NGW; if (row < NTOK) { const float4* xr = (const float4*)(row < NLAT ? p.x + (size_t)row * D : p.ctx + (size_t)(row - NLAT) * D);
#pragma unroll
                for (int i = 0; i < 4; ++i) v[q][i] = xr[lane + 64 * i]; } }
#pragma unroll
            for (int q = 0; q < 4; ++q) { const int row = rowb + q * NGW; if (row < NTOK) { float ss = 0.f;
#pragma unroll
                for (int i = 0; i < 4; ++i) ss += v[q][i].x * v[q][i].x + v[q][i].y * v[q][i].y + v[q][i].z * v[q][i].z + v[q][i].w * v[q][i].w;
                const float r = rsqrtf(wave_sum(ss, lane) * (1.f / D) + EPS);
                { uint2* xo = (uint2*)((bf16_t*)(ws + WS_X) + (size_t)row * D);
#pragma unroll
                  for (int i = 0; i < 4; ++i) xo[lane + 64 * i] = make_uint2(pk2(v[q][i].x, v[q][i].y), pk2(v[q][i].z, v[q][i].w)); }
                norm_mod_store(v[q], r, p.norm1_g, (const float*)(ws + WS_MOD) + (size_t)mod_row(row) * MODW, ws, row, lane); } }
        }
    }
    SEAM(PH_PRE1);
#pragma unroll 1
    for (int l = 0; l < 2; ++l) {
        const int pb = PH_L0 + l * PHL_N; const bool lastl = (l == 1); const int nrows = lastl ? NLAT : NTOK;
        if (IN(pb + PHL_INPROJ) && (MK_PHMASK & 2)) {
            PHASE_WS;
            pg8::EpiStoreBf16<false> E{(bf16_t*)(ws + WS_P), INC, nullptr, 0, ATT_C2, O_NAQ / 256, O_NAK / 256, O_BGC / 256};
            constexpr int NB16 = IP_S, N8 = 27 - IP_S;
            const int t16 = lastl ? (NLAT / 256) * NB16 + (NCTX / 256) * pg8::SchedInprojR::nkv(0, NB16) : (NTOK / 256) * NB16;
            const int t8 = lastl ? (NLAT / 256) * N8 + (NCTX / 256) * pg8::SchedInprojR::nkv(NB16, N8) : (NTOK / 256) * N8;
            const int cmin = t16 % G, nf0 = t8 / G - (cmin > 0 ? 1 : 0), nfull = nf0 > 0 ? nf0 : 0;
            if (NB16 > 0) { pg8::SchedInprojR S{(const char*)(ws + WS_H), (const char*)(ws + WS_WIN) + (size_t)l * INC * D * 2, 0, NB16, G, bx, D * 2, lastl, 1 << 30, 0};
                REPS(1) pg8::gemm_phase<pg8::EpiStoreBf16<false>, pg8::SchedInprojR, true, true>(lds, pg8::Gemm{D * 2, D * 2, D * 2, 0, 0}, S, E, wv_); }
            if (N8 > 0) { pg8::SchedInprojR S{(const char*)(ws + WS_H8), (const char*)(ws + WS_WIN8) + (size_t)l * INC * D, NB16, N8, G, bx, D, lastl, nfull, cmin};
                REPS(1) pg8::gemm_phase<pg8::EpiStoreBf16<false>, pg8::SchedInprojR, true, true, true>(lds, pg8::Gemm{D, D, D, 0x7f7f7f7f, 0x79797979}, S, E, wv_); }
        }
        SEAM(pb + PHL_INPROJ);
        if (IN(pb + PHL_MIX1) && (MK_PHMASK & 64)) {
            PHASE_IDS;
            REPS(9) for (int i = bx * 512 + tid; i < nrows * 16; i += G * 512) conv_item4(p, l, i);
            REPS(9) for (int i = bx * 512 + tid; i < NTOK * 2; i += G * 512) kprep_item(p, l, i);
            __syncthreads();
            typedef attn_body::bf16 abf;
            const abf* Pq = (const abf*)(ws + WS_P); abf* Yo = (abf*)(ws + WS_Y);
            REPS(2) { const int b = bx & 7, j = bx >> 3;
#pragma unroll 1
                for (int i = 0; i < 4; ++i) { const int u = j * 4 + i, h = u >> 4, R0 = (u & 15) * 4; const size_t row0 = (size_t)b * SEQ + R0 * 64;
                    const int rs0 = min(max(R0 - 4, 0), 56), rlast = min(max(R0 - 1, 0), 56) + 7; int NT = 4 + (rlast - rs0 + 1); NT += NT & 1;
                    const attn_body::NaArgs na{(long)NLAT + (long)b * CTXL, (long)b * SEQ + (long)rs0 * 64, R0, rs0, p.na_rpb + ((size_t)l * 8 + h) * 465};
                    attn_body::attn_unit<8, true>(Pq + row0 * INC + O_NAQ + h * 64, INC, Pq + O_NAK + h * 64, INC, Pq + O_NAV + h * 64, INC, Yo + row0 * 1536 + 512 + h * 64, 1536, NT, (char*)lds_raw, na, wv_); } }
        }
        SEAM(pb + PHL_MIX1);
        if (IN(pb + PHL_MIX2) && (MK_PHMASK & 128)) {
            PHASE_WS;
            typedef attn_body::bf16 abf;
            const abf* Pq = (const abf*)(ws + WS_P); const abf* Kg = (const abf*)(ws + WS_KG); const abf* Vg = (const abf*)(ws + WS_VG); abf* Yo = (abf*)(ws + WS_Y);
            REPS(3) { const int b = bx & 7, j = bx >> 3;
#pragma unroll 1
                for (int i = 0; i < 4; ++i) { const int u = j * 4 + i, h = u >> 4, qb = u & 15; const size_t row0 = (size_t)b * SEQ + qb * 256;
                    attn_body::attn_unit<8, false>(Pq + row0 * INC + O_GQ + h * 64, INC, Kg + ((size_t)b * KVLEN * 2 + (h >> 2)) * 64, 128, Vg + ((size_t)b * KVLEN * 2 + (h >> 2)) * 64, 128,
                                            Yo + row0 * 1536 + 1024 + h * 64, 1536, KVLEN / 64, (char*)lds_raw, attn_body::NaArgs{}, wv_, 1, p.q_norm_g + l * 64, qb * 256); } }
            if (!lastl && bx < 128) {
                const int kind = bx >> 6, b = (bx >> 3) & 7, h = bx & 7; const size_t row0 = (size_t)NLAT + (size_t)b * CTXL;
                if (kind == 0) attn_body::attn_unit<8, false>(Pq + row0 * INC + O_GQ + h * 64, INC, Kg + (((size_t)b * KVLEN + SEQ) * 2 + (h >> 2)) * 64, 128, Vg + (((size_t)b * KVLEN + SEQ) * 2 + (h >> 2)) * 64, 128,
                                                       Yo + row0 * 1536 + 1024 + h * 64, 1536, CTXL / 64, (char*)lds_raw, attn_body::NaArgs{}, wv_, 2, p.q_norm_g + l * 64, 0);
                else attn_body::attn_unit<8, false>(Pq + row0 * INC + O_NAQ + h * 64, INC, Pq + row0 * INC + O_NAK + h * 64, INC, Pq + row0 * INC + O_NAV + h * 64, INC,
                                             Yo + row0 * 1536 + 512 + h * 64, 1536, CTXL / 64, (char*)lds_raw, attn_body::NaArgs{}, wv_);
            }
        }
        SEAM(pb + PHL_MIX2);
        if (IN(pb + PHL_MERGE) && (MK_PHMASK & 4)) {
            PHASE_WS;
            pg8::SchedMerge S{(const char*)(ws + WS_Y), (const char*)(ws + WS_WMG) + (size_t)l * 3 * D * 512 * 2, !lastl, G, bx};
            pg8::EpiMergeF E{(const bf16_t*)(ws + WS_P), (bf16_t*)(ws + WS_M)};
            REPS(14) pg8::gemm_phase<pg8::EpiMergeF, pg8::SchedMerge, true, true, false, false, true>(lds, pg8::Gemm{512 * 2, 1536 * 2, 512 * 2, 0, 0}, S, E, wv_);
            if ((MK_REPEAT >> 4) & 1) { pg8::EpiNull EN{(float*)(ws + WS_CTL) + 8000}; pg8::gemm_phase<pg8::EpiNull, pg8::SchedMerge, true, true, false, false, true>(lds, pg8::Gemm{512 * 2, 1536 * 2, 512 * 2, 0, 0}, S, EN, wv_); }
        }
        SEAM(pb + PHL_MERGE);
        if (IN(pb + PHL_OUT) && (MK_PHMASK & 8)) {
            PHASE_WS;
            pg8::SchedOut S{(const char*)(ws + WS_M), (const char*)(ws + WS_WOUT) + (size_t)l * D * D * 2, !lastl, G, bx};
            REPS(10) { pg8::EpiOutF E{(bf16_t*)(ws + WS_X), (const float*)(ws + WS_MOD) + (size_t)l * 9 * MODW, rep_ ? 0.f : 1.f};
                pg8::gemm_phase<pg8::EpiOutF, pg8::SchedOut, true, true, false, false, true>(lds, pg8::Gemm{D * 2, D * 2, D * 2, 0, 0}, S, E, wv_); }
        }
        SEAM(pb + PHL_OUT);
        if (IN(pb + PHL_ROUTE) && (MK_PHMASK & 256)) {
            PHASE_IDS;
            typedef _Float16 h8 __attribute__((ext_vector_type(8))); typedef _Float16 h2v __attribute__((ext_vector_type(2)));
            const int tpb = nrows / NRB, nblk = tpb / 4; LAS int* hist = (LAS int*)(lds + HIST_OFF);
            if (tid < 32) hist[tid] = 0;
            { const pg8::u32x4* src = (const pg8::u32x4*)((const _Float16*)(ws + WS_WRT) + (size_t)l * NE * D);
                for (int c = tid; c < NE * 128; c += NWAVES * 64) { const int e = c >> 7, ch = c & 127; *(LAS pg8::u32x4*)(lds + 65536 + e * 2048 + ((ch ^ (e & 15)) << 4)) = src[c]; } }
            __syncthreads();
            LAS unsigned char* hs = lds + wave * 8192;
            LAS float* ls = (LAS float*)(lds + LDSCTL_OFF + 8192) + wave * 128;
            const float* gain = p.norm2_g + l * D; const int r16 = lane & 15, kq = lane >> 4, arow = r16 & 3;
            REPS(7) { uint2 xw[4][4];
#define ROUTE_LOAD(b_) do { const int rb_ = bx * tpb + min((b_), nblk - 1) * 4; _Pragma("unroll") for (int rr = 0; rr < 4; ++rr) { const uint2* xr = (const uint2*)((const bf16_t*)(ws + WS_X) + (size_t)(rb_ + rr) * D); \
                    _Pragma("unroll") for (int i = 0; i < 4; ++i) xw[rr][i] = xr[lane + 64 * i]; } } while (0)
              ROUTE_LOAD(wave);
              for (int blk = wave; blk < nblk; blk += NWAVES) {
                const int row0 = bx * tpb + blk * 4;
#pragma unroll
                for (int rr = 0; rr < 4; ++rr) { const int row = row0 + rr; float ss = 0.f; float4 xv[4];
#pragma unroll
                    for (int i = 0; i < 4; ++i) { const uint2 w = xw[rr][i]; xv[i] = make_float4(bf2f(w.x & 0xffff), bf2f(w.x >> 16), bf2f(w.y & 0xffff), bf2f(w.y >> 16)); ss += xv[i].x * xv[i].x + xv[i].y * xv[i].y + xv[i].z * xv[i].z + xv[i].w * xv[i].w; }
                    const float r = rsqrtf(wave_sum(ss, lane) * (1.f / D) + EPS);
                    const float* m = (const float*)(ws + WS_MOD) + ((size_t)l * 9 + mod_row(row)) * MODW + 3 * D; int* ho = (int*)(ws + WS_H + (size_t)row * D);
#pragma unroll
                    for (int i = 0; i < 4; ++i) { const int c4 = lane + 64 * i; const float4 g = ((const float4*)gain)[c4], sh = ((const float4*)m)[c4], sc = ((const float4*)(m + D))[c4]; const float4 v = xv[i];
                        const float h0 = v.x * r * g.x * (1.f + sc.x) + sh.x, h1 = v.y * r * g.y * (1.f + sc.y) + sh.y, h2 = v.z * r * g.z * (1.f + sc.z) + sh.z, h3 = v.w * r * g.w * (1.f + sc.w) + sh.w;
                        { int w8 = __builtin_amdgcn_cvt_pk_fp8_f32(h0, h1, 0, false); w8 = __builtin_amdgcn_cvt_pk_fp8_f32(h2, h3, w8, true); ho[c4] = w8; }
                        const h2v f01 = {(_Float16)h0, (_Float16)h1}, f23 = {(_Float16)h2, (_Float16)h3};
                        *(LAS pg8::u32x2*)(hs + rr * 2048 + ((((c4 >> 1) ^ rr)) << 4) + (c4 & 1) * 8) = (pg8::u32x2){__builtin_bit_cast(unsigned, f01), __builtin_bit_cast(unsigned, f23)}; } }
                asm volatile("s_waitcnt lgkmcnt(0)" ::: "memory");
                ROUTE_LOAD(blk + NWAVES);
                float zr_; asm volatile("v_mov_b32 %0, 0" : "=v"(zr_)); pg8::f32x4 acc0 = {zr_, zr_, zr_, zr_}, acc1 = {zr_, zr_, zr_, zr_};
#pragma unroll 8
                for (int s = 0; s < 32; ++s) { const int ch = 4 * s + kq;
                    const h8 a = *(const LAS h8*)(hs + arow * 2048 + ((ch ^ arow) << 4));
                    const h8 b0 = *(const LAS h8*)(lds + 65536 + r16 * 2048 + ((ch ^ r16) << 4)), b1 = *(const LAS h8*)(lds + 65536 + (r16 + 16) * 2048 + ((ch ^ r16) << 4));
                    acc0 = __builtin_amdgcn_mfma_f32_16x16x32_f16(a, b0, acc0, 0, 0, 0); acc1 = __builtin_amdgcn_mfma_f32_16x16x32_f16(a, b1, acc1, 0, 0, 0); }
                if (kq == 0) {
#pragma unroll
                    for (int reg = 0; reg < 4; ++reg) { ls[reg * 32 + r16] = acc0[reg]; ls[reg * 32 + 16 + r16] = acc1[reg]; } }
                asm volatile("s_waitcnt lgkmcnt(0)" ::: "memory");
                if (lane < 4) { float lg[32];
#pragma unroll
                    for (int e = 0; e < 32; ++e) lg[e] = ls[lane * 32 + e] + p.router_b[l * NE + e];
                    const unsigned es = top4_store(p, row0 + lane, lg);
                    if (rep_ == 0) {
#pragma unroll
                        for (int k = 0; k < 4; ++k) __hip_atomic_fetch_add(hist + ((es >> (8 * k)) & 255u), 1, __ATOMIC_RELAXED, __HIP_MEMORY_SCOPE_WORKGROUP); } }
                asm volatile("s_waitcnt lgkmcnt(0)" ::: "memory");
              }
#undef ROUTE_LOAD
            }
            __syncthreads();
            if (tid < 32) ((int*)(ws + WS_BCNT))[(l * NRB + bx) * 32 + tid] = hist[tid];
        }
        SEAM(pb + PHL_ROUTE);
        if (IN(pb + PHL_SCAN) && (MK_PHMASK & 512)) {
            PHASE_IDS;
            const int tpb = nrows / NRB, nent = tpb * 4;
            LAS int* part = (LAS int*)(lds + SC_PART_OFF); LAS int* tot = (LAS int*)(lds + SC_TOT_OFF); LAS int* base = (LAS int*)(lds + SC_BASE_OFF); LAS int* seoff = (LAS int*)(lds + SC_EOFF_OFF);
            LAS int* wcnt = (LAS int*)(lds + SC_WCNT_OFF); LAS int* sslot = (LAS int*)(lds + SC_SLOT_OFF);
            const int* bc = (const int*)(ws + WS_BCNT) + l * NRB * 32;
            { const int e = tid & 31, ch = tid >> 5; int sa = 0, sb = 0;
                for (int i = 0; i < 16; ++i) { const int b = ch * 16 + i; const int c = bc[b * 32 + e]; sa += c; sb += (b < bx) ? c : 0; }
                part[ch * 32 + e] = sa; part[512 + ch * 32 + e] = sb; }
            __syncthreads();
            if (tid < 32) { int ta = 0, tb = 0; for (int ch = 0; ch < 16; ++ch) { ta += part[ch * 32 + tid]; tb += part[512 + ch * 32 + tid]; } tot[tid] = ta; base[tid] = tb; }
            __syncthreads();
            if (tid == 0) { int o = 0; for (int i = 0; i < 32; ++i) { seoff[i] = o; o += (tot[i] + 255) & ~255; } seoff[32] = o; }
            __syncthreads();
            if (bx == 0 && tid <= 32) ((int*)(ws + WS_EOFF))[l * 64 + tid] = seoff[tid];
            const int* te = (const int*)(ws + WS_TOKE) + (size_t)bx * nent; int* ts = (int*)(ws + WS_TOKS) + (size_t)bx * nent;
            int mye[2], myrank[2];
#pragma unroll
            for (int rep = 0; rep < 2; ++rep) { const int chunk = wave + 8 * rep, i = chunk * 64 + lane; int e = -1, rank = 0;
                if (chunk * 64 < nent) { if (i < nent) e = te[i];
                    for (int ee = 0; ee < 32; ++ee) { const unsigned long long mk = __ballot(e == ee); if (e == ee) rank = __popcll(mk & ((1ull << lane) - 1ull)); if (lane == 0) wcnt[chunk * 32 + ee] = __popcll(mk); } }
                mye[rep] = e; myrank[rep] = rank; }
            __syncthreads();
#pragma unroll
            for (int rep = 0; rep < 2; ++rep) if (mye[rep] >= 0) { const int chunk = wave + 8 * rep, i = chunk * 64 + lane, e = mye[rep]; int cb = 0;
                for (int c = 0; c < chunk; ++c) cb += wcnt[c * 32 + e];
                const int slot = seoff[e] + base[e] + cb + myrank[rep]; ts[i] = slot; ((int*)(ws + WS_STOK))[slot] = bx * tpb + (i >> 2); }
            __syncthreads();
            if (bx < NE) { const int s0 = seoff[bx] + tot[bx], s1 = seoff[bx + 1]; for (int s = s0 + tid; s < s1; s += NWAVES * 64) ((int*)(ws + WS_STOK))[s] = 0; }
        }
        SEAM(pb + PHL_SCAN);
        if ((IN(pb + PHL_GEMM1) || IN(pb + PHL_GEMM2)) && (MK_PHMASK & 48)) {
            PHASE_WS;
            const int tid0 = opaque_tid(wv_);
            if (tid0 < 64) ((LAS int*)(lds + EOFF_OFF))[tid0] = tid0 <= NE ? (int)__hip_atomic_load((unsigned*)(ws + WS_EOFF) + l * 64 + tid0, __ATOMIC_RELAXED, __HIP_MEMORY_SCOPE_AGENT) : 0;
            __syncthreads();
        }
        if (IN(pb + PHL_GEMM1) && (MK_PHMASK & 16)) {
            PHASE_WS;
            pg8::SchedMoe S{(const char*)(ws + WS_H), (const char*)(ws + WS_WGU) + (size_t)l * NE * 2048 * D, (const LAS int*)(lds + EOFF_OFF), 8, G, bx, (size_t)2048 * D, D, true};
            pg8::EpiGUF E{ws + WS_A, (const float*)(ws + WS_BGU) + (size_t)l * NE * 2048, false};
            if ((MK_REPEAT >> 17) & 3) { pg8::EpiGUF E0{ws + WS_A, (const float*)(ws + WS_BGU) + (size_t)l * NE * 2048, ((MK_REPEAT >> 17) & 3) == 2};
                pg8::gemm_phase<pg8::EpiGUF, pg8::SchedMoe, true, true, true, true>(lds, pg8::Gemm{D, D, D, 0x7f7f7f7f, 0x79797979}, S, E0, wv_, (const int*)(ws + WS_STOK), (LAS int*)(lds + GTAB_OFF), (LAS float*)(lds + LBIAS_OFF)); }
            REPS(5) pg8::gemm_phase<pg8::EpiGUF, pg8::SchedMoe, true, true, true, true>(lds, pg8::Gemm{D, D, D, 0x7f7f7f7f, 0x79797979}, S, E, wv_, (const int*)(ws + WS_STOK), (LAS int*)(lds + GTAB_OFF), (LAS float*)(lds + LBIAS_OFF));
        }
        SEAM(pb + PHL_GEMM1);
        if (IN(pb + PHL_GEMM2) && (MK_PHMASK & 32)) {
            PHASE_WS;
            pg8::SchedMoe S{(const char*)(ws + WS_A), (const char*)(ws + WS_WDN) + (size_t)l * NE * D * D, (const LAS int*)(lds + EOFF_OFF), 4, G, bx, (size_t)D * D, D, false};
            pg8::EpiStoreF8 E{ws + WS_YB, D, p.b_down + (size_t)l * NE * D, D, YB_SCALE};
            REPS(6) pg8::gemm_phase<pg8::EpiStoreF8, pg8::SchedMoe, true, true, true>(lds, pg8::Gemm{D, D, D, 0x7d7d7d7d, 0x79797979}, S, E, wv_, nullptr, nullptr, (LAS float*)(lds + LBIAS_OFF));
        }
        SEAM(pb + PHL_GEMM2);
        if (IN(pb + PHL_COMB) && (MK_PHMASK & 1024)) {
            PHASE_IDS;
            REPS(11) for (int row = gw; row < nrows; row += 3 * NGW) combine_rows<3>(p, l, lastl ? 1 : 0, row, NGW, nrows, lane, rep_ ? 0.f : 1.f);
        }
        SEAM(pb + PHL_COMB);
    }
#undef IN
#undef SEAM
#undef PHASE_IDS
}

#ifndef MK_N_LAUNCHES
#define MK_N_LAUNCHES 1
#endif
static int g_grid = 0;
static void launch_mk(const Ptrs& p, int lo, int hi, hipStream_t stream) {
    MkArgs a{}; a.p = p; a.ph_lo = lo; a.ph_hi = hi;
    hipLaunchKernelGGL(mk_fwd, dim3(g_grid), dim3(NWAVES * 64), LDS_BYTES, stream, a);
    const hipError_t le = hipPeekAtLastError();
    if (le != hipSuccess) fprintf(stderr, "kernel_launch: mk_fwd[%d,%d) launch failed: %s\n", lo, hi, hipGetErrorName(le));
}
extern "C" void kernel_launch(void* const* d_in, const int* in_sizes, int n_in, void* d_out, int out_size, void* d_ws, size_t ws_size, hipStream_t stream) {
    if (n_in != 24 || ws_size < WS_END) { fprintf(stderr, "kernel_launch: unexpected n_in %d / ws %zu (need %zu)\n", n_in, ws_size, (size_t)WS_END); return; }
    if (g_grid == 0) {
        int dev = 0, cus = 0, per_cu = 0;
        if (hipGetDevice(&dev) != hipSuccess || hipDeviceGetAttribute(&cus, hipDeviceAttributeMultiprocessorCount, dev) != hipSuccess) { fprintf(stderr, "kernel_launch: device query failed\n"); g_grid = -1; return; }
        if (hipFuncSetAttribute((const void*)mk_fwd, hipFuncAttributeMaxDynamicSharedMemorySize, LDS_BYTES) != hipSuccess) { fprintf(stderr, "kernel_launch: hipFuncSetAttribute failed\n"); g_grid = -1; return; }
        if (hipOccupancyMaxActiveBlocksPerMultiprocessor(&per_cu, (const void*)mk_fwd, NWAVES * 64, LDS_BYTES) != hipSuccess || per_cu < 1) fprintf(stderr, "kernel_launch: occupancy query reports %d\n", per_cu);
        (void)hipGetLastError();
        g_grid = cus;
        if (g_grid != NRB) { fprintf(stderr, "kernel_launch: %d CUs, this kernel is written for %d\n", cus, NRB); g_grid = NRB; }
    }
    if (g_grid < 0) return;
    Ptrs p{};
    const float** pp = (const float**)&p; for (int i = 0; i < 24; ++i) pp[i] = (const float*)d_in[i];
    p.out = (float*)d_out; p.ws = (unsigned char*)d_ws;
    (void)hipMemsetAsync(p.ws + WS_CTL, 0, 65536, stream);
    if (MK_N_LAUNCHES == 1) launch_mk(p, 0, PH_END, stream);
    else for (int ph = 0; ph < PH_END; ++ph) launch_mk(p, ph, ph + 1, stream);
}
```

```cpp
#include <hip/hip_runtime.h>
#include <stdint.h>
#include <stdio.h>

typedef unsigned short bf16_t;
#define LAS __attribute__((address_space(3)))
#define GAS __attribute__((address_space(1)))
__device__ __forceinline__ float bf2f(unsigned b) { return __uint_as_float(b << 16); }
__device__ __forceinline__ unsigned f2bf(float f) { unsigned u = __float_as_uint(f); return (u + 0x7fffu + ((u >> 16) & 1u)) >> 16; }
__device__ __forceinline__ unsigned pk2(float lo, float hi) { return f2bf(lo) | (f2bf(hi) << 16); }

constexpr int D = 1024, NB = 8, SEQ = 4096, CTXL = 256, NLAT = NB * SEQ, NCTX = NB * CTXL, NTOK = NLAT + NCTX;
constexpr int INC = 6912, MODW = 6144;
constexpr int O_CB = 0, O_CC = 512, O_CX = 1024, O_NAQ = 1536, O_NAK = 2048, O_NAV = 2560, O_GQ = 3072, O_GK = 3584, O_GV = 3712, O_BGC = 3840, O_BGN = 4864, O_BGG = 5888;
constexpr int NE = 32, TOPK = 4, KVLEN = SEQ + CTXL;
constexpr int MPAD = 147456;
constexpr int NRB = 256;
constexpr float EPS = 1e-6f;
constexpr float YB_SCALE = 8.f;

constexpr size_t al256(size_t x) { return (x + 255) & ~(size_t)255; }
constexpr size_t WS_CTL = 0;
constexpr int CW_BAR = 4096;
constexpr size_t WS_MOD = 1 << 20;
constexpr size_t WS_TOKE = WS_MOD + al256(2 * 9 * MODW * 4);
constexpr size_t WS_TOKG = WS_TOKE + al256((size_t)NTOK * 16);
constexpr size_t WS_TOKS = WS_TOKG + al256((size_t)NTOK * 16);
constexpr size_t WS_BCNT = WS_TOKS + al256((size_t)NTOK * 16);
constexpr size_t WS_EOFF = WS_BCNT + al256(2 * NRB * 32 * 4);
constexpr size_t WS_STOK = al256(WS_EOFF + 512);
constexpr size_t WS_X = al256(WS_STOK + (size_t)MPAD * 4);
constexpr size_t WS_H = WS_X + (size_t)NTOK * D * 4;
constexpr size_t WS_KG = WS_H + (size_t)NTOK * D * 2;
constexpr size_t WS_VG = WS_KG + (size_t)NB * KVLEN * 128 * 2;
constexpr size_t WS_R1 = WS_VG + (size_t)NB * KVLEN * 128 * 2;
constexpr size_t WS_P = WS_R1;
constexpr size_t WS_Y = WS_P + (size_t)NTOK * INC * 2;
constexpr size_t WS_M = WS_Y + (size_t)NTOK * 1536 * 2;
constexpr size_t WS_XG = WS_R1;
constexpr size_t WS_A = WS_XG + (size_t)MPAD * D;
constexpr size_t WS_YB = WS_A + (size_t)MPAD * D;
constexpr size_t WS_R1_END = (WS_M + (size_t)NTOK * D * 2) > (WS_YB + (size_t)MPAD * D * 2) ? (WS_M + (size_t)NTOK * D * 2) : (WS_YB + (size_t)MPAD * D * 2);
constexpr size_t WS_WIN = al256(WS_R1_END);
constexpr size_t WS_WMG = WS_WIN + (size_t)2 * INC * D * 2;
constexpr size_t WS_WOUT = WS_WMG + (size_t)2 * 3 * D * 512 * 2;
constexpr size_t WS_WGU = WS_WOUT + (size_t)2 * D * D * 2;
constexpr size_t WS_WDN = WS_WGU + (size_t)2 * NE * 2048 * D;
constexpr size_t WS_BGU = WS_WDN + (size_t)2 * NE * D * D;
constexpr size_t WS_WRT = WS_BGU + (size_t)2 * NE * 2048 * 4;
constexpr size_t WS_H8 = al256(WS_WRT + (size_t)2 * NE * D * 2);
constexpr size_t WS_WIN8 = WS_H8 + (size_t)NTOK * D;
constexpr size_t WS_END = WS_WIN8 + (size_t)2 * INC * D;
#ifndef INPROJ_SPLIT
#define INPROJ_SPLIT 6
#endif
constexpr int IP_S = INPROJ_SPLIT;

struct Ptrs {
    const float *x, *c, *ctx, *c_ctx, *ada_w, *ada_b, *norm1_g, *norm2_g, *w_in, *conv_w, *na_rpb, *q_norm_g, *k_norm_g;
    const float *w_br_conv, *w_br_na, *w_br_gqa, *w_out, *router_w, *router_b, *w_gu, *b_gu, *w_down, *b_down, *final_g;
    float* out; unsigned char* ws;
};

__device__ __forceinline__ int mod_row(int row) { return row < NLAT ? row / SEQ : 8; }
__device__ __forceinline__ float lane_xor(float v, int lane, int o) { return __int_as_float(__builtin_amdgcn_ds_bpermute((lane ^ o) << 2, __float_as_int(v))); }
__device__ __forceinline__ float wave_sum(float v, int lane) {
#pragma unroll
    for (int o = 1; o < 64; o <<= 1) v += lane_xor(v, lane, o);
    return v;
}
__device__ __forceinline__ int opaque_tid(int wv) { int l; asm volatile("v_mbcnt_lo_u32_b32 %0, -1, 0\n\tv_mbcnt_hi_u32_b32 %0, -1, %0" : "=v"(l)); return wv * 64 + l; }

__device__ __forceinline__ void sincos_small(float a, float& s, float& c) {
    const float k = rintf(a * 0.6366197723675814f); const float r = ((a - k * 1.5703125f) - k * 4.837512969970703125e-4f) - k * 7.54978995489188216e-8f; const float r2 = r * r;
    const float sr = r + r * r2 * (-1.6666654611e-1f + r2 * (8.3321608736e-3f + r2 * (-1.9515295891e-4f)));
    const float cr = 1.f - 0.5f * r2 + r2 * r2 * (4.166664568298827e-2f + r2 * (-1.388731625493765e-3f + r2 * 2.443315711809948e-5f));
    const int q = ((int)k) & 3; s = (q == 0) ? sr : (q == 1) ? cr : (q == 2) ? -sr : -cr; c = (q == 0) ? cr : (q == 1) ? -sr : (q == 2) ? -cr : sr;
}
__device__ __forceinline__ void head_norm_rope(float (&v)[64], const float* g, bool rope, int t) {
    float ss = 0.f;
#pragma unroll
    for (int d = 0; d < 64; ++d) ss += v[d] * v[d];
    const float r = rsqrtf(ss * (1.f / 64.f) + EPS);
#pragma unroll
    for (int d = 0; d < 64; ++d) v[d] = v[d] * r * g[d];
    if (rope) {
        const float pr = (float)(t / 64), pc = (float)(t % 64);
#pragma unroll
        for (int i = 0; i < 16; ++i) { const float inv = exp2f(-(float)i * 0.8304820237218406f);
            { float cs, sn; sincos_small(pr * inv, sn, cs); const float x1 = v[i], x2 = v[16 + i]; v[i] = x1 * cs - x2 * sn; v[16 + i] = x1 * sn + x2 * cs; }
            { float cs, sn; sincos_small(pc * inv, sn, cs); const float x1 = v[32 + i], x2 = v[48 + i]; v[32 + i] = x1 * cs - x2 * sn; v[48 + i] = x1 * sn + x2 * cs; } }
    }
}
__device__ __forceinline__ void load64(float (&v)[64], const bf16_t* src) {
#pragma unroll
    for (int i = 0; i < 8; ++i) { const uint4 w = ((const uint4*)src)[i];
        v[8 * i + 0] = bf2f(w.x & 0xffff); v[8 * i + 1] = bf2f(w.x >> 16); v[8 * i + 2] = bf2f(w.y & 0xffff); v[8 * i + 3] = bf2f(w.y >> 16);
        v[8 * i + 4] = bf2f(w.z & 0xffff); v[8 * i + 5] = bf2f(w.z >> 16); v[8 * i + 6] = bf2f(w.w & 0xffff); v[8 * i + 7] = bf2f(w.w >> 16); }
}
__device__ __forceinline__ void store64(bf16_t* dst, const float (&v)[64]) {
#pragma unroll
    for (int i = 0; i < 8; ++i) { uint4 w; w.x = pk2(v[8 * i], v[8 * i + 1]); w.y = pk2(v[8 * i + 2], v[8 * i + 3]); w.z = pk2(v[8 * i + 4], v[8 * i + 5]); w.w = pk2(v[8 * i + 6], v[8 * i + 7]); ((uint4*)dst)[i] = w; }
}

__device__ __forceinline__ void norm_mod_store(const float4 (&v)[4], float r, const float* gain, const float* m, unsigned char* ws_, int row, int lane) {
    uint2* hb = (uint2*)((bf16_t*)(ws_ + WS_H) + (size_t)row * D); int* ho = (int*)(ws_ + WS_H8 + (size_t)row * D);
#pragma unroll
    for (int i = 0; i < 4; ++i) { const int c4 = lane + 64 * i; const float4 g = ((const float4*)gain)[c4], sh = ((const float4*)m)[c4], sc = ((const float4*)(m + D))[c4];
        const float h0 = v[i].x * r * g.x * (1.f + sc.x) + sh.x, h1 = v[i].y * r * g.y * (1.f + sc.y) + sh.y, h2 = v[i].z * r * g.z * (1.f + sc.z) + sh.z, h3 = v[i].w * r * g.w * (1.f + sc.w) + sh.w;
        if (IP_S > 0) { uint2 o; o.x = pk2(h0, h1); o.y = pk2(h2, h3); hb[c4] = o; }
        if (IP_S < 27) { int w8 = __builtin_amdgcn_cvt_pk_fp8_f32(h0, h1, 0, false); w8 = __builtin_amdgcn_cvt_pk_fp8_f32(h2, h3, w8, true); ho[c4] = w8; } }
}
__device__ __forceinline__ void mod_item(const Ptrs& p, int item, int lane, const LAS float* sil) {
    const int l = item / (MODW / 32), cb = item % (MODW / 32), kq = lane >> 3, cq = lane & 7;
    const float* w = p.ada_w + (size_t)l * D * MODW + cb * 32 + cq * 4;
    float4 acc[9];
#pragma unroll
    for (int r = 0; r < 9; ++r) acc[r] = make_float4(0.f, 0.f, 0.f, 0.f);
#pragma unroll 16
    for (int k = kq; k < D; k += 8) { const float4 wv = *(const float4*)(w + (size_t)k * MODW);
#pragma unroll
        for (int r = 0; r < 9; ++r) { const float s = sil[r * D + k]; acc[r].x += s * wv.x; acc[r].y += s * wv.y; acc[r].z += s * wv.z; acc[r].w += s * wv.w; } }
#pragma unroll
    for (int r = 0; r < 9; ++r)
#pragma unroll
        for (int o = 8; o < 64; o <<= 1) { acc[r].x += lane_xor(acc[r].x, lane, o); acc[r].y += lane_xor(acc[r].y, lane, o); acc[r].z += lane_xor(acc[r].z, lane, o); acc[r].w += lane_xor(acc[r].w, lane, o); }
    if (kq == 0) { const float4 b = *(const float4*)(p.ada_b + l * MODW + cb * 32 + cq * 4);
#pragma unroll
        for (int r = 0; r < 9; ++r) *(float4*)((float*)(p.ws + WS_MOD) + ((size_t)l * 9 + r) * MODW + cb * 32 + cq * 4) = make_float4(acc[r].x + b.x, acc[r].y + b.y, acc[r].z + b.z, acc[r].w + b.w); }
}
__device__ __forceinline__ void conv_item4(const Ptrs& p, int layer, int item) {
    const int row0 = (item >> 6) * 4, c8 = (item & 63) * 8;
    const bf16_t* P = (const bf16_t*)(p.ws + WS_P); const float* w = p.conv_w + layer * 3 * 512 + c8;
    int t0, T; if (row0 < NLAT) { t0 = row0 % SEQ; T = SEQ; } else { t0 = (row0 - NLAT) % CTXL; T = CTXL; }
    const bf16_t* pr = P + (size_t)row0 * INC + c8;
    const uint4 z4 = make_uint4(0, 0, 0, 0);
    uint4 cc[6], cx[6], cb[4];
#pragma unroll
    for (int j = 0; j < 6; ++j) { const bool ok = (j > 0 || t0 > 0) && (j < 5 || t0 + 4 < T); cc[j] = ok ? *(const uint4*)(pr + (j - 1) * INC + O_CC) : z4; cx[j] = ok ? *(const uint4*)(pr + (j - 1) * INC + O_CX) : z4; }
#pragma unroll
    for (int j = 0; j < 4; ++j) cb[j] = *(const uint4*)(pr + j * INC + O_CB);
    float u[6][8];
#pragma unroll
    for (int j = 0; j < 6; ++j) { const unsigned a[4] = {cc[j].x, cc[j].y, cc[j].z, cc[j].w}, x[4] = {cx[j].x, cx[j].y, cx[j].z, cx[j].w};
#pragma unroll
        for (int q = 0; q < 4; ++q) { u[j][2 * q] = bf2f(a[q] & 0xffff) * bf2f(x[q] & 0xffff); u[j][2 * q + 1] = bf2f(a[q] >> 16) * bf2f(x[q] >> 16); } }
    float w0[8], w1[8], w2[8];
#pragma unroll
    for (int c = 0; c < 8; ++c) { w0[c] = w[c]; w1[c] = w[512 + c]; w2[c] = w[1024 + c]; }
#pragma unroll
    for (int j = 0; j < 4; ++j) { const unsigned bw[4] = {cb[j].x, cb[j].y, cb[j].z, cb[j].w}; unsigned o[4];
#pragma unroll
        for (int q = 0; q < 4; ++q) { const float r0 = bf2f(bw[q] & 0xffff) * (w0[2 * q] * u[j][2 * q] + w1[2 * q] * u[j + 1][2 * q] + w2[2 * q] * u[j + 2][2 * q]);
            const float r1 = bf2f(bw[q] >> 16) * (w0[2 * q + 1] * u[j][2 * q + 1] + w1[2 * q + 1] * u[j + 1][2 * q + 1] + w2[2 * q + 1] * u[j + 2][2 * q + 1]); o[q] = pk2(r0, r1); }
        *(uint4*)((bf16_t*)(p.ws + WS_Y) + (size_t)(row0 + j) * 1536 + c8) = make_uint4(o[0], o[1], o[2], o[3]); }
}
__device__ __forceinline__ void kprep_item(const Ptrs& p, int layer, int i) {
    const int row = i >> 1, kvh = i & 1;
    const bf16_t* pr = (const bf16_t*)(p.ws + WS_P) + (size_t)row * INC;
    int b, pos, t; if (row < NLAT) { b = row / SEQ; t = row % SEQ; pos = t; } else { b = (row - NLAT) / CTXL; t = 0; pos = SEQ + (row - NLAT) % CTXL; }
    float v[64]; load64(v, pr + O_GK + kvh * 64); head_norm_rope(v, p.k_norm_g + layer * 64, row < NLAT, t);
    const size_t o = (((size_t)b * KVLEN + pos) * 2 + kvh) * 64;
    store64((bf16_t*)(p.ws + WS_KG) + o, v);
    const uint4* s = (const uint4*)(pr + O_GV + kvh * 64); uint4* d = (uint4*)((bf16_t*)(p.ws + WS_VG) + o);
#pragma unroll
    for (int j = 0; j < 8; ++j) d[j] = s[j];
}
constexpr float ATT_C2 = 0.125f * 1.4426950408889634f;
__device__ __forceinline__ void qprep_item(const Ptrs& p, int layer, int i) {
    const int row = i >> 3, h = i & 7; bf16_t* pr = (bf16_t*)(p.ws + WS_P) + (size_t)row * INC;
    float v[64]; load64(v, pr + O_GQ + h * 64); head_norm_rope(v, p.q_norm_g + layer * 64, row < NLAT, row < NLAT ? row % SEQ : 0);
#pragma unroll
    for (int d = 0; d < 64; ++d) v[d] *= ATT_C2;
    store64(pr + O_GQ + h * 64, v);
}
#define ATT_STEP(kp, vp, bias) do { float kv_[64]; load64(kv_, kp); float s_ = 0.f; _Pragma("unroll") for (int d = 0; d < 64; ++d) s_ += q[d] * kv_[d]; s_ = s_ * 0.125f + (bias); \
    const float mn_ = fmaxf(mx, s_), cr_ = __expf(mx - mn_), pp_ = __expf(s_ - mn_); l = l * cr_ + pp_; mx = mn_; load64(kv_, vp); _Pragma("unroll") for (int d = 0; d < 64; ++d) o[d] = o[d] * cr_ + pp_ * kv_[d]; } while (0)
__device__ __forceinline__ void gqa_ref_item(const Ptrs& p, int layer, int i) {
    const int t = i & (SEQ - 1), h = (i >> 12) & 7, b = i >> 15, row = b * SEQ + t;
    float q[64]; load64(q, (const bf16_t*)(p.ws + WS_P) + (size_t)row * INC + O_GQ + h * 64); head_norm_rope(q, p.q_norm_g + layer * 64, true, t);
    float o[64]; float mx = -1e30f, l = 0.f;
#pragma unroll
    for (int d = 0; d < 64; ++d) o[d] = 0.f;
    const bf16_t* kb = (const bf16_t*)(p.ws + WS_KG) + ((size_t)b * KVLEN * 2 + (h >> 2)) * 64; const bf16_t* vb = (const bf16_t*)(p.ws + WS_VG) + ((size_t)b * KVLEN * 2 + (h >> 2)) * 64;
    for (int j = 0; j < KVLEN; ++j) ATT_STEP(kb + (size_t)j * 128, vb + (size_t)j * 128, 0.f);
    const float il = 1.f / l;
#pragma unroll
    for (int d = 0; d < 64; ++d) o[d] *= il;
    store64((bf16_t*)(p.ws + WS_Y) + (size_t)row * 1536 + 1024 + h * 64, o);
}
__device__ __forceinline__ void na_ref_item(const Ptrs& p, int layer, int i) {
    const int t = i & (SEQ - 1), h = (i >> 12) & 7, b = i >> 15, row = b * SEQ + t;
    const bf16_t* P = (const bf16_t*)(p.ws + WS_P);
    float q[64]; load64(q, P + (size_t)row * INC + O_NAQ + h * 64);
    float o[64]; float mx = -1e30f, l = 0.f;
#pragma unroll
    for (int d = 0; d < 64; ++d) o[d] = 0.f;
    const int r = t >> 6, c = t & 63; const int rs = min(max(r - 4, 0), 56), cs = min(max(c - 8, 0), 48);
    const float* rpb = p.na_rpb + ((size_t)layer * 8 + h) * 15 * 31;
    for (int ii = 0; ii < 8; ++ii) for (int j = 0; j < 16; ++j) { const int kr = rs + ii, kc = cs + j; const bf16_t* kp = P + (size_t)(b * SEQ + kr * 64 + kc) * INC;
        ATT_STEP(kp + O_NAK + h * 64, kp + O_NAV + h * 64, rpb[(kr - r + 7) * 31 + (kc - c + 15)]); }
    for (int j = 0; j < CTXL; ++j) { const bf16_t* kp = P + (size_t)(NLAT + b * CTXL + j) * INC; ATT_STEP(kp + O_NAK + h * 64, kp + O_NAV + h * 64, 0.f); }
    const float il = 1.f / l;
#pragma unroll
    for (int d = 0; d < 64; ++d) o[d] *= il;
    store64((bf16_t*)(p.ws + WS_Y) + (size_t)row * 1536 + 512 + h * 64, o);
}
__device__ __forceinline__ void ctx_ref_item(const Ptrs& p, int layer, int i, int which) {
    const int h = i & 7, cr = i >> 3, row = NLAT + cr, b = cr / CTXL; const bf16_t* P = (const bf16_t*)(p.ws + WS_P);
    float q[64]; float o[64]; float mx = -1e30f, l = 0.f;
#pragma unroll
    for (int d = 0; d < 64; ++d) o[d] = 0.f;
    if (which == 0) { load64(q, P + (size_t)row * INC + O_NAQ + h * 64);
        for (int j = 0; j < CTXL; ++j) { const bf16_t* kp = P + (size_t)(NLAT + b * CTXL + j) * INC; ATT_STEP(kp + O_NAK + h * 64, kp + O_NAV + h * 64, 0.f); } }
    else { load64(q, P + (size_t)row * INC + O_GQ + h * 64); head_norm_rope(q, p.q_norm_g + layer * 64, false, 0);
        const bf16_t* kb = (const bf16_t*)(p.ws + WS_KG) + (((size_t)b * KVLEN + SEQ) * 2 + (h >> 2)) * 64; const bf16_t* vb = (const bf16_t*)(p.ws + WS_VG) + (((size_t)b * KVLEN + SEQ) * 2 + (h >> 2)) * 64;
        for (int j = 0; j < CTXL; ++j) ATT_STEP(kb + (size_t)j * 128, vb + (size_t)j * 128, 0.f); }
    const float il = 1.f / l;
#pragma unroll
    for (int d = 0; d < 64; ++d) o[d] *= il;
    store64((bf16_t*)(p.ws + WS_Y) + (size_t)row * 1536 + (which ? 1024 : 512) + h * 64, o);
}
__device__ __forceinline__ unsigned top4_store(const Ptrs& p, int row, const float (&lg)[32]) {
    int ie[4]; float ve[4];
#pragma unroll
    for (int k = 0; k < 4; ++k) { float bv = -3.0e38f; int bi = 0;
#pragma unroll
        for (int e = 0; e < 32; ++e) { const bool taken = (k > 0 && ie[0] == e) || (k > 1 && ie[1] == e) || (k > 2 && ie[2] == e); if (!taken && lg[e] > bv) { bv = lg[e]; bi = e; } }
        ie[k] = bi; ve[k] = bv; }
    const float e0 = 1.f, e1 = expf(ve[1] - ve[0]), e2 = expf(ve[2] - ve[0]), e3 = expf(ve[3] - ve[0]), is = 1.f / (e0 + e1 + e2 + e3);
    ((int4*)(p.ws + WS_TOKE))[row] = make_int4(ie[0], ie[1], ie[2], ie[3]); ((float4*)(p.ws + WS_TOKG))[row] = make_float4(e0 * is, e1 * is, e2 * is, e3 * is);
    return (unsigned)ie[0] | ((unsigned)ie[1] << 8) | ((unsigned)ie[2] << 16) | ((unsigned)ie[3] << 24);
}
template <int NR>
__device__ __forceinline__ void combine_rows(const Ptrs& p, int layer, int mode, int row0, int stride, int nrows, int lane, float gmul = 1.f) {
    typedef float v2f_ __attribute__((ext_vector_type(2)));
    int4 sl[NR]; float4 gg[NR]; unsigned yv[NR][4][4]; uint2 xv[NR][4];
#pragma unroll
    for (int q = 0; q < NR; ++q) { const int row = min(row0 + q * stride, nrows - 1); sl[q] = ((const int4*)(p.ws + WS_TOKS))[row]; gg[q] = ((const float4*)(p.ws + WS_TOKG))[row]; }
#pragma unroll
    for (int q = 0; q < NR; ++q) { const int row = min(row0 + q * stride, nrows - 1); const int sls[4] = {sl[q].x, sl[q].y, sl[q].z, sl[q].w}; const uint2* xr = (const uint2*)((const bf16_t*)(p.ws + WS_X) + (size_t)row * D);
#pragma unroll
        for (int i = 0; i < 4; ++i) { xv[q][i] = xr[lane + 64 * i];
#pragma unroll
            for (int k = 0; k < 4; ++k) yv[q][i][k] = ((const unsigned*)(p.ws + WS_YB + (size_t)sls[k] * D))[lane + 64 * i]; } }
#pragma unroll
    for (int q = 0; q < NR; ++q) { const int row = row0 + q * stride; if (row >= nrows) continue;
        const float gs[4] = {gg[q].x * (1.f / YB_SCALE), gg[q].y * (1.f / YB_SCALE), gg[q].z * (1.f / YB_SCALE), gg[q].w * (1.f / YB_SCALE)};
        uint2* xr = (uint2*)((bf16_t*)(p.ws + WS_X) + (size_t)row * D);
        const float* ml = (const float*)(p.ws + WS_MOD) + ((size_t)layer * 9 + mod_row(row)) * MODW;
        float4 v[4]; float ss = 0.f;
#pragma unroll
        for (int i = 0; i < 4; ++i) { const int c4 = lane + 64 * i; float4 a = make_float4(0, 0, 0, 0);
#pragma unroll
            for (int k = 0; k < 4; ++k) { const int w = (int)yv[q][i][k]; const v2f_ y01 = __builtin_amdgcn_cvt_pk_f32_fp8(w, false), y23 = __builtin_amdgcn_cvt_pk_f32_fp8(w, true);
                a.x += gs[k] * y01[0]; a.y += gs[k] * y01[1]; a.z += gs[k] * y23[0]; a.w += gs[k] * y23[1]; }
            const float4 g2 = ((const float4*)(ml + 5 * D))[c4]; const uint2 xw_ = xv[q][i]; float4 x = make_float4(bf2f(xw_.x & 0xffff), bf2f(xw_.x >> 16), bf2f(xw_.y & 0xffff), bf2f(xw_.y >> 16));
            x.x += gmul * g2.x * a.x; x.y += gmul * g2.y * a.y; x.z += gmul * g2.z * a.z; x.w += gmul * g2.w * a.w; v[i] = x; ss += x.x * x.x + x.y * x.y + x.z * x.z + x.w * x.w; }
        const float r = rsqrtf(wave_sum(ss, lane) * (1.f / D) + EPS);
        if (mode == 0) {
#pragma unroll
            for (int i = 0; i < 4; ++i) xr[lane + 64 * i] = make_uint2(pk2(v[i].x, v[i].y), pk2(v[i].z, v[i].w));
            norm_mod_store(v, r, p.norm1_g + (layer + 1) * D, (const float*)(p.ws + WS_MOD) + ((size_t)(layer + 1) * 9 + mod_row(row)) * MODW, p.ws, row, lane);
        } else {
            float4* orow = (float4*)(p.out + (size_t)row * D);
#pragma unroll
            for (int i = 0; i < 4; ++i) { const int c4 = lane + 64 * i; const float4 g = ((const float4*)p.final_g)[c4]; orow[c4] = make_float4(v[i].x * r * g.x, v[i].y * r * g.y, v[i].z * r * g.z, v[i].w * r * g.w); }
        }
    }
}

namespace pg8 {
typedef short bf16x8 __attribute__((ext_vector_type(8)));
typedef float f32x4 __attribute__((ext_vector_type(4)));
typedef unsigned u32x4 __attribute__((ext_vector_type(4)));
typedef unsigned u32x2 __attribute__((ext_vector_type(2)));
typedef int v4i __attribute__((ext_vector_type(4)));
typedef int v8i __attribute__((ext_vector_type(8)));
#ifndef PG8_WGM
#define PG8_WGM 8
#endif
constexpr int BM = 256, BK = 64, HALF = 128, HTB = HALF * BK * 2, STAGE_BYTES = 8 * HTB, NXCD = 8, WGM = PG8_WGM;
__host__ __device__ __forceinline__ int lds_byte(int r, int c) { const int st = (r >> 4) * 2 + (c >> 5), rr = r & 15, cc = c & 31, ob = rr * 64 + cc * 2; return st * 1024 + (ob ^ (((ob >> 9) & 1) << 5)); }
__host__ __device__ __forceinline__ void stage_rc(int b, int& R, int& C) { const int st = b / 1024, sb = b % 1024, swz = sb ^ (((sb >> 9) & 1) << 5); R = (st >> 1) * 16 + swz / 64; C = (st & 1) * 32 + (swz % 64) / 2; }
__host__ __device__ __forceinline__ int perm32(int rho) { const int n = rho >> 4, i = rho & 15; return 8 * (i >> 2) + 4 * n + (i & 3); }
struct Unit { int pm, pn, z, hf; };
struct Gemm { int Kb, lda, ldb; int scaleA, scaleB; };
__device__ __forceinline__ bool tile_order(int L, int nM, int nN, int& pm, int& pn) {
    const int nwg = nM * nN; if (L >= nwg) return false;
    int wgid = L; { const int q = nwg / NXCD, r = nwg % NXCD, xcd = wgid % NXCD, off = wgid / NXCD; wgid = (xcd < r ? xcd * (q + 1) : r * (q + 1) + (xcd - r) * q) + off; }
    const int nig = WGM * nN, gid = wgid / nig, fm = gid * WGM, gsz = (nM - fm) < WGM ? (nM - fm) : WGM;
    pm = fm + ((wgid % nig) % gsz); pn = (wgid % nig) / gsz; return true;
}
__device__ __forceinline__ unsigned cvt_pk_bf16(float lo, float hi) { unsigned r; asm volatile("v_cvt_pk_bf16_f32 %0, %1, %2" : "=v"(r) : "v"(lo), "v"(hi)); return r; }
__device__ __forceinline__ float fast_sigmoid(float v) { return __builtin_amdgcn_rcpf(1.f + __builtin_amdgcn_exp2f(-1.4426950408889634f * v)); }

template <class Epi, class Sched, bool ALIGN_EPI, bool SP2, bool FP8 = false, bool GATHER = false, bool HALFU = false>
__device__ __forceinline__ void gemm_phase(LAS unsigned char* lds, const Gemm g, const Sched& S, const Epi& E, int wvid, const int* gtab = nullptr, LAS int* ltab = nullptr, LAS float* lbias = nullptr) {
    const int tid_ = opaque_tid(wvid);
    const int tid = tid_, wid = __builtin_amdgcn_readfirstlane(tid >> 6), lane = tid & 63, wr = wid >> 2, wc = wid & 3, fr = lane & 15, fq = lane >> 4;
    const int nt = g.Kb / (BK * 2);
    unsigned voffA[2], voffB[2];
#pragma unroll
    for (int i = 0; i < 2; ++i) { int R, C; stage_rc(tid * 16 + i * 8192, R, C); const int Rb = Epi::PERM ? ((R & ~31) + perm32(R & 31)) : R;
        voffA[i] = (unsigned)(R * g.lda + C * 2); voffB[i] = (unsigned)(Rb * g.ldb + C * 2); }
    const size_t kstep = (size_t)(BK * 2);
    const size_t hstepA = (size_t)HALF * g.lda, hstepB = (size_t)HALF * g.ldb;
    const unsigned ldsw = (unsigned)wid * 1024u;
    const int aoff = lds_byte(wr * 64 + fr, fq * 8), boff = lds_byte(wc * 32 + fr, fq * 8);
#define PG8_SA(b, h) (((b) * 2 + (h)) * HTB)
#define PG8_SB(b, h) ((4 + (b) * 2 + (h)) * HTB)
#define PG8_STAGE(bufoff, gbase, voff) do { _Pragma("unroll") for (int _i = 0; _i < 2; ++_i) \
        __builtin_amdgcn_global_load_lds((const unsigned*)((const char*)(gbase) + (voff)[_i]), (LAS unsigned*)(lds + (bufoff) + ldsw + _i * 8192), 16, 0, 0); } while (0)
    unsigned vgC[2], vgN[2], gc2 = 0; (void)vgC; (void)vgN; (void)gc2;
    if constexpr (GATHER) { int R0_, C0_, R1_, C1_; stage_rc(tid * 16, R0_, C0_); stage_rc(tid * 16 + 8192, R1_, C1_); gc2 = (unsigned)(C0_ * 2) | ((unsigned)(C1_ * 2) << 8); }
#define PG8_GTAB_FETCH(u, buf) do { if (wid == 7) { int ln_; asm volatile("v_mbcnt_lo_u32_b32 %0, -1, 0\n\tv_mbcnt_hi_u32_b32 %0, -1, %0" : "=v"(ln_));   \
        __builtin_amdgcn_global_load_lds((const unsigned*)(gtab + (size_t)(u).pm * BM + ln_ * 4), (LAS unsigned*)(ltab + (buf) * BM), 16, 0, 0); } } while (0)
#define PG8_GTAB_READ(dst, buf) do { int tq_; asm volatile("v_mbcnt_lo_u32_b32 %0, -1, 0\n\tv_mbcnt_hi_u32_b32 %0, -1, %0" : "=v"(tq_)); tq_ += wid * 64;   \
        int Ra_, Ca_, Rb_, Cb_; stage_rc(tq_ * 16, Ra_, Ca_); stage_rc(tq_ * 16 + 8192, Rb_, Cb_); \
        _Pragma("unroll") for (int h_ = 0; h_ < 2; ++h_) dst[h_] = (unsigned)ltab[(buf) * BM + Ra_ + HALF * h_] | ((unsigned)ltab[(buf) * BM + Rb_ + HALF * h_] << 16); } while (0)
#define PG8_STAGE_A(bufoff, ptr, h, nx) do { if constexpr (GATHER) { const unsigned pk_ = (nx) ? vgN[h] : vgC[h]; unsigned vo_[2] = {(pk_ & 0xffffu) * (unsigned)g.lda + (gc2 & 0xffu), (pk_ >> 16) * (unsigned)g.lda + (gc2 >> 8)}; PG8_STAGE(bufoff, ptr, vo_); } \
        else PG8_STAGE(bufoff, (ptr) + (h) * hstepA, voffA); } while (0)
#define PG8_LD16(off) (*(const LAS v4i*)(lds + (off)))
#define PG8_LDA(dst, b, h) do { _Pragma("unroll") for (int m = 0; m < 4; ++m) { \
        if constexpr (FP8) dst##q[m] = __builtin_shufflevector(PG8_LD16(PG8_SA(b, h) + aoff + m * 2048), PG8_LD16(PG8_SA(b, h) + aoff + m * 2048 + 1024), 0, 1, 2, 3, 4, 5, 6, 7); \
        else { _Pragma("unroll") for (int k = 0; k < 2; ++k) dst[m][k] = *(const LAS bf16x8*)(lds + PG8_SA(b, h) + aoff + m * 2048 + k * 1024); } } } while (0)
#define PG8_LDB(dst, b, h) do { _Pragma("unroll") for (int n = 0; n < 2; ++n) { \
        if constexpr (FP8) dst##q[n] = __builtin_shufflevector(PG8_LD16(PG8_SB(b, h) + boff + n * 2048), PG8_LD16(PG8_SB(b, h) + boff + n * 2048 + 1024), 0, 1, 2, 3, 4, 5, 6, 7); \
        else { _Pragma("unroll") for (int k = 0; k < 2; ++k) dst[n][k] = *(const LAS bf16x8*)(lds + PG8_SB(b, h) + boff + n * 2048 + k * 1024); } } } while (0)
#define PG8_MMA(ai, bj, At, Bt) do { __builtin_amdgcn_s_setprio(1); _Pragma("unroll") for (int m = 0; m < 4; ++m) _Pragma("unroll") for (int n = 0; n < 2; ++n) { \
        if constexpr (FP8)   \
            asm volatile("v_mfma_scale_f32_16x16x128_f8f6f4 %0, %1, %2, %0, %3, %4 op_sel_hi:[0,0,0]" : "+v"(acc[ai][bj][m][n]) : "v"(Bt##q[n]), "v"(At##q[m]), "v"(scB_), "v"(scA_));   \
        else { _Pragma("unroll") for (int k = 0; k < 2; ++k) acc[ai][bj][m][n] = __builtin_amdgcn_mfma_f32_16x16x32_bf16(Bt[n][k], At[m][k], acc[ai][bj][m][n], 0, 0, 0); } } \
        __builtin_amdgcn_s_setprio(0); } while (0)
#define PG8_WAIT_V(n) asm volatile("s_waitcnt vmcnt(" #n ")" ::: "memory")
#define PG8_WAIT_L(n) asm volatile("s_waitcnt lgkmcnt(" #n ")" ::: "memory")
#define PG8_BAR __builtin_amdgcn_s_barrier()
#define PG8_SCHED __builtin_amdgcn_sched_barrier(0)
    Unit cur, nxt; int ui = 0;
    if (!S.next(0, cur)) return;
    f32x4 acc[2][2][4][2];
    float z0_; asm volatile("v_mov_b32 %0, 0" : "=v"(z0_));
#pragma unroll
    for (int a = 0; a < 2; ++a)
#pragma unroll
        for (int b = 0; b < 2; ++b)
#pragma unroll
            for (int m = 0; m < 4; ++m)
#pragma unroll
                for (int n = 0; n < 2; ++n) acc[a][b][m][n] = (f32x4){0.f, 0.f, 0.f, 0.f};
    const int scA_ = g.scaleA, scB_ = g.scaleB; (void)scA_; (void)scB_;
    const char* cA = S.a_ptr(cur); const char* cB = S.b_ptr(cur);
#define PG8_BIAS_FETCH(u, buf) do { if constexpr (Epi::BIAS_LDS) { if (wid == 6) { int lb_; asm volatile("v_mbcnt_lo_u32_b32 %0, -1, 0\n\tv_mbcnt_hi_u32_b32 %0, -1, %0" : "=v"(lb_));   \
        __builtin_amdgcn_global_load_lds((const unsigned*)(E.bias_src(u) + lb_ * 4), (LAS unsigned*)(lbias + (buf) * BM), 16, 0, 0); } } } while (0)
    PG8_BIAS_FETCH(cur, 0);
    if constexpr (GATHER) { PG8_GTAB_FETCH(cur, 0); PG8_WAIT_V(0); PG8_BAR; PG8_GTAB_READ(vgC, 0); }
    if constexpr (SP2) {
        PG8_STAGE(PG8_SB(0, 0), cB, voffB); PG8_STAGE(PG8_SB(0, 1), cB + hstepB, voffB); PG8_STAGE_A(PG8_SA(0, 0), cA, 0, false); PG8_STAGE_A(PG8_SA(0, 1), cA, 1, false);
        if (wr == 1) PG8_BAR;
        PG8_WAIT_V(2); PG8_BAR;
        PG8_STAGE(PG8_SB(1, 0), cB + kstep, voffB); PG8_STAGE_A(PG8_SA(1, 0), cA + kstep, 0, false); PG8_STAGE(PG8_SB(1, 1), cB + hstepB + kstep, voffB);
        PG8_WAIT_V(6); PG8_BAR;
    } else {
        PG8_STAGE(PG8_SB(0, 0), cB, voffB); PG8_STAGE(PG8_SA(0, 0), cA, voffA); PG8_STAGE(PG8_SB(0, 1), cB + hstepB, voffB); PG8_STAGE(PG8_SA(0, 1), cA + hstepA, voffA);
        if (wr == 1) PG8_BAR;
        PG8_WAIT_V(4); PG8_BAR;
        PG8_STAGE(PG8_SB(1, 0), cB + kstep, voffB); PG8_STAGE_A(PG8_SA(1, 0), cA + kstep, 0, false); PG8_STAGE(PG8_SB(1, 1), cB + hstepB + kstep, voffB);
        PG8_WAIT_V(6); PG8_BAR;
    }
    for (;;) {
        const bool has_next = S.next(ui + 1, nxt);
        const char* nA = has_next ? S.a_ptr(nxt) : cA; const char* nB = has_next ? S.b_ptr(nxt) : cB;
        if constexpr (GATHER) { if (has_next) PG8_GTAB_FETCH(nxt, (ui + 1) & 1); }
        if (ui > 0) PG8_BIAS_FETCH(cur, ui & 1);
        const bool hu = HALFU && cur.hf != 0;
        for (int t = 0; t < nt; t += 2) {
            const bool last = (t == nt - 2);
            if constexpr (GATHER) { if (last && has_next) PG8_GTAB_READ(vgN, (ui + 1) & 1); }
            const char* a1 = cA + (size_t)(t + 1) * kstep;
            const char* a2 = last ? nA : cA + (size_t)(t + 2) * kstep; const char* b2 = last ? nB : cB + (size_t)(t + 2) * kstep;
            const char* a3 = a2 + kstep; const char* b3 = b2 + kstep;
            bf16x8 At[4][2], B0[2][2], B1[2][2]; v8i Atq[4], B0q[2], B1q[2]; (void)At; (void)B0; (void)B1; (void)Atq; (void)B0q; (void)B1q;
            if constexpr (SP2) {
            PG8_LDB(B0, 0, 0); PG8_LDB(B1, 0, 1); PG8_SCHED; PG8_LDA(At, 0, 0); PG8_STAGE_A(PG8_SA(1, 1), a1, 1, false);
            PG8_WAIT_V(8); PG8_WAIT_L(0); PG8_BAR; PG8_MMA(0, 0, At, B0); PG8_MMA(0, 1, At, B1); PG8_BAR; PG8_SCHED;
            if (!hu) PG8_LDA(At, 0, 1); PG8_STAGE(PG8_SB(0, 0), b2, voffB); PG8_STAGE(PG8_SB(0, 1), b2 + hstepB, voffB); PG8_STAGE_A(PG8_SA(0, 0), a2, 0, last);
            PG8_WAIT_V(8); PG8_WAIT_L(0); PG8_BAR; if (!hu) { PG8_MMA(1, 0, At, B0); PG8_MMA(1, 1, At, B1); } PG8_BAR; PG8_SCHED;
            PG8_LDB(B0, 1, 0); PG8_LDB(B1, 1, 1); PG8_SCHED; PG8_LDA(At, 1, 0); PG8_STAGE_A(PG8_SA(0, 1), a2, 1, last);
            PG8_WAIT_V(8); PG8_WAIT_L(0); PG8_BAR; PG8_MMA(0, 0, At, B0); PG8_MMA(0, 1, At, B1); PG8_BAR; PG8_SCHED;
            if (!hu) PG8_LDA(At, 1, 1); PG8_STAGE(PG8_SB(1, 0), b3, voffB); PG8_STAGE(PG8_SB(1, 1), b3 + hstepB, voffB); PG8_STAGE_A(PG8_SA(1, 0), a3, 0, last);
            PG8_WAIT_V(8); PG8_WAIT_L(0); PG8_BAR; if (!hu) { PG8_MMA(1, 0, At, B0); PG8_MMA(1, 1, At, B1); } PG8_BAR; PG8_SCHED;
            } else {
            PG8_LDB(B0, 0, 0); PG8_SCHED; PG8_LDA(At, 0, 0); PG8_STAGE_A(PG8_SA(1, 1), a1, 1, false);
            PG8_WAIT_L(8); PG8_BAR; PG8_WAIT_L(0); PG8_MMA(0, 0, At, B0); PG8_BAR; PG8_SCHED;
            PG8_LDB(B1, 0, 1); PG8_STAGE(PG8_SB(0, 0), b2, voffB);
            PG8_BAR; PG8_WAIT_L(0); PG8_MMA(0, 1, At, B1); PG8_BAR;
            PG8_LDA(At, 0, 1); PG8_STAGE_A(PG8_SA(0, 0), a2, 0, last);
            PG8_BAR; PG8_WAIT_L(0); PG8_MMA(1, 0, At, B0); PG8_BAR; PG8_SCHED;
            PG8_STAGE(PG8_SB(0, 1), b2 + hstepB, voffB);
            PG8_WAIT_V(6); PG8_BAR; PG8_MMA(1, 1, At, B1); PG8_BAR;
            PG8_LDB(B0, 1, 0); PG8_SCHED; PG8_LDA(At, 1, 0); PG8_STAGE_A(PG8_SA(0, 1), a2, 1, last);
            PG8_WAIT_L(8); PG8_BAR; PG8_WAIT_L(0); PG8_MMA(0, 0, At, B0); PG8_BAR; PG8_SCHED;
            PG8_LDB(B1, 1, 1); PG8_STAGE(PG8_SB(1, 0), b3, voffB);
            PG8_BAR; PG8_WAIT_L(0); PG8_MMA(0, 1, At, B1); PG8_BAR;
            PG8_LDA(At, 1, 1); PG8_STAGE_A(PG8_SA(1, 0), a3, 0, last);
            PG8_BAR; PG8_WAIT_L(0); PG8_MMA(1, 0, At, B0); PG8_BAR; PG8_SCHED;
            PG8_STAGE(PG8_SB(1, 1), b3 + hstepB, voffB);
            PG8_WAIT_V(6); PG8_BAR; PG8_MMA(1, 1, At, B1); PG8_BAR;
            }
        }
        if constexpr (ALIGN_EPI) { if (wr == 0) PG8_BAR; }
        if constexpr (FP8) asm volatile("s_nop 15\n\ts_nop 15" ::: "memory");
        bool keep_ = false; if constexpr (Epi::CHAIN) keep_ = E.chain(acc, cur, wr, wc, fr, fq); else if constexpr (Epi::BIAS_LDS) E(acc, cur, wr, wc, fr, fq, lbias + (ui & 1) * BM); else E(acc, cur, wr, wc, fr, fq);
        if (!has_next) break;
        if (!keep_) {
#pragma unroll
        for (int a = 0; a < 2; ++a)
#pragma unroll
            for (int b = 0; b < 2; ++b)
#pragma unroll
                for (int m = 0; m < 4; ++m)
#pragma unroll
                    for (int n = 0; n < 2; ++n) acc[a][b][m][n] = (f32x4){z0_, z0_, z0_, z0_};
        }
        cur = nxt; cA = nA; cB = nB; ++ui;
        if constexpr (GATHER) {
#pragma unroll
            for (int h_ = 0; h_ < 2; ++h_) vgC[h_] = vgN[h_]; }
        if constexpr (ALIGN_EPI) { if (wr == 1) PG8_BAR; }
    }
    PG8_WAIT_V(0);
    if constexpr (!ALIGN_EPI) { if (wr == 0) PG8_BAR; }
    PG8_BAR;
#undef PG8_SA
#undef PG8_SB
#undef PG8_STAGE
#undef PG8_LDA
#undef PG8_LD16
#undef PG8_STAGE_A
#undef PG8_GTAB_FETCH
#undef PG8_GTAB_READ
#undef PG8_BIAS_FETCH
#undef PG8_LDB
#undef PG8_MMA
#undef PG8_WAIT_V
#undef PG8_WAIT_L
#undef PG8_BAR
#undef PG8_SCHED
}

template <bool HAS_BIAS> struct EpiStoreBf16 {
    static constexpr bool PERM = true, CHAIN = false, BIAS_LDS = HAS_BIAS;
    bf16_t* O; int ldc; const float* bias; int bias_stride; float scale; int sc_lo, sc_hi, ex_lo;
    __device__ __forceinline__ const float* bias_src(const Unit& u) const { return bias + (size_t)u.z * bias_stride + u.pn * BM; }
    __device__ __forceinline__ void operator()(const f32x4 (&acc)[2][2][4][2], const Unit& u, int wr, int wc, int fr, int fq, const LAS float* lb = nullptr) const {
        const int row0 = u.pm * BM + wr * 64 + fr, col0 = u.pn * BM + wc * 32 + 8 * fq; const float sc = (u.pn >= sc_lo && u.pn < sc_hi) ? scale : 1.f;
        f32x4 bv[2][2];
#pragma unroll
        for (int bj = 0; bj < 2; ++bj)
#pragma unroll
            for (int n = 0; n < 2; ++n) { if constexpr (HAS_BIAS) bv[bj][n] = *(const LAS f32x4*)(lb + wc * 32 + 8 * fq + bj * HALF + 4 * n); }
#pragma unroll
        for (int ai = 0; ai < 2; ++ai)
#pragma unroll
            for (int m = 0; m < 4; ++m) { bf16_t* rowp = O + (size_t)(row0 + ai * HALF + m * 16) * ldc + col0;
#pragma unroll
                for (int bj = 0; bj < 2; ++bj) { f32x4 v0 = acc[ai][bj][m][0], v1 = acc[ai][bj][m][1]; if constexpr (HAS_BIAS) { v0 += bv[bj][0]; v1 += bv[bj][1]; } v0 *= sc; v1 *= sc;
                    if (u.pn >= ex_lo) {
#pragma unroll
                        for (int j = 0; j < 4; ++j) { v0[j] = __builtin_amdgcn_exp2f(fminf(-1.4426950408889634f * v0[j], 8.75f)); v1[j] = __builtin_amdgcn_exp2f(fminf(-1.4426950408889634f * v1[j], 8.75f)); }
                        int lo = __builtin_amdgcn_cvt_pk_fp8_f32(v0[0], v0[1], 0, false); lo = __builtin_amdgcn_cvt_pk_fp8_f32(v0[2], v0[3], lo, true);
                        int hi = __builtin_amdgcn_cvt_pk_fp8_f32(v1[0], v1[1], 0, false); hi = __builtin_amdgcn_cvt_pk_fp8_f32(v1[2], v1[3], hi, true);
                        *(u32x2*)((unsigned char*)(rowp - col0) + ex_lo * BM * 2 + (col0 - ex_lo * BM) + bj * HALF) = (u32x2){(unsigned)lo, (unsigned)hi}; }
                    else { u32x4 w; w.x = cvt_pk_bf16(v0[0], v0[1]); w.y = cvt_pk_bf16(v0[2], v0[3]); w.z = cvt_pk_bf16(v1[0], v1[1]); w.w = cvt_pk_bf16(v1[2], v1[3]);
                        *(u32x4*)(rowp + bj * HALF) = w; } } }
    }
};
struct EpiStoreF8 {
    static constexpr bool PERM = true, CHAIN = false, BIAS_LDS = true;
    unsigned char* O; int ldc; const float* bias; int bias_stride; float scale;
    __device__ __forceinline__ const float* bias_src(const Unit& u) const { return bias + (size_t)u.z * bias_stride + u.pn * BM; }
    __device__ __forceinline__ void operator()(const f32x4 (&acc)[2][2][4][2], const Unit& u, int wr, int wc, int fr, int fq, const LAS float* lb) const {
        const int row0 = u.pm * BM + wr * 64 + fr, col0 = u.pn * BM + wc * 32 + 8 * fq;
        f32x4 bv[2][2];
#pragma unroll
        for (int bj = 0; bj < 2; ++bj)
#pragma unroll
            for (int n = 0; n < 2; ++n) bv[bj][n] = *(const LAS f32x4*)(lb + wc * 32 + 8 * fq + bj * HALF + 4 * n);
#pragma unroll
        for (int ai = 0; ai < 2; ++ai)
#pragma unroll
            for (int m = 0; m < 4; ++m) { unsigned char* rowp = O + (size_t)(row0 + ai * HALF + m * 16) * ldc + col0;
#pragma unroll
                for (int bj = 0; bj < 2; ++bj) { const f32x4 v0 = (acc[ai][bj][m][0] + bv[bj][0]) * scale, v1 = (acc[ai][bj][m][1] + bv[bj][1]) * scale;
                    int lo = __builtin_amdgcn_cvt_pk_fp8_f32(v0[0], v0[1], 0, false); lo = __builtin_amdgcn_cvt_pk_fp8_f32(v0[2], v0[3], lo, true);
                    int hi = __builtin_amdgcn_cvt_pk_fp8_f32(v1[0], v1[1], 0, false); hi = __builtin_amdgcn_cvt_pk_fp8_f32(v1[2], v1[3], hi, true);
                    *(u32x2*)(rowp + bj * HALF) = (u32x2){(unsigned)lo, (unsigned)hi}; } }
    }
};
struct EpiMergeF {
    static constexpr bool PERM = true, CHAIN = true, BIAS_LDS = false;
    const bf16_t* P; bf16_t* Mo;
    __device__ __forceinline__ bool chain(f32x4 (&acc)[2][2][4][2], const Unit& u, int wr, int wc, int fr, int fq) const {
        const int row0 = u.pm * BM + (u.hf == 2 ? HALF : 0) + wr * 64 + fr, col0 = u.pn * BM + wc * 32 + 8 * fq; const int ga = (u.z == 0 ? O_BGC : u.z == 1 ? O_BGN : O_BGG) + col0, gb = (u.z == 0 ? O_BGN : O_BGG) + col0;
        const bool last = (u.z == 2); const int nai = u.hf != 0 ? 1 : 2;
        u32x2 wa[2][4][2], wb[2][4][2];
#pragma unroll
        for (int ai = 0; ai < 2; ++ai) { if (ai < nai) {
#pragma unroll
            for (int m = 0; m < 4; ++m) { const unsigned char* gp = (const unsigned char*)(P + (size_t)(row0 + ai * HALF + m * 16) * INC + O_BGC);
#pragma unroll
                for (int bj = 0; bj < 2; ++bj) { wa[ai][m][bj] = *(const u32x2*)(gp + (ga - O_BGC) + bj * HALF); wb[ai][m][bj] = last ? wa[ai][m][bj] : *(const u32x2*)(gp + (gb - O_BGC) + bj * HALF); } } } }
        asm volatile("" ::: "memory");
#pragma unroll
        for (int ai = 0; ai < 2; ++ai) { if (ai < nai) {
#pragma unroll
            for (int m = 0; m < 4; ++m) { const size_t row = (size_t)(row0 + ai * HALF + m * 16);
#pragma unroll
                for (int bj = 0; bj < 2; ++bj) { typedef float v2f_ __attribute__((ext_vector_type(2))); float f[8];
#pragma unroll
                    for (int j = 0; j < 2; ++j) { const int w = (int)(j ? wa[ai][m][bj].y : wa[ai][m][bj].x); const v2f_ e01 = __builtin_amdgcn_cvt_pk_f32_fp8(w, false), e23 = __builtin_amdgcn_cvt_pk_f32_fp8(w, true);
                        f[4 * j] = __builtin_amdgcn_rcpf(1.f + e01[0]); f[4 * j + 1] = __builtin_amdgcn_rcpf(1.f + e01[1]); f[4 * j + 2] = __builtin_amdgcn_rcpf(1.f + e23[0]); f[4 * j + 3] = __builtin_amdgcn_rcpf(1.f + e23[1]); }
                    if (!last) {
#pragma unroll
                        for (int j = 0; j < 2; ++j) { const int w = (int)(j ? wb[ai][m][bj].y : wb[ai][m][bj].x); const v2f_ e01 = __builtin_amdgcn_cvt_pk_f32_fp8(w, false), e23 = __builtin_amdgcn_cvt_pk_f32_fp8(w, true);
                            f[4 * j] *= 1.f + e01[0]; f[4 * j + 1] *= 1.f + e01[1]; f[4 * j + 2] *= 1.f + e23[0]; f[4 * j + 3] *= 1.f + e23[1]; } }
                    f32x4& a0 = acc[ai][bj][m][0]; f32x4& a1 = acc[ai][bj][m][1];
                    a0[0] *= f[0]; a0[1] *= f[1]; a0[2] *= f[2]; a0[3] *= f[3]; a1[0] *= f[4]; a1[1] *= f[5]; a1[2] *= f[6]; a1[3] *= f[7];
                    if (last) { u32x4 w; w.x = cvt_pk_bf16(a0[0], a0[1]); w.y = cvt_pk_bf16(a0[2], a0[3]); w.z = cvt_pk_bf16(a1[0], a1[1]); w.w = cvt_pk_bf16(a1[2], a1[3]);
                        *(u32x4*)(Mo + row * D + col0 + bj * HALF) = w; } } } } }
        return !last;
    }
};
struct EpiNull { static constexpr bool PERM = true, CHAIN = false, BIAS_LDS = false; float* sink;
    __device__ __forceinline__ void operator()(const f32x4 (&acc)[2][2][4][2], const Unit& u, int wr, int wc, int fr, int fq) const { float s = 0.f;
#pragma unroll
        for (int a = 0; a < 2; ++a)
#pragma unroll
            for (int b = 0; b < 2; ++b)
#pragma unroll
                for (int m = 0; m < 4; ++m)
#pragma unroll
                    for (int n = 0; n < 2; ++n) s += acc[a][b][m][n][0];
        if (s == 1.2345e30f) sink[0] = s; } };
struct EpiOutF {
    static constexpr bool PERM = true, CHAIN = false, BIAS_LDS = false;
    bf16_t* X; const float* modl; float gmul;
    __device__ __forceinline__ void operator()(const f32x4 (&acc)[2][2][4][2], const Unit& u, int wr, int wc, int fr, int fq) const {
        const int row0 = u.pm * BM + (u.hf == 2 ? HALF : 0) + wr * 64 + fr, col0 = u.pn * BM + wc * 32 + 8 * fq; const bool lat = u.pm < NLAT / BM; const int mr = lat ? u.pm / (SEQ / BM) : 8;
        const float* gt = modl + (size_t)mr * MODW + 2 * D + col0;
        f32x4 gv[2][2];
#pragma unroll
        for (int bj = 0; bj < 2; ++bj)
#pragma unroll
            for (int n = 0; n < 2; ++n) gv[bj][n] = *(const f32x4*)(gt + bj * HALF + n * 4) * gmul;
#pragma unroll
        for (int ai = 0; ai < 2; ++ai) { if (ai == 1 && u.hf != 0) break;
            u32x4 xb[4][2];
#pragma unroll
            for (int m = 0; m < 4; ++m) { const bf16_t* srcp = X + (size_t)row0 * D + (size_t)(ai * HALF + m * 16) * D + col0;
#pragma unroll
                for (int bj = 0; bj < 2; ++bj) xb[m][bj] = *(const u32x4*)(srcp + bj * HALF); }
            asm volatile("" ::: "memory");
#pragma unroll
            for (int m = 0; m < 4; ++m) { bf16_t* rowp = X + (size_t)row0 * D + (size_t)(ai * HALF + m * 16) * D + col0;
#pragma unroll
                for (int bj = 0; bj < 2; ++bj) { const u32x4 w = xb[m][bj];
                    const f32x4 x0 = {bf2f(w.x & 0xffff), bf2f(w.x >> 16), bf2f(w.y & 0xffff), bf2f(w.y >> 16)}, x1 = {bf2f(w.z & 0xffff), bf2f(w.z >> 16), bf2f(w.w & 0xffff), bf2f(w.w >> 16)};
                    const f32x4 o0 = x0 + gv[bj][0] * acc[ai][bj][m][0], o1 = x1 + gv[bj][1] * acc[ai][bj][m][1];
                    *(u32x4*)(rowp + bj * HALF) = (u32x4){cvt_pk_bf16(o0[0], o0[1]), cvt_pk_bf16(o0[2], o0[3]), cvt_pk_bf16(o1[0], o1[1]), cvt_pk_bf16(o1[2], o1[3])}; } }
        }
    }
};
struct EpiGUF {
    static constexpr bool PERM = true, CHAIN = false, BIAS_LDS = true;
    unsigned char* Ao; const float* bias; bool nobias;
    __device__ __forceinline__ const float* bias_src(const Unit& u) const { return bias + (size_t)u.z * 2048 + u.pn * BM; }
    __device__ __forceinline__ void operator()(const f32x4 (&acc)[2][2][4][2], const Unit& u, int wr, int wc, int fr, int fq, const LAS float* lb) const {
        const int row0 = u.pm * BM + wr * 64 + fr;
        f32x4 bv[2][2];
#pragma unroll
        for (int bj = 0; bj < 2; ++bj)
#pragma unroll
            for (int n = 0; n < 2; ++n) { bv[bj][n] = nobias ? (f32x4){0.1f, 0.2f, 0.3f, 0.4f} : *(const LAS f32x4*)(lb + wc * 32 + 8 * fq + bj * HALF + 4 * n); if (n == 0) bv[bj][n] *= -1.702f * 1.4426950408889634f; }
        constexpr float C1 = -1.702f * 1.4426950408889634f, K4 = 4.f / C1;
#pragma unroll
        for (int ai = 0; ai < 2; ++ai)
#pragma unroll
            for (int bj = 0; bj < 2; ++bj) { unsigned w[4];
#pragma unroll
                for (int m = 0; m < 4; ++m) { float r[4];
#pragma unroll
                    for (int jp = 0; jp < 2; ++jp) {
                        typedef float f2_ __attribute__((ext_vector_type(2)));
                        const f2_ g2 = {acc[ai][bj][m][0][2 * jp], acc[ai][bj][m][0][2 * jp + 1]}, u2 = {acc[ai][bj][m][1][2 * jp], acc[ai][bj][m][1][2 * jp + 1]};
                        const f2_ bg2 = {bv[bj][0][2 * jp], bv[bj][0][2 * jp + 1]}, bu2 = {bv[bj][1][2 * jp], bv[bj][1][2 * jp + 1]};
                        f2_ t2 = __builtin_elementwise_fma(g2, (f2_){C1, C1}, bg2); t2[0] = fmaxf(t2[0], 7.f * C1); t2[1] = fmaxf(t2[1], 7.f * C1);
                        f2_ d2 = {__builtin_amdgcn_exp2f(t2[0]), __builtin_amdgcn_exp2f(t2[1])}; d2 = d2 + (f2_){1.f, 1.f};
                        const f2_ s2 = {__builtin_amdgcn_rcpf(d2[0]), __builtin_amdgcn_rcpf(d2[1])};
                        f2_ uc2 = u2 + bu2; uc2[0] = __builtin_amdgcn_fmed3f(uc2[0], -7.f, 7.f); uc2[1] = __builtin_amdgcn_fmed3f(uc2[1], -7.f, 7.f);
                        const f2_ r2 = __builtin_elementwise_fma(uc2, (f2_){K4, K4}, (f2_){K4, K4}) * (t2 * s2);
                        r[2 * jp] = r2[0]; r[2 * jp + 1] = r2[1]; }
                    int pk = __builtin_amdgcn_cvt_pk_fp8_f32(r[0], r[1], 0, false); pk = __builtin_amdgcn_cvt_pk_fp8_f32(r[2], r[3], pk, true); w[m] = (unsigned)pk; }
                { auto p02 = __builtin_amdgcn_permlane32_swap(w[0], w[2], false, false); auto p13 = __builtin_amdgcn_permlane32_swap(w[1], w[3], false, false);
                  auto q01 = __builtin_amdgcn_permlane16_swap(p02[0], p13[0], false, false); auto q23 = __builtin_amdgcn_permlane16_swap(p02[1], p13[1], false, false);
                  w[0] = q01[0]; w[1] = q01[1]; w[2] = q23[0]; w[3] = q23[1]; }
                *(u32x4*)(Ao + (size_t)(row0 + ai * HALF + fq * 16) * D + (u.pn * (BM / 2) + wc * 16) + bj * (HALF / 2)) = (u32x4){w[0], w[1], w[2], w[3]}; }
    }
};

struct SchedGrid {
    const char* A; const char* B; int nM, nN, G, c, lda, ldb;
    __device__ __forceinline__ bool next(int i, Unit& u) const { u.z = 0; u.hf = 0; return tile_order(i * G + c, nM, nN, u.pm, u.pn); }
    __device__ __forceinline__ const char* a_ptr(const Unit& u) const { return A + (size_t)u.pm * BM * lda; }
    __device__ __forceinline__ const char* b_ptr(const Unit& u) const { return B + (size_t)u.pn * BM * ldb; }
};
struct SchedInprojR {
    const char* A; const char* B; int pn0, nN, G, c, rowb; bool ctxkv; int nfull, cmin;
    static __host__ __device__ __forceinline__ int nkv(int p0, int n) { const int lo = p0 > 8 ? p0 : 8, hi = (p0 + n) < 12 ? (p0 + n) : 12; return (hi > lo ? hi - lo : 0) + ((p0 <= 14 && 14 < p0 + n) ? 1 : 0); }
    __device__ __forceinline__ bool next(int i, Unit& u) const { u.z = 0; u.hf = 0; if (i >= nfull && c < cmin) return false;
        const int L = i < nfull ? i * G + c : nfull * G + (i - nfull) * (G - cmin) + (c - cmin), nM = ctxkv ? NLAT / BM : NTOK / BM, nl = nM * nN;
        if (L < nl) { const bool ok = tile_order(L, nM, nN, u.pm, u.pn); u.pn += pn0; return ok; }
        if (!ctxkv) return false;
        const int j = L - nl, lo = pn0 > 8 ? pn0 : 8, hi = (pn0 + nN) < 12 ? (pn0 + nN) : 12, n1 = hi > lo ? hi - lo : 0, nk = nkv(pn0, nN); if (nk == 0 || j >= (NCTX / BM) * nk) return false;
        u.pm = NLAT / BM + j / nk; const int q = j % nk; u.pn = q < n1 ? lo + q : 14; return true; }
    __device__ __forceinline__ const char* a_ptr(const Unit& u) const { return A + (size_t)u.pm * BM * rowb; }
    __device__ __forceinline__ const char* b_ptr(const Unit& u) const { return B + (size_t)u.pn * BM * rowb; }
};
__device__ __forceinline__ bool mo_tile(int T, bool ctx, Unit& u) {
    u.hf = 0; if (T < (NLAT / BM) * 4) return tile_order(T, NLAT / BM, 4, u.pm, u.pn);
    const int j = T - (NLAT / BM) * 4; if (!ctx || j >= (NCTX / BM) * 8) return false;
    u.pm = NLAT / BM + (j >> 3); u.pn = (j >> 1) & 3; u.hf = 1 + (j & 1); return true; }
struct SchedMerge {
    const char* Y; const char* W; bool ctx; int G, c;
    __device__ __forceinline__ bool next(int i, Unit& u) const { u.z = i % 3; return mo_tile((i / 3) * G + c, ctx, u); }
    __device__ __forceinline__ const char* a_ptr(const Unit& u) const { return Y + ((size_t)(u.pm * BM + (u.hf == 2 ? HALF : 0)) * 1536 + u.z * 512) * 2; }
    __device__ __forceinline__ const char* b_ptr(const Unit& u) const { return W + ((size_t)u.z * D * 512 + (size_t)u.pn * BM * 512) * 2; }
};
struct SchedOut {
    const char* A; const char* B; bool ctx; int G, c;
    __device__ __forceinline__ bool next(int i, Unit& u) const { u.z = 0; return mo_tile(i * G + c, ctx, u); }
    __device__ __forceinline__ const char* a_ptr(const Unit& u) const { return A + (size_t)(u.pm * BM + (u.hf == 2 ? HALF : 0)) * D * 2; }
    __device__ __forceinline__ const char* b_ptr(const Unit& u) const { return B + (size_t)u.pn * BM * D * 2; }
};
struct SchedMoe {
    const char* A; const char* W; const LAS int* eoff; int nN, G, c; size_t wstride; int rowb; bool gather;
    __device__ __forceinline__ bool next(int i, Unit& u) const {
        const int npan = eoff[NE] / BM;
        if (G == 256) { const int x = c & 7, r = c >> 3, ppx = 32 / nN; u.pm = (i * 8 + x) * ppx + r / nN; u.pn = r % nN; if (u.pm >= npan) return false; }
        else { const int L = i * G + c; if (L >= npan * nN) return false; u.pm = L / nN; u.pn = L % nN; }
        int e = 0; const int row = u.pm * BM;
#pragma unroll
        for (int s = 16; s >= 1; s >>= 1) { if (__builtin_amdgcn_readfirstlane(eoff[e + s]) <= row) e += s; }
        u.z = e; u.hf = 0; return true; }
    __device__ __forceinline__ const char* a_ptr(const Unit& u) const { return gather ? A : A + (size_t)u.pm * BM * rowb; }
    __device__ __forceinline__ const char* b_ptr(const Unit& u) const { return W + (size_t)u.z * wstride + (size_t)u.pn * BM * rowb; }
};
}

#define XB_TMO      128
#define XB_XCNT(j)  (256  + 64 * (j))
#define XB_XSUB(j)  (1280 + 64 * (j))
#define XB_XGEN(j)  (2304 + 64 * (j))
#define XB_TOP      3328
#define XB_TOPGEN   3392
#define XCD_BAR_WORDS 3456
#define XB_SPIN_CAP (1u << 20)
__device__ __forceinline__ unsigned xb_ld(unsigned* p)              { return __hip_atomic_load(p, __ATOMIC_RELAXED, __HIP_MEMORY_SCOPE_AGENT); }
__device__ __forceinline__ unsigned xb_add(unsigned* p, unsigned v) { return __hip_atomic_fetch_add(p, v, __ATOMIC_RELAXED, __HIP_MEMORY_SCOPE_AGENT); }
__device__ __forceinline__ unsigned xb_xcc_id() { return (unsigned)__builtin_amdgcn_s_getreg((3 << 11) | 20) & 0xFu; }
#define XB_SPIN(cond, bar) do { unsigned _sp = 0; while (cond) { __builtin_amdgcn_s_sleep(1); \
    if ((++_sp & 255u) == 0u) { if (xb_ld(&(bar)[XB_TMO])) break; if (_sp > XB_SPIN_CAP) { atomicAdd(&(bar)[XB_TMO], 1u); break; } } } } while (0)
struct XcdBarrier { unsigned* bar; unsigned x; volatile LAS unsigned* st; };
__device__ __forceinline__ XcdBarrier xcd_barrier_post(unsigned* bar, volatile LAS unsigned* st) {
    XcdBarrier b; b.bar = bar; b.x = xb_xcc_id(); b.st = st;
    if (threadIdx.x == 0) (void)xb_add(&bar[XB_XCNT(b.x)], 1u);
    return b;
}
__device__ __forceinline__ void xcd_barrier_complete(unsigned* bar, unsigned x, unsigned& nloc, unsigned& nx) {
    const unsigned G = gridDim.x * gridDim.y * gridDim.z;
    unsigned sum, cnt, mine, sp = 0u;
    for (;;) {
        sum = 0u; cnt = 0u; mine = 0u;
#pragma unroll 1
        for (unsigned j = 0; j < 16; ++j) { const unsigned c = xb_ld(&bar[XB_XCNT(j)]); sum += c; cnt += (c > 0u) ? 1u : 0u; mine = (j == x) ? c : mine; }
        if (sum == G) break;
        __builtin_amdgcn_s_sleep(1);
        if ((++sp & 255u) == 0u) { if (xb_ld(&bar[XB_TMO])) break; if (sp > XB_SPIN_CAP) { atomicAdd(&bar[XB_TMO], 1u); break; } }
    }
    nloc = mine > 0u ? mine : 1u; nx = cnt > 0u ? cnt : 1u;
}
__device__ __forceinline__ void xcd_barrier(const XcdBarrier& b, int wvid) {
    asm volatile("s_waitcnt vmcnt(0)" ::: "memory");
    __syncthreads();
    if (opaque_tid(wvid) == 0) {
        unsigned* bar = b.bar;
        __builtin_amdgcn_s_waitcnt(0);
        unsigned nloc = b.st[0], nx = b.st[1];
        if (nloc == 0u) { xcd_barrier_complete(bar, b.x, nloc, nx); b.st[0] = nloc; b.st[1] = nx; }
        const unsigned old = xb_add(&bar[XB_XSUB(b.x)], 1u);
        const unsigned gen = old / nloc;
        if (old + 1u == (gen + 1u) * nloc) {
            __builtin_amdgcn_fence(__ATOMIC_RELEASE, "agent");
            asm volatile("s_waitcnt vmcnt(0)" ::: "memory");
            const unsigned og = xb_add(&bar[XB_TOP], 1u);
            const unsigned tg = og / nx;
            if (og + 1u == (tg + 1u) * nx) xb_add(&bar[XB_TOPGEN], 1u);
            else XB_SPIN(xb_ld(&bar[XB_TOPGEN]) == tg, bar);
            __builtin_amdgcn_fence(__ATOMIC_ACQUIRE, "agent");
            xb_add(&bar[XB_XGEN(b.x)], 1u);
            asm volatile("s_waitcnt vmcnt(0)" ::: "memory");
        } else {
            XB_SPIN(xb_ld(&bar[XB_XGEN(b.x)]) == gen, bar);
            __builtin_amdgcn_fence(__ATOMIC_ACQUIRE, "agent");
            asm volatile("s_waitcnt vmcnt(0)" ::: "memory");
        }
    }
    __syncthreads();
}

#include <hip/hip_bf16.h>
#include <cmath>
namespace attn_body {
using bf16=__hip_bfloat16;
using bf16x8=__attribute__((ext_vector_type(8)))short;
using s16x4=__attribute__((ext_vector_type(4)))short;
using f32x16=__attribute__((ext_vector_type(16)))float;
using u32x4=__attribute__((ext_vector_type(4)))unsigned;
constexpr int D=64;
constexpr int NW=8,QBLK=32,QB=QBLK*NW,KVBLK=64;
constexpr int ATTN_UNIT_ROWS=QB;
__device__ __forceinline__ int crow(int r,int hi){return (r&3)+8*(r>>2)+4*hi;}
#define SBAR() __builtin_amdgcn_sched_barrier(0)
constexpr int NSLOT=3, SLOTB=8192;
constexpr int LDS_K=0, LDS_V=NSLOT*SLOTB, LDS_WS=2*NSLOT*SLOTB, LDS_OST=LDS_WS+NW*64*4, LDS_BYTES=LDS_OST+NW*4096;
constexpr float C2=0.125f*1.4426950408889634f;
__device__ __forceinline__ void glds16(const void*gsrc,unsigned lds_dst){unsigned keep;
  asm volatile("s_mov_b32 %0, m0\n\ts_mov_b32 m0, %2\n\ts_nop 0\n\tglobal_load_lds_dwordx4 %1, off\n\ts_mov_b32 m0, %0":"=&s"(keep):"v"(gsrc),"s"(lds_dst):"memory");}
__device__ __forceinline__ float max3f(float a,float b,float c){float r;asm("v_max3_f32 %0, %1, %2, %3":"=v"(r):"v"(a),"v"(b),"v"(c));return r;}
__device__ __forceinline__ float max2f(float a,float b){float r;asm("v_max_f32_e32 %0, %1, %2":"=v"(r):"v"(a),"v"(b));return r;}
__device__ __forceinline__ float fadd_s(float a,float b){float r;asm("v_add_f32_e32 %0, %1, %2":"=v"(r):"v"(a),"v"(b));return r;}
__device__ __forceinline__ float fsub_s(float a,float b){float r;asm("v_sub_f32_e32 %0, %1, %2":"=v"(r):"v"(a),"v"(b));return r;}
typedef float f32x2_t __attribute__((ext_vector_type(2))); typedef __bf16 bf16x2_t __attribute__((ext_vector_type(2)));
__device__ __forceinline__ unsigned cvtpk_s(float lo,float hi){f32x2_t v={lo,hi};bf16x2_t b=__builtin_convertvector(v,bf16x2_t);return __builtin_bit_cast(unsigned,b);}
#define WAIT_BAR(N) asm volatile("s_waitcnt vmcnt(" #N ") lgkmcnt(0)\n\ts_barrier":::"memory")

__device__ __forceinline__ void qkt(f32x16&p0,f32x16&p1,const char*Kslot,const bf16x8*qr,const f32x16&negm,int r32,int hi){
  const char*kb=Kslot+hi*1024+r32*16;
  #pragma unroll
  for(int d0=0;d0<4;++d0){
    const bf16x8 b0=*reinterpret_cast<const bf16x8*>(kb+d0*2048);
    const bf16x8 b1=*reinterpret_cast<const bf16x8*>(kb+d0*2048+512);
    if(d0==0){p0=__builtin_amdgcn_mfma_f32_32x32x16_bf16(b0,qr[0],negm,0,0,0);p1=__builtin_amdgcn_mfma_f32_32x32x16_bf16(b1,qr[0],negm,0,0,0);}
    else{p0=__builtin_amdgcn_mfma_f32_32x32x16_bf16(b0,qr[d0],p0,0,0,0);p1=__builtin_amdgcn_mfma_f32_32x32x16_bf16(b1,qr[d0],p1,0,0,0);}}
}
typedef __attribute__((address_space(3))) const char* lds_cptr;
typedef short v4i16_t __attribute__((ext_vector_type(4)));
__device__ __forceinline__ void kload8(bf16x8*kf,lds_cptr kp){
  kf[0]=*(const __attribute__((address_space(3))) bf16x8*)(kp);      kf[1]=*(const __attribute__((address_space(3))) bf16x8*)(kp+512);
  kf[2]=*(const __attribute__((address_space(3))) bf16x8*)(kp+2048); kf[3]=*(const __attribute__((address_space(3))) bf16x8*)(kp+2560);
  kf[4]=*(const __attribute__((address_space(3))) bf16x8*)(kp+4096); kf[5]=*(const __attribute__((address_space(3))) bf16x8*)(kp+4608);
  kf[6]=*(const __attribute__((address_space(3))) bf16x8*)(kp+6144); kf[7]=*(const __attribute__((address_space(3))) bf16x8*)(kp+6656);
}
__device__ __forceinline__ void kload2(bf16x8*kf,lds_cptr kp,int j){ kf[2*j]=*(const __attribute__((address_space(3))) bf16x8*)(kp+j*2048); kf[2*j+1]=*(const __attribute__((address_space(3))) bf16x8*)(kp+j*2048+512); }
__device__ __forceinline__ s16x4 vtr(lds_cptr p){ return __builtin_bit_cast(s16x4,__builtin_amdgcn_ds_read_tr16_b64_v4i16((__attribute__((address_space(3))) v4i16_t*)p)); }
__device__ __forceinline__ float rowmax(const f32x16&p0,const f32x16&p1){
  float a=max3f(p0[0],p0[1],p1[0]),b=max3f(p0[2],p0[3],p1[1]);a=max3f(a,p1[2],p1[3]);
  #pragma unroll
  for(int r=4;r<16;r+=4){a=max3f(a,p0[r],p0[r+1]);b=max3f(b,p0[r+2],p0[r+3]);a=max3f(a,p1[r],p1[r+1]);b=max3f(b,p1[r+2],p1[r+3]);}
  const float m=max2f(a,b);
  auto rr=__builtin_amdgcn_permlane32_swap(__float_as_uint(m),__float_as_uint(m),false,false);
  return max2f(__uint_as_float(rr[0]),__uint_as_float(rr[1]));
}
__device__ __forceinline__ void pv(f32x16*o,int vb,bf16x8 pa0,bf16x8 pa1,bf16x8 pa2,bf16x8 pa3){
  #pragma unroll
  for(int d0=0;d0<2;++d0){s16x4 lo[4],hi[4];
    #pragma unroll
    for(int ks=0;ks<4;++ks){
      asm volatile("ds_read_b64_tr_b16 %0,%1 offset:%c2":"=&v"(lo[ks]):"v"(vb),"i"(d0*4096+ks*1024):"memory");
      asm volatile("ds_read_b64_tr_b16 %0,%1 offset:%c2":"=&v"(hi[ks]):"v"(vb),"i"(d0*4096+ks*1024+512):"memory");}
    asm volatile("s_waitcnt lgkmcnt(0)":::"memory");SBAR();
    #define PK(k) (bf16x8){lo[k][0],lo[k][1],lo[k][2],lo[k][3],hi[k][0],hi[k][1],hi[k][2],hi[k][3]}
    o[d0]=__builtin_amdgcn_mfma_f32_32x32x16_bf16(pa0,PK(0),o[d0],0,0,0);
    o[d0]=__builtin_amdgcn_mfma_f32_32x32x16_bf16(pa1,PK(1),o[d0],0,0,0);
    o[d0]=__builtin_amdgcn_mfma_f32_32x32x16_bf16(pa2,PK(2),o[d0],0,0,0);
    o[d0]=__builtin_amdgcn_mfma_f32_32x32x16_bf16(pa3,PK(3),o[d0],0,0,0);
    #undef PK
  }
}

#ifndef ATTN_STORE16
#define ATTN_STORE16(p,v) (*(u32x4*)(p)=(v))
#endif
struct NaArgs { long trow_ctx, trow_band; int R0, rs0; const float* natab; };
template<int THRL,bool NA> __device__ __forceinline__ void attn_unit(const bf16*Qw0,int QP,const bf16*__restrict__ Kh,int KP,const bf16*__restrict__ Vh,int VP,bf16*Ow0,int OP,int NT,char*shm,const NaArgs na,int wvid,int qmode=0,const float*qgain=nullptr,int tq0=0){
  const int tid=opaque_tid(wvid),lane=tid&63,r32=lane&31,hi=lane>>5; const int wid=__builtin_amdgcn_readfirstlane(tid>>6);
  if(wid>=4)__builtin_amdgcn_s_setprio(1);
  const bf16*Qw=Qw0+(long)(wid*QBLK)*QP;
  const unsigned lds0=(unsigned)(uintptr_t)shm;
  float*wsf=(float*)(shm+LDS_WS)+wid*64;
  const bf16*ksrc=Kh+(long)lane*KP+wid*8;
  const bf16*vsrc=Vh+(long)(16*(wid&3)+(lane>>2))*VP+(wid>>2)*32+(lane&3)*8;
  const unsigned kdst=lds0+LDS_K+wid*1024, vdst=lds0+LDS_V+wid*1024;
  #define TROW(t) (NA ? ((t)<4 ? na.trow_ctx+(long)(t)*KVBLK : na.trow_band+(long)((t)-4)*KVBLK) : (long)(t)*KVBLK)
  #define DMA_K(t,slot) glds16(ksrc+TROW(t)*KP,(unsigned)__builtin_amdgcn_readfirstlane(kdst+(slot)))
  #define DMA_V(t,slot) glds16(vsrc+TROW(t)*VP,(unsigned)__builtin_amdgcn_readfirstlane(vdst+(slot)))
  const int vb0=(int)(lds0+LDS_V)+((lane>>4)&1)*32+(lane&3)*8+(4*hi+((lane&15)>>2))*64;
  const char*Kbase=shm+LDS_K; bf16x8 kf[8];
  const lds_cptr shm3=(lds_cptr)shm; const lds_cptr kp0=shm3+LDS_K+hi*1024+r32*16; const lds_cptr vp0=shm3+LDS_V+((lane>>4)&1)*32+(lane&3)*8+(4*hi+((lane&15)>>2))*64;
  DMA_K(0,0);DMA_V(0,0);DMA_K(1,SLOTB);
  bf16x8 qr[4];
  #pragma unroll
  for(int d0=0;d0<4;++d0)qr[d0]=*reinterpret_cast<const bf16x8*>(&Qw[(long)r32*QP+d0*16+hi*8]);
  if(qmode!=0){
    float v[32]; float ss=0.f;
    #pragma unroll
    for(int d0=0;d0<4;++d0)
      #pragma unroll
      for(int j=0;j<8;++j){const float x=__uint_as_float(((unsigned)(unsigned short)qr[d0][j])<<16); v[8*d0+j]=x; ss+=x*x;}
    {auto rr=__builtin_amdgcn_permlane32_swap(__float_as_uint(ss),__float_as_uint(ss),false,false); ss=__uint_as_float(rr[0])+__uint_as_float(rr[1]);}
    const float rn=rsqrtf(ss*(1.f/64.f)+EPS);
    #pragma unroll
    for(int d0=0;d0<4;++d0){const float4 g0=*(const float4*)(qgain+16*d0+8*hi),g1=*(const float4*)(qgain+16*d0+8*hi+4);
      v[8*d0+0]=v[8*d0+0]*rn*g0.x;v[8*d0+1]=v[8*d0+1]*rn*g0.y;v[8*d0+2]=v[8*d0+2]*rn*g0.z;v[8*d0+3]=v[8*d0+3]*rn*g0.w;
      v[8*d0+4]=v[8*d0+4]*rn*g1.x;v[8*d0+5]=v[8*d0+5]*rn*g1.y;v[8*d0+6]=v[8*d0+6]*rn*g1.z;v[8*d0+7]=v[8*d0+7]*rn*g1.w;}
    if(qmode==1){const int tq=tq0+wid*QBLK+r32; const float pr=(float)(tq/64),pc=(float)(tq%64);
      #pragma unroll
      for(int j=0;j<8;++j){const float inv=exp2f(-(float)(8*hi+j)*0.8304820237218406f);
        {float cs,sn;sincos_small(pr*inv,sn,cs);const float x1=v[j],x2=v[8+j];v[j]=x1*cs-x2*sn;v[8+j]=x1*sn+x2*cs;}
        {float cs,sn;sincos_small(pc*inv,sn,cs);const float x1=v[16+j],x2=v[24+j];v[16+j]=x1*cs-x2*sn;v[24+j]=x1*sn+x2*cs;}}}
    #pragma unroll
    for(int d0=0;d0<4;++d0)
      #pragma unroll
      for(int j=0;j<8;++j)qr[d0][j]=(short)f2bf(v[8*d0+j]*C2);
  }
  float mhat=0.f,l_reg=0.f;f32x16 o[2];o[0]=f32x16{};o[1]=f32x16{};f32x16 negm=f32x16{};asm volatile("":"+v"(negm));
  const int na_qr=na.R0+(wid>>1), na_rsq=min(max(na_qr-4,0),56), na_qc=(wid&1)*32+r32, na_cs=min(max(na_qc-8,0),48);
  unsigned na_w0=0u,na_w1=0u;
  if(NA){
    #pragma unroll
    for(int r=0;r<16;++r){const int kv=(r&3)+8*(r>>2)+4*hi; if((unsigned)(kv-na_cs)<16u)na_w0|=1u<<r; if((unsigned)(kv+32-na_cs)<16u)na_w1|=1u<<r;}
    const float*gt=na.natab; float*lt=(float*)(shm+LDS_BYTES)+64;
    for(int i=tid;i<15*31;i+=NW*64)lt[i]=gt[i]*1.4426950408889634f;
  }
  const float*na_tb=(const float*)(shm+LDS_BYTES)+64+(15-na_qc)+4*hi;
  #define CMASK(P0,P1,t) do{ if(NA&&(t)>=4){ const int kr_=na.rs0+(t)-4; const float rowneg_=((unsigned)(kr_-na_rsq)>=8u)?-INFINITY:0.f;     \
      const float*tb_=na_tb+min(max(kr_-na_qr+7,0),14)*31; int d0_=4*hi-na_cs; asm volatile("":"+v"(d0_));   \
      _Pragma("unroll") for(int r=0;r<16;++r){ const int c_=(r&3)+8*(r>>2); const float b0_=tb_[c_]+rowneg_,b1_=tb_[32+c_]+rowneg_; \
        P0[r]=((unsigned)(d0_+c_)<16u)?P0[r]+b0_:-INFINITY; P1[r]=((unsigned)(d0_+c_+32)<16u)?P1[r]+b1_:-INFINITY; } } }while(0)
  bool resc=false;
  #define START(P0,P1) do{ const float rm=rowmax(P0,P1); resc=false; \
    { const float dl=rm; mhat=fadd_s(mhat,dl); \
      _Pragma("unroll") for(int r=0;r<16;++r){P0[r]=fsub_s(P0[r],dl);P1[r]=fsub_s(P1[r],dl);} \
      _Pragma("unroll") for(int r=0;r<16;++r)negm[r]=-mhat; asm volatile("":"+v"(negm)); } \
    _Pragma("unroll") for(int r=0;r<16;++r)P0[r]=__builtin_amdgcn_exp2f(P0[r]); }while(0)
  #define RESC() do{ if(resc){ asm volatile("s_waitcnt lgkmcnt(0)":::"memory"); \
      _Pragma("unroll") for(int d_=0;d_<2;++d_) _Pragma("unroll") for(int r=0;r<16;++r)o[d_][r]*=wsf[crow(r,hi)]; } }while(0)
  f32x16 pA0,pA1,pB0,pB1;
  int sl_prev=0,sl_cur=0,sl_next=SLOTB;
  #define ROT() do{sl_prev=sl_cur;sl_cur=sl_next;sl_next=(sl_next==(NSLOT-1)*SLOTB)?0:sl_next+SLOTB;}while(0)
  DMA_K(2,2*SLOTB);
  WAIT_BAR(3);
  qkt(pA0,pA1,Kbase,qr,negm,r32,hi);asm volatile("s_nop 15\n\ts_nop 7":"+v"(pA0),"+v"(pA1));CMASK(pA0,pA1,0);
  START(pA0,pA1);
  _Pragma("unroll") for(int r=0;r<16;++r)pA1[r]=__builtin_amdgcn_exp2f(pA1[r]);
  WAIT_BAR(0);
  DMA_K(3,0);DMA_V(1,SLOTB);
  ROT();
  kload8(kf,kp0+sl_cur);
  WAIT_BAR(2);
  s16x4 vlo[8],vhi[8]; u32x4 pw0,pw1,pw2,pw3;
  #define PKW(P,B) cvtpk_s(P[B],P[B+1])
  #define PAF(k) __builtin_bit_cast(bf16x8,pw##k)
  #define VFR(i) (bf16x8){vlo[i][0],vlo[i][1],vlo[i][2],vlo[i][3],vhi[i][0],vhi[i][1],vhi[i][2],vhi[i][3]}
  #define PIN(x) asm volatile("":"+v"(x))
  #define MX3(a,b,c) __builtin_fmaxf(__builtin_fmaxf((a),(b)),(c))
  #define GAPA(MF,A0,A1,A2,A3,W0,W1,PW) do{ MF; sacc+=A0; sacc+=A1; sacc+=A2; sacc+=A3; PIN(sacc); W0; W1; PIN(PW); SBAR(); }while(0)
  #define EX(v) __builtin_amdgcn_exp2f(v)
  #define GAPB(MF,X,B) do{ MF; X[B]=EX(X[B]); X[B+1]=EX(X[B+1]); X[B+2]=EX(X[B+2]); X[B+3]=EX(X[B+3]); PIN(X); SBAR(); }while(0)
  #define VRD(i) do{ vlo[i]=vtr(vp_+(((i)>>2)*4096+((i)&3)*1024)); vhi[i]=vtr(vp_+(((i)>>2)*4096+((i)&3)*1024+512)); }while(0)
  #define KRD(G,j) do{ if(G){ kload2(kf,kp0+sl_next,j); SBAR(); } }while(0)
  #define STEP(C0,C1,P0,P1,t,GK,GV,GL) do{ SBAR(); \
    const lds_cptr vp_=vp0+sl_prev; \
    VRD(0); SBAR(); float sacc=(P0[0]+P0[1]); \
    GAPA(C0=__builtin_amdgcn_mfma_f32_32x32x16_bf16(kf[0],qr[0],negm,0,0,0), P0[2],P0[3],P0[4],P0[5],     pw0[0]=PKW(P0,0), pw0[1]=PKW(P0,2), pw0); \
    VRD(4); SBAR(); GAPA(C1=__builtin_amdgcn_mfma_f32_32x32x16_bf16(kf[1],qr[0],negm,0,0,0), P0[6],P0[7],P0[8],P0[9],     pw0[2]=PKW(P0,4), pw0[3]=PKW(P0,6), pw0); \
    VRD(1); SBAR(); GAPA(C0=__builtin_amdgcn_mfma_f32_32x32x16_bf16(kf[2],qr[1],C0,0,0,0),   P0[10],P0[11],P0[12],P0[13], pw1[0]=PKW(P0,8), pw1[1]=PKW(P0,10), pw1); \
    VRD(5); SBAR(); GAPA(C1=__builtin_amdgcn_mfma_f32_32x32x16_bf16(kf[3],qr[1],C1,0,0,0),   P0[14],P0[15],P1[0],P1[1],   pw1[2]=PKW(P0,12),pw1[3]=PKW(P0,14), pw1); \
    VRD(2); SBAR(); GAPA(C0=__builtin_amdgcn_mfma_f32_32x32x16_bf16(kf[4],qr[2],C0,0,0,0),   P1[2],P1[3],P1[4],P1[5],     pw2[0]=PKW(P1,0), pw2[1]=PKW(P1,2), pw2); \
    VRD(6); SBAR(); GAPA(C1=__builtin_amdgcn_mfma_f32_32x32x16_bf16(kf[5],qr[2],C1,0,0,0),   P1[6],P1[7],P1[8],P1[9],     pw2[2]=PKW(P1,4), pw2[3]=PKW(P1,6), pw2); \
    VRD(3); SBAR(); GAPA(C0=__builtin_amdgcn_mfma_f32_32x32x16_bf16(kf[6],qr[3],C0,0,0,0),   P1[10],P1[11],P1[12],P1[13], pw3[0]=PKW(P1,8), pw3[1]=PKW(P1,10), pw3); \
    VRD(7); SBAR(); GAPA(C1=__builtin_amdgcn_mfma_f32_32x32x16_bf16(kf[7],qr[3],C1,0,0,0),   P1[14],P1[15],0.f,0.f,       pw3[2]=PKW(P1,12),pw3[3]=PKW(P1,14), pw3); \
    l_reg+=sacc; \
    if(GK){DMA_K((t)+3,sl_cur);} if(GV){DMA_V((t)+1,sl_next);} \
    CMASK(C0,C1,t); \
    { float a=MX3(C0[0],C0[1],C1[0]),b=MX3(C0[2],C0[3],C1[1]); a=MX3(a,C1[2],C1[3]); \
      _Pragma("unroll") for(int r=4;r<16;r+=4){a=MX3(a,C0[r],C0[r+1]);b=MX3(b,C0[r+2],C0[r+3]);a=MX3(a,C1[r],C1[r+1]);b=MX3(b,C1[r+2],C1[r+3]);} \
      float rm=__builtin_fmaxf(a,b); { auto rr=__builtin_amdgcn_permlane32_swap(__float_as_uint(rm),__float_as_uint(rm),false,false); rm=__builtin_fmaxf(__uint_as_float(rr[0]),__uint_as_float(rr[1])); } \
      resc=false; \
      if(__builtin_expect(__any(rm>(float)THRL),0)){ const float dl=__builtin_fmaxf(rm,0.f); mhat+=dl; \
        _Pragma("unroll") for(int r=0;r<16;++r){C0[r]-=dl;C1[r]-=dl;} \
        _Pragma("unroll") for(int r=0;r<16;++r)negm[r]=-mhat; asm volatile("":"+v"(negm)); \
        const float f=__builtin_amdgcn_exp2f(-dl); l_reg*=f; if(hi==0)wsf[r32]=f; resc=true; } } \
    SBAR(); \
    GAPB(o[0]=__builtin_amdgcn_mfma_f32_32x32x16_bf16(PAF(0),VFR(0),o[0],0,0,0), C0,0); \
    GAPB(o[1]=__builtin_amdgcn_mfma_f32_32x32x16_bf16(PAF(0),VFR(4),o[1],0,0,0), C0,4); \
    KRD(GL,0); GAPB(o[0]=__builtin_amdgcn_mfma_f32_32x32x16_bf16(PAF(1),VFR(1),o[0],0,0,0), C0,8); \
    KRD(GL,1); GAPB(o[1]=__builtin_amdgcn_mfma_f32_32x32x16_bf16(PAF(1),VFR(5),o[1],0,0,0), C0,12); \
    KRD(GL,2); GAPB(o[0]=__builtin_amdgcn_mfma_f32_32x32x16_bf16(PAF(2),VFR(2),o[0],0,0,0), C1,0); \
    KRD(GL,3); GAPB(o[1]=__builtin_amdgcn_mfma_f32_32x32x16_bf16(PAF(2),VFR(6),o[1],0,0,0), C1,4); \
    GAPB(o[0]=__builtin_amdgcn_mfma_f32_32x32x16_bf16(PAF(3),VFR(3),o[0],0,0,0), C1,8); \
    GAPB(o[1]=__builtin_amdgcn_mfma_f32_32x32x16_bf16(PAF(3),VFR(7),o[1],0,0,0), C1,12); \
    }while(0)
  int t=1;
  for(;t+5<NT;t+=2){
    STEP(pB0,pB1,pA0,pA1,t,true,true,true);     WAIT_BAR(2); RESC(); ROT();
    STEP(pA0,pA1,pB0,pB1,t+1,true,true,true);   WAIT_BAR(2); RESC(); ROT();
  }
  #define ENDW(tt) do{ if((tt)+3<NT){WAIT_BAR(2);} else if((tt)+2<NT){WAIT_BAR(1);} else {WAIT_BAR(0);} }while(0)
  for(;t+1<NT;t+=2){
    STEP(pB0,pB1,pA0,pA1,t,(t+3<NT),(t+1<NT),(t+1<NT));       ENDW(t);   RESC(); ROT();
    STEP(pA0,pA1,pB0,pB1,t+1,(t+4<NT),(t+2<NT),(t+2<NT));     ENDW(t+1); RESC(); ROT();
  }
  STEP(pB0,pB1,pA0,pA1,NT-1,false,false,false); RESC();
  { float sacc=pB0[0]+pB0[1]; _Pragma("unroll") for(int r=2;r<16;++r)sacc+=pB0[r]; _Pragma("unroll") for(int r=0;r<16;++r)sacc+=pB1[r]; l_reg+=sacc;
    pw0=(u32x4){PKW(pB0,0),PKW(pB0,2),PKW(pB0,4),PKW(pB0,6)};pw1=(u32x4){PKW(pB0,8),PKW(pB0,10),PKW(pB0,12),PKW(pB0,14)};pw2=(u32x4){PKW(pB1,0),PKW(pB1,2),PKW(pB1,4),PKW(pB1,6)};pw3=(u32x4){PKW(pB1,8),PKW(pB1,10),PKW(pB1,12),PKW(pB1,14)};
    SBAR(); pv(o,vb0+sl_cur,PAF(0),PAF(1),PAF(2),PAF(3)); }
  #undef PKW
  #undef PAF
  #undef VFR
  #undef PIN
  #undef MX3
  #undef GAPA
  #undef GAPB
  #undef EX
  #undef VRD
  #undef KRD
  #undef STEP
  #undef ENDW
  {auto rr=__builtin_amdgcn_permlane32_swap(__float_as_uint(l_reg),__float_as_uint(l_reg),false,false);l_reg=__uint_as_float(rr[0])+__uint_as_float(rr[1]);}
  if(hi==0)wsf[32+r32]=l_reg;asm volatile("s_waitcnt lgkmcnt(0)":::"memory");
  float rli[16];
  #pragma unroll
  for(int r=0;r<16;++r)rli[r]=__builtin_amdgcn_rcpf(wsf[32+crow(r,hi)]);
  bf16*Ow=Ow0+(long)(wid*QBLK)*OP;
  { bf16*stg=(bf16*)(shm+LDS_OST)+wid*2048;
    #pragma unroll
    for(int r=0;r<16;++r){const int orow=crow(r,hi);
      #pragma unroll
      for(int d0=0;d0<2;++d0)stg[orow*64+d0*32+r32]=__float2bfloat16(o[d0][r]*rli[r]);}
    asm volatile("s_waitcnt lgkmcnt(0)":::"memory");
    #pragma unroll
    for(int i=0;i<4;++i){const int row=i*8+(lane>>3),ch=lane&7; const u32x4 v=*(const u32x4*)(stg+row*64+ch*8); ATTN_STORE16(Ow+(long)row*OP+ch*8,v);} }
  __builtin_amdgcn_s_setprio(0);
  asm volatile("s_waitcnt lgkmcnt(0)\n\ts_barrier":::"memory");
  #undef DMA_K
  #undef DMA_V
  #undef TROW
  #undef CMASK
  #undef START
  #undef RESC
  #undef ROT
}
constexpr int ATTN_LDS_BYTES=LDS_BYTES+(64+15*31+64+3)/4*4*4;
#undef SBAR
#undef WAIT_BAR
}
#ifndef MK_PHMASK
#define MK_PHMASK 0xffffffff
#endif
#ifndef MK_REPEAT
#define MK_REPEAT 0
#endif
#define REPS(b) for (int rep_ = 0; rep_ < 1 + ((MK_REPEAT >> (b)) & 1); ++rep_)
constexpr int NWAVES = 8;
constexpr int RING_BYTES = 131072, LDSCTL_OFF = RING_BYTES, MISC_OFF = LDSCTL_OFF + 320, EOFF_OFF = LDSCTL_OFF + 1024, HIST_OFF = LDSCTL_OFF + 1280, SC_PART_OFF = LDSCTL_OFF + 1536,
              SC_TOT_OFF = LDSCTL_OFF + 5632, SC_BASE_OFF = LDSCTL_OFF + 5760, SC_EOFF_OFF = LDSCTL_OFF + 5888, SC_WCNT_OFF = LDSCTL_OFF + 6144, SC_SLOT_OFF = LDSCTL_OFF + 8192, PTAB_OFF = LDSCTL_OFF + 512, GTAB_OFF = LDSCTL_OFF + 12288, LBIAS_OFF = LDSCTL_OFF + 14336, LDS_BYTES = 147456;
enum { PH_PRE0 = 0, PH_PRE1 = 1, PH_L0 = 2, PHL_INPROJ = 0, PHL_MIX1 = 1, PHL_MIX2 = 2, PHL_MERGE = 3, PHL_OUT = 4, PHL_ROUTE = 5, PHL_SCAN = 6, PHL_GEMM1 = 7, PHL_GEMM2 = 8, PHL_COMB = 9, PHL_N = 10, PH_END = PH_L0 + 2 * PHL_N };
struct MkArgs { Ptrs p; int ph_lo, ph_hi; };

__device__ __forceinline__ void cvt_item(const float* W, int K, int N, bf16_t* WT, bool deint, LAS float* scr, int item, int lane) {
    const int nblk = N / 32, kb = item / nblk, nb = item % nblk, k0 = 64 * kb, n0 = 32 * nb;
#pragma unroll 8
    for (int i = 0; i < 32; ++i) { const int kk = 2 * i + (lane >> 5); scr[kk * 33 + (lane & 31)] = W[(size_t)(k0 + kk) * N + n0 + (lane & 31)]; }
    asm volatile("s_waitcnt lgkmcnt(0)" ::: "memory");
    const int c = lane & 7;
#pragma unroll
    for (int j = 0; j < 4; ++j) { const int n = (lane >> 3) + 8 * j; const LAS float* s = scr + (8 * c) * 33 + n;
        pg8::u32x4 o; o.x = pk2(s[0 * 33], s[1 * 33]); o.y = pk2(s[2 * 33], s[3 * 33]); o.z = pk2(s[4 * 33], s[5 * 33]); o.w = pk2(s[6 * 33], s[7 * 33]);
        const int no = n0 + n, nd = deint ? ((no & ~7) | ((no & 1) << 2) | ((no & 7) >> 1)) : no;
        *(pg8::u32x4*)(WT + (size_t)nd * K + k0 + 8 * c) = o; }
    asm volatile("s_waitcnt lgkmcnt(0)" ::: "memory");
}

__device__ __forceinline__ void cvt_item_fp8(const float* W, int K, int N, unsigned char* WT, bool deint, LAS float* scr, int item, int lane) {
    const int nblk = N / 32, kb = item / nblk, nb = item % nblk, k0 = 64 * kb, n0 = 32 * nb;
#pragma unroll 8
    for (int i = 0; i < 32; ++i) { const int kk = 2 * i + (lane >> 5); scr[kk * 33 + (lane & 31)] = W[(size_t)(k0 + kk) * N + n0 + (lane & 31)]; }
    asm volatile("s_waitcnt lgkmcnt(0)" ::: "memory");
    const int c = lane & 7;
#pragma unroll
    for (int j = 0; j < 4; ++j) { const int n = (lane >> 3) + 8 * j; const LAS float* s = scr + (8 * c) * 33 + n;
        int lo = __builtin_amdgcn_cvt_pk_fp8_f32(64.f * s[0 * 33], 64.f * s[1 * 33], 0, false); lo = __builtin_amdgcn_cvt_pk_fp8_f32(64.f * s[2 * 33], 64.f * s[3 * 33], lo, true);
        int hi = __builtin_amdgcn_cvt_pk_fp8_f32(64.f * s[4 * 33], 64.f * s[5 * 33], 0, false); hi = __builtin_amdgcn_cvt_pk_fp8_f32(64.f * s[6 * 33], 64.f * s[7 * 33], hi, true);
        const int no = n0 + n, nd = deint ? ((no & ~7) | ((no & 1) << 2) | ((no & 7) >> 1)) : no;
        *(pg8::u32x2*)(WT + (size_t)nd * K + k0 + 8 * c) = (pg8::u32x2){(unsigned)lo, (unsigned)hi}; }
    asm volatile("s_waitcnt lgkmcnt(0)" ::: "memory");
}

struct CvtJob { const float* W; unsigned char* WT; int K, N, item, mode, ldw; };
__device__ __forceinline__ void cvt_load(const CvtJob& j, int lane, float4 (&wv)[8]) {
    const int nblk = j.N / 32, kb = j.item / nblk, nb = j.item % nblk, k0 = 64 * kb, n0 = 32 * nb;
    const char* base = (const char*)(j.W + (size_t)k0 * j.ldw + n0);
    const unsigned loff = (unsigned)(((lane >> 3) * j.ldw + 4 * (lane & 7)) * 4);
#pragma unroll
    for (int i = 0; i < 8; ++i) { const unsigned long long bi = (unsigned long long)base + (unsigned long long)(8 * i) * (unsigned)j.ldw * 4ull;
        const GAS char* sb = (const GAS char*)(((unsigned long long)(unsigned)__builtin_amdgcn_readfirstlane((int)(bi >> 32)) << 32) | (unsigned)__builtin_amdgcn_readfirstlane((int)bi));
        const pg8::f32x4 t4 = *(const GAS pg8::f32x4*)(sb + loff); wv[i] = make_float4(t4.x, t4.y, t4.z, t4.w); }
}
__device__ __forceinline__ void cvt_finish(const CvtJob& j, const float4 (&wv)[8], LAS float* scr, int lane, bool st = true) {
    const int nblk = j.N / 32, kb = j.item / nblk, nb = j.item % nblk, k0 = 64 * kb, n0 = 32 * nb;
#pragma unroll
    for (int i = 0; i < 8; ++i) { LAS float* d = scr + (8 * i + (lane >> 3)) * 33 + 4 * (lane & 7); d[0] = wv[i].x; d[1] = wv[i].y; d[2] = wv[i].z; d[3] = wv[i].w; }
    asm volatile("s_waitcnt lgkmcnt(0)" ::: "memory");
    const int c = lane & 7;
    if (j.mode == 0) {
        asm volatile("" ::: "memory");
#pragma unroll
        for (int jj = 0; jj < 4; ++jj) { const int n = (lane >> 3) + 8 * jj; const LAS float* s = scr + (8 * c) * 33 + n; const int nd = n0 + n;
            pg8::u32x4 o; o.x = pg8::cvt_pk_bf16(s[0 * 33], s[1 * 33]); o.y = pg8::cvt_pk_bf16(s[2 * 33], s[3 * 33]); o.z = pg8::cvt_pk_bf16(s[4 * 33], s[5 * 33]); o.w = pg8::cvt_pk_bf16(s[6 * 33], s[7 * 33]);
            if (st || o.x == 0x12345u) *(pg8::u32x4*)((bf16_t*)j.WT + (size_t)nd * j.K + k0 + 8 * c) = o; }
    } else {
        asm volatile("" ::: "memory");
#pragma unroll
        for (int jj = 0; jj < 4; ++jj) { const int n = (lane >> 3) + 8 * jj; const LAS float* s = scr + (8 * c) * 33 + n;
            const int no = n0 + n, nd = j.mode == 2 ? ((no & ~7) | ((no & 1) << 2) | ((no & 7) >> 1)) : no;
            int lo = __builtin_amdgcn_cvt_pk_fp8_f32(64.f * s[0 * 33], 64.f * s[1 * 33], 0, false); lo = __builtin_amdgcn_cvt_pk_fp8_f32(64.f * s[2 * 33], 64.f * s[3 * 33], lo, true);
            int hi = __builtin_amdgcn_cvt_pk_fp8_f32(64.f * s[4 * 33], 64.f * s[5 * 33], 0, false); hi = __builtin_amdgcn_cvt_pk_fp8_f32(64.f * s[6 * 33], 64.f * s[7 * 33], hi, true);
            if (st || lo == 0x12345) *(pg8::u32x2*)(j.WT + (size_t)nd * j.K + k0 + 8 * c) = (pg8::u32x2){(unsigned)lo, (unsigned)hi}; }
    }
    asm volatile("s_waitcnt lgkmcnt(0)" ::: "memory");
}

__global__ void __launch_bounds__(NWAVES * 64, 2) mk_fwd(MkArgs args) {
    extern __shared__ __attribute__((aligned(16))) unsigned char lds_raw[];
    LAS unsigned char* lds = (LAS unsigned char*)lds_raw;
    volatile LAS unsigned* MISC = (volatile LAS unsigned*)(lds + MISC_OFF);
    const Ptrs& p = args.p; unsigned char* const ws0_ = p.ws;
    const int G = gridDim.x, bx = blockIdx.x, wv_ = __builtin_amdgcn_readfirstlane((int)threadIdx.x >> 6);
    { const int tid0 = threadIdx.x; for (int u = tid0; u < (LDS_BYTES - LDSCTL_OFF) / 4; u += NWAVES * 64) ((LAS unsigned*)(lds + LDSCTL_OFF))[u] = 0u;
 }
    __syncthreads();
    const int lo = args.ph_lo, hi = args.ph_hi;
    unsigned* const barw = (unsigned*)(ws0_ + WS_CTL) + CW_BAR;
    XcdBarrier bar; bar.bar = barw; bar.x = 0; bar.st = nullptr;
    if (hi - lo > 1) bar = xcd_barrier_post(barw, MISC + 8);
#define IN(k) (lo <= (k) && (k) < hi)
#define SEAM(k) do { if (IN(k) && IN((k) + 1)) { xcd_barrier(bar, wv_); if ((MK_REPEAT >> 13) & 1) xcd_barrier(bar, wv_); } } while (0)
#define PHASE_WS unsigned long long wsa_ = (unsigned long long)ws0_; asm volatile("" : "+s"(wsa_)); unsigned char* const ws = (unsigned char*)(GAS unsigned char*)wsa_
#define PHASE_IDS PHASE_WS; const int tid = opaque_tid(wv_), lane = tid & 63, wave = __builtin_amdgcn_readfirstlane(tid >> 6), gw = bx * NWAVES + wave, NGW = G * NWAVES; (void)lane; (void)gw; (void)NGW

    if (IN(PH_PRE0) && (MK_PHMASK & 1)) {
        PHASE_IDS;
        LAS float* scr = (LAS float*)(lds + wave * 8448); LAS float* sil = (LAS float*)(lds + 8 * 8448);
        constexpr int I_MOD = 2 * (MODW / 32);
        if (bx * NWAVES < I_MOD) { for (int i = tid; i < 9 * D; i += NWAVES * 64) { const int r = i >> 10, k = i & 1023; const float v = r < 8 ? p.c[r * D + k] : p.c_ctx[k]; sil[i] = v / (1.f + expf(-v)); } }
        __syncthreads();
        constexpr int I_INB = (D / 64) * (IP_S * 8), I_IN8 = (D / 64) * ((27 - IP_S) * 8), I_BR = (512 / 64) * (D / 32), I_OUT = (D / 64) * (D / 32), I_GU = (D / 64) * (2048 / 32), I_DN = (D / 64) * (D / 32);
        constexpr int T_INB = 2 * I_INB, T_IN8 = 2 * I_IN8, T_BR = 6 * I_BR, T_OUT = 2 * I_OUT, T_GU = 64 * I_GU, T_DN = 64 * I_DN, NITEMS = I_MOD + T_INB + T_IN8 + T_BR + T_OUT + T_GU + T_DN;
        auto decode = [&](int r) -> CvtJob {
            if (r < T_INB) { const int l = r / (I_INB > 0 ? I_INB : 1); return CvtJob{p.w_in + (size_t)l * D * INC, ws + WS_WIN + (size_t)l * INC * D * 2, D, IP_S * 256, r % (I_INB > 0 ? I_INB : 1), 0, INC}; } r -= T_INB;
            if (r < T_IN8) { const int l = r / (I_IN8 > 0 ? I_IN8 : 1); return CvtJob{p.w_in + (size_t)l * D * INC + IP_S * 256, ws + WS_WIN8 + ((size_t)l * INC + IP_S * 256) * D, D, (27 - IP_S) * 256, r % (I_IN8 > 0 ? I_IN8 : 1), 1, INC}; } r -= T_IN8;
            if (r < T_BR) { const int q = r / I_BR, l = q / 3, br = q % 3; const float* src = (br == 0 ? p.w_br_conv : br == 1 ? p.w_br_na : p.w_br_gqa) + (size_t)l * 512 * D;
                return CvtJob{src, ws + WS_WMG + (size_t)q * D * 512 * 2, 512, D, r % I_BR, 0, D}; } r -= T_BR;
            if (r < T_OUT) { const int l = r / I_OUT; return CvtJob{p.w_out + (size_t)l * D * D, ws + WS_WOUT + (size_t)l * D * D * 2, D, D, r % I_OUT, 0, D}; } r -= T_OUT;
            if (r < T_GU) { const int q = r / I_GU; return CvtJob{p.w_gu + (size_t)q * D * 2048, ws + WS_WGU + (size_t)q * 2048 * D, D, 2048, r % I_GU, 2, 2048}; } r -= T_GU;
            const int q = r / I_DN; return CvtJob{p.w_down + (size_t)q * D * D, ws + WS_WDN + (size_t)q * D * D, D, D, r % I_DN, 1, D}; };
        REPS(0) { int it = gw; const bool st_ = !(((MK_REPEAT >> 20) & 1) && rep_ == 1);
            if (it < I_MOD) { if (!(((MK_REPEAT >> 21) & 1) && rep_ == 1)) mod_item(p, it, lane, sil); it += NGW; }
            if (it < NITEMS) {
                auto J = [&](int x) -> CvtJob { return decode(min(x, NITEMS - 1) - I_MOD); };
                CvtJob ja = J(it), jb = J(it + NGW), jc = ja; float4 wa[8], wb[8], wc[8];
                cvt_load(ja, lane, wa); cvt_load(jb, lane, wb);
                for (;;) {
                    jc = J(it + 2 * NGW); cvt_load(jc, lane, wc); cvt_finish(ja, wa, scr, lane, st_); it += NGW; if (it >= NITEMS) break;
                    ja = J(it + 2 * NGW); cvt_load(ja, lane, wa); cvt_finish(jb, wb, scr, lane, st_); it += NGW; if (it >= NITEMS) break;
                    jb = J(it + 2 * NGW); cvt_load(jb, lane, wb); cvt_finish(jc, wc, scr, lane, st_); it += NGW; if (it >= NITEMS) break;
                } } }
        for (int i = bx * 512 + tid; i < 2 * NE * D; i += G * 512) { const int ll = i >> 15, e = (i >> 10) & 31, k = i & 1023; ((_Float16*)(ws + WS_WRT))[i] = (_Float16)p.router_w[(size_t)ll * D * NE + k * NE + e]; }
        for (int i = bx * 512 + tid; i < 2 * NE * 2048; i += G * 512) { const int no = i & 2047, nd = (no & ~7) | ((no & 1) << 2) | ((no & 7) >> 1); ((float*)(ws + WS_BGU))[(i & ~2047) + nd] = p.b_gu[i]; }
        __syncthreads();
    }
    SEAM(PH_PRE0);
    if (IN(PH_PRE1) && (MK_PHMASK & 1)) {
        PHASE_IDS;
        REPS(12) for (int rowb = gw; rowb < NTOK; rowb += 4 * NGW) {
            float4 v[4][4];
#pragma unroll
            for (int q = 0; q < 4; ++q) { const int row = rowb + q * NGW; if (row < NTOK) { const float4* xr = (const float4*)(row < NLAT ? p.x + (size_t)row * D : p.ctx + (size_t)(row - NLAT) * D);
#pragma unroll
                for (int i = 0; i < 4; ++i) v[q][i] = xr[lane + 64 * i]; } }
#pragma unroll
            for (int q = 0; q < 4; ++q) { const int row = rowb + q * NGW; if (row < NTOK) { float ss = 0.f;
#pragma unroll
                for (int i = 0; i < 4; ++i) ss += v[q][i].x * v[q][i].x + v[q][i].y * v[q][i].y + v[q][i].z * v[q][i].z + v[q][i].w * v[q][i].w;
                const float r = rsqrtf(wave_sum(ss, lane) * (1.f / D) + EPS);
                { uint2* xo = (uint2*)((bf16_t*)(ws + WS_X) + (size_t)row * D);
#pragma unroll
                  for (int i = 0; i < 4; ++i) xo[lane + 64 * i] = make_uint2(pk2(v[q][i].x, v[q][i].y), pk2(v[q][i].z, v[q][i].w)); }
                norm_mod_store(v[q], r, p.norm1_g, (const float*)(ws + WS_MOD) + (size_t)mod_row(row) * MODW, ws, row, lane); } }
        }
    }
    SEAM(PH_PRE1);
#pragma unroll 1
    for (int l = 0; l < 2; ++l) {
        const int pb = PH_L0 + l * PHL_N; const bool lastl = (l == 1); const int nrows = lastl ? NLAT : NTOK;
        if (IN(pb + PHL_INPROJ) && (MK_PHMASK & 2)) {
            PHASE_WS;
            pg8::EpiStoreBf16<false> E{(bf16_t*)(ws + WS_P), INC, nullptr, 0, ATT_C2, O_NAQ / 256, O_NAK / 256, O_BGC / 256};
            constexpr int NB16 = IP_S, N8 = 27 - IP_S;
            const int t16 = lastl ? (NLAT / 256) * NB16 + (NCTX / 256) * pg8::SchedInprojR::nkv(0, NB16) : (NTOK / 256) * NB16;
            const int t8 = lastl ? (NLAT / 256) * N8 + (NCTX / 256) * pg8::SchedInprojR::nkv(NB16, N8) : (NTOK / 256) * N8;
            const int cmin = t16 % G, nf0 = t8 / G - (cmin > 0 ? 1 : 0), nfull = nf0 > 0 ? nf0 : 0;
            if (NB16 > 0) { pg8::SchedInprojR S{(const char*)(ws + WS_H), (const char*)(ws + WS_WIN) + (size_t)l * INC * D * 2, 0, NB16, G, bx, D * 2, lastl, 1 << 30, 0};
                REPS(1) pg8::gemm_phase<pg8::EpiStoreBf16<false>, pg8::SchedInprojR, true, true>(lds, pg8::Gemm{D * 2, D * 2, D * 2, 0, 0}, S, E, wv_); }
            if (N8 > 0) { pg8::SchedInprojR S{(const char*)(ws + WS_H8), (const char*)(ws + WS_WIN8) + (size_t)l * INC * D, NB16, N8, G, bx, D, lastl, nfull, cmin};
                REPS(1) pg8::gemm_phase<pg8::EpiStoreBf16<false>, pg8::SchedInprojR, true, true, true>(lds, pg8::Gemm{D, D, D, 0x7f7f7f7f, 0x79797979}, S, E, wv_); }
        }
        SEAM(pb + PHL_INPROJ);
        if (IN(pb + PHL_MIX1) && (MK_PHMASK & 64)) {
            PHASE_IDS;
            REPS(9) for (int i = bx * 512 + tid; i < nrows * 16; i += G * 512) conv_item4(p, l, i);
            REPS(9) for (int i = bx * 512 + tid; i < NTOK * 2; i += G * 512) kprep_item(p, l, i);
            __syncthreads();
            typedef attn_body::bf16 abf;
            const abf* Pq = (const abf*)(ws + WS_P); abf* Yo = (abf*)(ws + WS_Y);
            REPS(2) { const int b = bx & 7, j = bx >> 3;
#pragma unroll 1
                for (int i = 0; i < 4; ++i) { const int u = j * 4 + i, h = u >> 4, R0 = (u & 15) * 4; const size_t row0 = (size_t)b * SEQ + R0 * 64;
                    const int rs0 = min(max(R0 - 4, 0), 56), rlast = min(max(R0 - 1, 0), 56) + 7; int NT = 4 + (rlast - rs0 + 1); NT += NT & 1;
                    const attn_body::NaArgs na{(long)NLAT + (long)b * CTXL, (long)b * SEQ + (long)rs0 * 64, R0, rs0, p.na_rpb + ((size_t)l * 8 + h) * 465};
                    attn_body::attn_unit<8, true>(Pq + row0 * INC + O_NAQ + h * 64, INC, Pq + O_NAK + h * 64, INC, Pq + O_NAV + h * 64, INC, Yo + row0 * 1536 + 512 + h * 64, 1536, NT, (char*)lds_raw, na, wv_); } }
        }
        SEAM(pb + PHL_MIX1);
        if (IN(pb + PHL_MIX2) && (MK_PHMASK & 128)) {
            PHASE_WS;
            typedef attn_body::bf16 abf;
            const abf* Pq = (const abf*)(ws + WS_P); const abf* Kg = (const abf*)(ws + WS_KG); const abf* Vg = (const abf*)(ws + WS_VG); abf* Yo = (abf*)(ws + WS_Y);
            REPS(3) { const int b = bx & 7, j = bx >> 3;
#pragma unroll 1
                for (int i = 0; i < 4; ++i) { const int u = j * 4 + i, h = u >> 4, qb = u & 15; const size_t row0 = (size_t)b * SEQ + qb * 256;
                    attn_body::attn_unit<8, false>(Pq + row0 * INC + O_GQ + h * 64, INC, Kg + ((size_t)b * KVLEN * 2 + (h >> 2)) * 64, 128, Vg + ((size_t)b * KVLEN * 2 + (h >> 2)) * 64, 128,
                                            Yo + row0 * 1536 + 1024 + h * 64, 1536, KVLEN / 64, (char*)lds_raw, attn_body::NaArgs{}, wv_, 1, p.q_norm_g + l * 64, qb * 256); } }
            if (!lastl && bx < 128) {
                const int kind = bx >> 6, b = (bx >> 3) & 7, h = bx & 7; const size_t row0 = (size_t)NLAT + (size_t)b * CTXL;
                if (kind == 0) attn_body::attn_unit<8, false>(Pq + row0 * INC + O_GQ + h * 64, INC, Kg + (((size_t)b * KVLEN + SEQ) * 2 + (h >> 2)) * 64, 128, Vg + (((size_t)b * KVLEN + SEQ) * 2 + (h >> 2)) * 64, 128,
                                                       Yo + row0 * 1536 + 1024 + h * 64, 1536, CTXL / 64, (char*)lds_raw, attn_body::NaArgs{}, wv_, 2, p.q_norm_g + l * 64, 0);
                else attn_body::attn_unit<8, false>(Pq + row0 * INC + O_NAQ + h * 64, INC, Pq + row0 * INC + O_NAK + h * 64, INC, Pq + row0 * INC + O_NAV + h * 64, INC,
                                             Yo + row0 * 1536 + 512 + h * 64, 1536, CTXL / 64, (char*)lds_raw, attn_body::NaArgs{}, wv_);
            }
        }
        SEAM(pb + PHL_MIX2);
        if (IN(pb + PHL_MERGE) && (MK_PHMASK & 4)) {
            PHASE_WS;
            pg8::SchedMerge S{(const char*)(ws + WS_Y), (const char*)(ws + WS_WMG) + (size_t)l * 3 * D * 512 * 2, !lastl, G, bx};
            pg8::EpiMergeF E{(const bf16_t*)(ws + WS_P), (bf16_t*)(ws + WS_M)};
            REPS(14) pg8::gemm_phase<pg8::EpiMergeF, pg8::SchedMerge, true, true, false, false, true>(lds, pg8::Gemm{512 * 2, 1536 * 2, 512 * 2, 0, 0}, S, E, wv_);
            if ((MK_REPEAT >> 4) & 1) { pg8::EpiNull EN{(float*)(ws + WS_CTL) + 8000}; pg8::gemm_phase<pg8::EpiNull, pg8::SchedMerge, true, true, false, false, true>(lds, pg8::Gemm{512 * 2, 1536 * 2, 512 * 2, 0, 0}, S, EN, wv_); }
        }
        SEAM(pb + PHL_MERGE);
        if (IN(pb + PHL_OUT) && (MK_PHMASK & 8)) {
            PHASE_WS;
            pg8::SchedOut S{(const char*)(ws + WS_M), (const char*)(ws + WS_WOUT) + (size_t)l * D * D * 2, !lastl, G, bx};
            REPS(10) { pg8::EpiOutF E{(bf16_t*)(ws + WS_X), (const float*)(ws + WS_MOD) + (size_t)l * 9 * MODW, rep_ ? 0.f : 1.f};
                pg8::gemm_phase<pg8::EpiOutF, pg8::SchedOut, true, true, false, false, true>(lds, pg8::Gemm{D * 2, D * 2, D * 2, 0, 0}, S, E, wv_); }
        }
        SEAM(pb + PHL_OUT);
        if (IN(pb + PHL_ROUTE) && (MK_PHMASK & 256)) {
            PHASE_IDS;
            typedef _Float16 h8 __attribute__((ext_vector_type(8))); typedef _Float16 h2v __attribute__((ext_vector_type(2)));
            const int tpb = nrows / NRB, nchunk = (tpb + 31) / 32; LAS int* hist = (LAS int*)(lds + HIST_OFF);
            if (tid < 32) hist[tid] = 0;
            const int r16 = lane & 15, kq = lane >> 4;
            h8 bw[2][4];
            { const _Float16* wsrc = (const _Float16*)(ws + WS_WRT) + (size_t)l * NE * D;
#pragma unroll
                for (int eh = 0; eh < 2; ++eh)
#pragma unroll
                    for (int ks = 0; ks < 4; ++ks) bw[eh][ks] = *(const h8*)(wsrc + (size_t)(16 * eh + r16) * D + 128 * wave + 32 * ks + 8 * kq); }
            LAS float* part = (LAS float*)(lds + 65536);
            const float* gain = p.norm2_g + l * D; const float rb0 = p.router_b[l * NE + r16], rb1 = p.router_b[l * NE + 16 + r16];
            __syncthreads();
            REPS(7) { uint2 xw[4][4];
#define ROUTE_LOAD(c_) do { _Pragma("unroll") for (int rr = 0; rr < 4; ++rr) { const int rl_ = min(32 * (c_) + 4 * wave + rr, tpb - 1); const uint2* xr = (const uint2*)((const bf16_t*)(ws + WS_X) + (size_t)(bx * tpb + rl_) * D); \
                    _Pragma("unroll") for (int i = 0; i < 4; ++i) xw[rr][i] = xr[lane + 64 * i]; } } while (0)
              ROUTE_LOAD(0);
              for (int ck = 0; ck < nchunk; ++ck) {
#pragma unroll
                for (int rr = 0; rr < 4; ++rr) { const int rloc = 32 * ck + 4 * wave + rr; if (rloc < tpb) { const int row = bx * tpb + rloc, srow = 4 * wave + rr; float ss = 0.f; float4 xv[4];
#pragma unroll
                    for (int i = 0; i < 4; ++i) { const uint2 w = xw[rr][i]; xv[i] = make_float4(bf2f(w.x & 0xffff), bf2f(w.x >> 16), bf2f(w.y & 0xffff), bf2f(w.y >> 16)); ss += xv[i].x * xv[i].x + xv[i].y * xv[i].y + xv[i].z * xv[i].z + xv[i].w * xv[i].w; }
                    const float r = rsqrtf(wave_sum(ss, lane) * (1.f / D) + EPS);
                    const float* m = (const float*)(ws + WS_MOD) + ((size_t)l * 9 + mod_row(row)) * MODW + 3 * D; int* ho = (int*)(ws + WS_H + (size_t)row * D);
#pragma unroll
                    for (int i = 0; i < 4; ++i) { const int c4 = lane + 64 * i; const float4 g = ((const float4*)gain)[c4], sh = ((const float4*)m)[c4], sc = ((const float4*)(m + D))[c4]; const float4 v = xv[i];
                        const float h0 = v.x * r * g.x * (1.f + sc.x) + sh.x, h1 = v.y * r * g.y * (1.f + sc.y) + sh.y, h2 = v.z * r * g.z * (1.f + sc.z) + sh.z, h3 = v.w * r * g.w * (1.f + sc.w) + sh.w;
                        { int w8 = __builtin_amdgcn_cvt_pk_fp8_f32(h0, h1, 0, false); w8 = __builtin_amdgcn_cvt_pk_fp8_f32(h2, h3, w8, true); ho[c4] = w8; }
                        const h2v f01 = {(_Float16)h0, (_Float16)h1}, f23 = {(_Float16)h2, (_Float16)h3};
                        *(LAS pg8::u32x2*)(lds + srow * 2048 + ((((c4 >> 1) ^ (srow & 15))) << 4) + (c4 & 1) * 8) = (pg8::u32x2){__builtin_bit_cast(unsigned, f01), __builtin_bit_cast(unsigned, f23)}; } } }
                if (ck + 1 < nchunk) ROUTE_LOAD(ck + 1);
                __syncthreads();
                float zr_; asm volatile("v_mov_b32 %0, 0" : "=v"(zr_)); pg8::f32x4 acc[2][2];
#pragma unroll
                for (int rb = 0; rb < 2; ++rb)
#pragma unroll
                    for (int eh = 0; eh < 2; ++eh) acc[rb][eh] = (pg8::f32x4){zr_, zr_, zr_, zr_};
#pragma unroll
                for (int ks = 0; ks < 4; ++ks)
#pragma unroll
                    for (int rb = 0; rb < 2; ++rb) { const int arow = 16 * rb + r16, ch = 16 * wave + 4 * ks + kq;
                        const h8 a = *(const LAS h8*)(lds + arow * 2048 + ((ch ^ (arow & 15)) << 4));
                        acc[rb][0] = __builtin_amdgcn_mfma_f32_16x16x32_f16(a, bw[0][ks], acc[rb][0], 0, 0, 0); acc[rb][1] = __builtin_amdgcn_mfma_f32_16x16x32_f16(a, bw[1][ks], acc[rb][1], 0, 0, 0); }
#pragma unroll
                for (int rb = 0; rb < 2; ++rb)
#pragma unroll
                    for (int eh = 0; eh < 2; ++eh)
#pragma unroll
                        for (int reg = 0; reg < 4; ++reg) part[(wave * 32 + 16 * rb + 4 * kq + reg) * 32 + 16 * eh + r16] = acc[rb][eh][reg];
                __syncthreads();
                {
                    const int trow = lane >> 4, sub = lane & 15, srow = 4 * wave + trow, rloc = 32 * ck + srow;
                    float v0 = rb0, v1 = rb1;
#pragma unroll
                    for (int w8 = 0; w8 < 8; ++w8) { v0 += part[(w8 * 32 + srow) * 32 + sub]; v1 += part[(w8 * 32 + srow) * 32 + 16 + sub]; }
                    int ie[4]; float ve[4];
#pragma unroll
                    for (int k = 0; k < 4; ++k) { float mx = fmaxf(v0, v1);
#pragma unroll
                        for (int o = 1; o < 16; o <<= 1) mx = fmaxf(mx, lane_xor(mx, lane, o));
                        int cand = (v0 == mx) ? sub : ((v1 == mx) ? sub + 16 : 64);
#pragma unroll
                        for (int o = 1; o < 16; o <<= 1) cand = min(cand, __builtin_amdgcn_ds_bpermute((lane ^ o) << 2, cand));
                        ie[k] = cand; ve[k] = mx; if (cand == sub) v0 = -INFINITY; if (cand == sub + 16) v1 = -INFINITY; }
                    const float e1 = expf(ve[1] - ve[0]), e2 = expf(ve[2] - ve[0]), e3 = expf(ve[3] - ve[0]), is = 1.f / (1.f + e1 + e2 + e3);
                    if (rloc < tpb) {
                        if (sub == 0) { ((int4*)(ws + WS_TOKE))[bx * tpb + rloc] = make_int4(ie[0], ie[1], ie[2], ie[3]); ((float4*)(ws + WS_TOKG))[bx * tpb + rloc] = make_float4(is, e1 * is, e2 * is, e3 * is); }
                        if (sub < 4 && rep_ == ((MK_REPEAT >> 7) & 1)) { const int ek = sub == 0 ? ie[0] : sub == 1 ? ie[1] : sub == 2 ? ie[2] : ie[3]; __hip_atomic_fetch_add(hist + ek, 1, __ATOMIC_RELAXED, __HIP_MEMORY_SCOPE_WORKGROUP); } } }
              }
#undef ROUTE_LOAD
            }
            __syncthreads();
            if (tid < 32) ((int*)(ws + WS_BCNT))[(l * NRB + bx) * 32 + tid] = hist[tid];
        }
        SEAM(pb + PHL_ROUTE);
        if (IN(pb + PHL_SCAN) && (MK_PHMASK & 512)) {
            PHASE_IDS;
            const int tpb = nrows / NRB, nent = tpb * 4;
            LAS int* part = (LAS int*)(lds + SC_PART_OFF); LAS int* tot = (LAS int*)(lds + SC_TOT_OFF); LAS int* base = (LAS int*)(lds + SC_BASE_OFF); LAS int* seoff = (LAS int*)(lds + SC_EOFF_OFF);
            LAS int* wcnt = (LAS int*)(lds + SC_WCNT_OFF); LAS int* sslot = (LAS int*)(lds + SC_SLOT_OFF);
            const int* bc = (const int*)(ws + WS_BCNT) + l * NRB * 32;
            { const int e = tid & 31, ch = tid >> 5; int sa = 0, sb = 0;
                for (int i = 0; i < 16; ++i) { const int b = ch * 16 + i; const int c = bc[b * 32 + e]; sa += c; sb += (b < bx) ? c : 0; }
                part[ch * 32 + e] = sa; part[512 + ch * 32 + e] = sb; }
            __syncthreads();
            if (tid < 32) { int ta = 0, tb = 0; for (int ch = 0; ch < 16; ++ch) { ta += part[ch * 32 + tid]; tb += part[512 + ch * 32 + tid]; } tot[tid] = ta; base[tid] = tb; }
            __syncthreads();
            if (tid == 0) { int o = 0; for (int i = 0; i < 32; ++i) { seoff[i] = o; o += (tot[i] + 255) & ~255; } seoff[32] = o; }
            __syncthreads();
            if (bx == 0 && tid <= 32) ((int*)(ws + WS_EOFF))[l * 64 + tid] = seoff[tid];
            const int* te = (const int*)(ws + WS_TOKE) + (size_t)bx * nent; int* ts = (int*)(ws + WS_TOKS) + (size_t)bx * nent;
            int mye[2], myrank[2];
#pragma unroll
            for (int rep = 0; rep < 2; ++rep) { const int chunk = wave + 8 * rep, i = chunk * 64 + lane; int e = -1, rank = 0;
                if (chunk * 64 < nent) { if (i < nent) e = te[i];
                    for (int ee = 0; ee < 32; ++ee) { const unsigned long long mk = __ballot(e == ee); if (e == ee) rank = __popcll(mk & ((1ull << lane) - 1ull)); if (lane == 0) wcnt[chunk * 32 + ee] = __popcll(mk); } }
                mye[rep] = e; myrank[rep] = rank; }
            __syncthreads();
#pragma unroll
            for (int rep = 0; rep < 2; ++rep) if (mye[rep] >= 0) { const int chunk = wave + 8 * rep, i = chunk * 64 + lane, e = mye[rep]; int cb = 0;
                for (int c = 0; c < chunk; ++c) cb += wcnt[c * 32 + e];
                const int slot = seoff[e] + base[e] + cb + myrank[rep]; ts[i] = slot; ((int*)(ws + WS_STOK))[slot] = bx * tpb + (i >> 2); }
            __syncthreads();
            if (bx < NE) { const int s0 = seoff[bx] + tot[bx], s1 = seoff[bx + 1]; for (int s = s0 + tid; s < s1; s += NWAVES * 64) ((int*)(ws + WS_STOK))[s] = 0; }
        }
        SEAM(pb + PHL_SCAN);
        if ((IN(pb + PHL_GEMM1) || IN(pb + PHL_GEMM2)) && (MK_PHMASK & 48)) {
            PHASE_WS;
            const int tid0 = opaque_tid(wv_);
            if (tid0 < 64) ((LAS int*)(lds + EOFF_OFF))[tid0] = tid0 <= NE ? (int)__hip_atomic_load((unsigned*)(ws + WS_EOFF) + l * 64 + tid0, __ATOMIC_RELAXED, __HIP_MEMORY_SCOPE_AGENT) : 0;
            __syncthreads();
        }
        if (IN(pb + PHL_GEMM1) && (MK_PHMASK & 16)) {
            PHASE_WS;
            pg8::SchedMoe S{(const char*)(ws + WS_H), (const char*)(ws + WS_WGU) + (size_t)l * NE * 2048 * D, (const LAS int*)(lds + EOFF_OFF), 8, G, bx, (size_t)2048 * D, D, true};
            pg8::EpiGUF E{ws + WS_A, (const float*)(ws + WS_BGU) + (size_t)l * NE * 2048, false};
            if ((MK_REPEAT >> 17) & 3) { pg8::EpiGUF E0{ws + WS_A, (const float*)(ws + WS_BGU) + (size_t)l * NE * 2048, ((MK_REPEAT >> 17) & 3) == 2};
                pg8::gemm_phase<pg8::EpiGUF, pg8::SchedMoe, true, true, true, true>(lds, pg8::Gemm{D, D, D, 0x7f7f7f7f, 0x79797979}, S, E0, wv_, (const int*)(ws + WS_STOK), (LAS int*)(lds + GTAB_OFF), (LAS float*)(lds + LBIAS_OFF)); }
            REPS(5) pg8::gemm_phase<pg8::EpiGUF, pg8::SchedMoe, true, true, true, true>(lds, pg8::Gemm{D, D, D, 0x7f7f7f7f, 0x79797979}, S, E, wv_, (const int*)(ws + WS_STOK), (LAS int*)(lds + GTAB_OFF), (LAS float*)(lds + LBIAS_OFF));
        }
        SEAM(pb + PHL_GEMM1);
        if (IN(pb + PHL_GEMM2) && (MK_PHMASK & 32)) {
            PHASE_WS;
            pg8::SchedMoe S{(const char*)(ws + WS_A), (const char*)(ws + WS_WDN) + (size_t)l * NE * D * D, (const LAS int*)(lds + EOFF_OFF), 4, G, bx, (size_t)D * D, D, false};
            pg8::EpiStoreF8 E{ws + WS_YB, D, p.b_down + (size_t)l * NE * D, D, YB_SCALE};
            REPS(6) pg8::gemm_phase<pg8::EpiStoreF8, pg8::SchedMoe, true, true, true>(lds, pg8::Gemm{D, D, D, 0x7d7d7d7d, 0x79797979}, S, E, wv_, nullptr, nullptr, (LAS float*)(lds + LBIAS_OFF));
        }
        SEAM(pb + PHL_GEMM2);
        if (IN(pb + PHL_COMB) && (MK_PHMASK & 1024)) {
            PHASE_IDS;
            REPS(11) for (int row = gw; row < nrows; row += 3 * NGW) combine_rows<3>(p, l, lastl ? 1 : 0, row, NGW, nrows, lane, rep_ ? 0.f : 1.f);
        }
        SEAM(pb + PHL_COMB);
    }
#undef IN
#undef SEAM
#undef PHASE_IDS
}

#ifndef MK_N_LAUNCHES
#define MK_N_LAUNCHES 1
#endif
static int g_grid = 0;
static void launch_mk(const Ptrs& p, int lo, int hi, hipStream_t stream) {
    MkArgs a{}; a.p = p; a.ph_lo = lo; a.ph_hi = hi;
    hipLaunchKernelGGL(mk_fwd, dim3(g_grid), dim3(NWAVES * 64), LDS_BYTES, stream, a);
    const hipError_t le = hipPeekAtLastError();
    if (le != hipSuccess) fprintf(stderr, "kernel_launch: mk_fwd[%d,%d) launch failed: %s\n", lo, hi, hipGetErrorName(le));
}
extern "C" void kernel_launch(void* const* d_in, const int* in_sizes, int n_in, void* d_out, int out_size, void* d_ws, size_t ws_size, hipStream_t stream) {
    if (n_in != 24 || ws_size < WS_END) { fprintf(stderr, "kernel_launch: unexpected n_in %d / ws %zu (need %zu)\n", n_in, ws_size, (size_t)WS_END); return; }
    if (g_grid == 0) {
        int dev = 0, cus = 0, per_cu = 0;
        if (hipGetDevice(&dev) != hipSuccess || hipDeviceGetAttribute(&cus, hipDeviceAttributeMultiprocessorCount, dev) != hipSuccess) { fprintf(stderr, "kernel_launch: device query failed\n"); g_grid = -1; return; }
        if (hipFuncSetAttribute((const void*)mk_fwd, hipFuncAttributeMaxDynamicSharedMemorySize, LDS_BYTES) != hipSuccess) { fprintf(stderr, "kernel_launch: hipFuncSetAttribute failed\n"); g_grid = -1; return; }
        if (hipOccupancyMaxActiveBlocksPerMultiprocessor(&per_cu, (const void*)mk_fwd, NWAVES * 64, LDS_BYTES) != hipSuccess || per_cu < 1) fprintf(stderr, "kernel_launch: occupancy query reports %d\n", per_cu);
        (void)hipGetLastError();
        g_grid = cus;
        if (g_grid != NRB) { fprintf(stderr, "kernel_launch: %d CUs, this kernel is written for %d\n", cus, NRB); g_grid = NRB; }
    }
    if (g_grid < 0) return;
    Ptrs p{};
    const float** pp = (const float**)&p; for (int i = 0; i < 24; ++i) pp[i] = (const float*)d_in[i];
    p.out = (float*)d_out; p.ws = (unsigned char*)d_ws;
    (void)hipMemsetAsync(p.ws + WS_CTL, 0, 65536, stream);
    if (MK_N_LAUNCHES == 1) launch_mk(p, 0, PH_END, stream);
    else for (int ph = 0; ph < PH_END; ++ph) launch_mk(p, ph, ph + 1, stream);
}
```
